# Optimizing an MI355X kernel written in HIP

```python
import math
import jax, jax.numpy as jnp
from jax import lax
import numpy as np

D_MODEL = 2048
BATCH = 16
SEQ = 256
DEPTH = 4
DEC_BATCH = 4
DEC_SEQ = 1024
PAST_LEN = 256

GRID_W = 64
MLA_HEADS = 8
MLA_NOPE = 128
MLA_ROPE = 64
MLA_V = 128
Q_LORA = 512
KV_LORA = 256
MLA_WIDTH = MLA_HEADS * MLA_V
FNET_GROUPS = 4
FNET_GROUP_DIM = 128
FNET_WIDTH = FNET_GROUPS * FNET_GROUP_DIM
RWKV_HEADS = 8
RWKV_HEAD_DIM = 64
RWKV_WIDTH = RWKV_HEADS * RWKV_HEAD_DIM
W_LORA = 64
A_LORA = 64
G_LORA = 128
MIX_WIDTH = MLA_WIDTH + FNET_WIDTH + RWKV_WIDTH
IN_SIZES = (Q_LORA, KV_LORA, MLA_ROPE, FNET_WIDTH, 3 * RWKV_WIDTH, W_LORA, A_LORA, G_LORA)
IN_WIDTH = Q_LORA + KV_LORA + MLA_ROPE + FNET_WIDTH + 3 * RWKV_WIDTH + W_LORA + A_LORA + G_LORA
D_FF = 5632
CONV_W = 3
QUERY_BLOCK = 128
ROPE_BASE = 10000.0
EPS = 1e-6
GN_EPS = 64e-5
DECAY_SCALE = math.exp(-0.5)

kernel_name = 'hybrid_mla_fnet_rwkv7_dit_step'


def _split(x, sizes):
    idx = np.cumsum(sizes)[:-1].tolist()
    return jnp.split(x, idx, axis=-1)


def rmsnorm(x, g):
    x32 = x.astype(jnp.float32)
    y = x32 * lax.rsqrt(jnp.mean(x32 * x32, axis=-1, keepdims=True) + EPS)
    return (y * g.astype(jnp.float32)).astype(x.dtype)


def dwconv3(x, w):
    xp = jnp.pad(x, ((0, 0), (1, 1), (0, 0)))
    return xp[:, :-2] * w[0] + xp[:, 1:-1] * w[1] + xp[:, 2:] * w[2]


def rope_tables(T, dtype):
    rows = T // GRID_W
    t = jnp.arange(rows * GRID_W)
    row = (t // GRID_W).astype(jnp.float32)
    col = (t % GRID_W).astype(jnp.float32)
    n = MLA_ROPE // 4
    inv = ROPE_BASE ** (-jnp.arange(n, dtype=jnp.float32) / n)
    ang = jnp.concatenate([row[:, None] * inv, col[:, None] * inv], axis=-1)
    return jnp.cos(ang).astype(dtype), jnp.sin(ang).astype(dtype)


def apply_rope(x, cos, sin):
    half = MLA_ROPE // 2
    x1, x2 = x[..., :half], x[..., half:]
    return jnp.concatenate([x1 * cos - x2 * sin, x1 * sin + x2 * cos], axis=-1)


def up_kv(c_kv, w_ukv):
    B, T, _ = c_kv.shape
    kv = (c_kv @ w_ukv).reshape(B, T, MLA_HEADS, MLA_NOPE + MLA_V)
    return kv[..., :MLA_NOPE], kv[..., MLA_NOPE:]


def block_attention(q_nope, q_rope, k_nope, k_rope, v):
    B, Tq, H, _ = q_nope.shape
    nb = Tq // QUERY_BLOCK
    scale = (MLA_NOPE + MLA_ROPE) ** -0.5

    def one_block(qs):
        qn, qr = qs
        s = jnp.einsum('bqhd,bkhd->bhqk', qn, k_nope) + jnp.einsum('bqhd,bkd->bhqk', qr, k_rope)
        p = jax.nn.softmax(s.astype(jnp.float32) * scale, axis=-1).astype(v.dtype)
        return jnp.einsum('bhqk,bkhd->bqhd', p, v)

    qn = q_nope.reshape(B, nb, QUERY_BLOCK, H, MLA_NOPE).swapaxes(0, 1)
    qr = q_rope.reshape(B, nb, QUERY_BLOCK, H, MLA_ROPE).swapaxes(0, 1)
    out = lax.map(one_block, (qn, qr))
    return out.swapaxes(0, 1).reshape(B, Tq, H * MLA_V)


def fourier_mix(xf):
    B, T, _ = xf.shape
    z = xf.astype(jnp.float32).reshape(B, T, FNET_GROUPS, FNET_GROUP_DIM)
    out = jnp.fft.fft2(z, axes=(1, 3), norm='ortho').real
    return out.reshape(B, T, FNET_WIDTH).astype(xf.dtype)


def rwkv_scan(r, w, kt, v, kh, a, s0):
    def step(S, inp):
        r_t, w_t, k_t, v_t, kh_t, a_t = inp
        sk = jnp.einsum('bhvk,bhk->bhv', S, kh_t)
        S = (S * w_t[:, :, None, :] - sk[..., None] * (a_t * kh_t)[:, :, None, :]
             + v_t[..., None] * k_t[:, :, None, :])
        return S, jnp.einsum('bhvk,bhk->bhv', S, r_t)

    xs = tuple(jnp.moveaxis(t, 1, 0) for t in (r, w, kt, v, kh, a))
    S, ys = lax.scan(step, s0, xs)
    return jnp.moveaxis(ys, 0, 1), S


def rwkv_mix(rkv, w_lo, a_lo, g_lo, p, s0_f, s0_b):
    B, T, _ = rkv.shape
    f32 = jnp.float32
    r, k, v = jnp.split(dwconv3(rkv, p['rwkv_conv']).astype(f32), 3, axis=-1)
    w_lo, a_lo, g_lo = w_lo.astype(f32), a_lo.astype(f32), g_lo.astype(f32)
    w = jnp.exp(-DECAY_SCALE * jax.nn.sigmoid(
        p['rwkv_w0'][:, None, None, :] + jnp.einsum('btr,drc->dbtc', jnp.tanh(w_lo), p['rwkv_w2'])))
    a = jax.nn.sigmoid(p['rwkv_a0'][:, None, None, :] + jnp.einsum('btr,drc->dbtc', a_lo, p['rwkv_a2']))
    g = jax.nn.sigmoid(g_lo) @ p['rwkv_g2']

    def heads(t):
        return t.reshape(t.shape[:-1] + (RWKV_HEADS, RWKV_HEAD_DIM))

    kappa = heads(k * p['rwkv_k_k'])
    kh = kappa * lax.rsqrt(jnp.sum(kappa * kappa, axis=-1, keepdims=True) + EPS)
    kt = heads(k * (1.0 + (a - 1.0) * p['rwkv_k_a']))
    rh, vh, wh, ah = heads(r), heads(v), heads(w), heads(a)
    y_f, S_f = rwkv_scan(rh, wh[0], kt[0], vh, kh, ah[0], s0_f.astype(f32))

    def flip(t):
        return t[:, ::-1]

    y_b, S_b = rwkv_scan(flip(rh), flip(wh[1]), flip(kt[1]), flip(vh), flip(kh), flip(ah[1]),
                         s0_b.astype(f32))
    y = y_f + flip(y_b)
    mu = jnp.mean(y, axis=-1, keepdims=True)
    var = jnp.mean((y - mu) ** 2, axis=-1, keepdims=True)
    yn = ((y - mu) * lax.rsqrt(var + GN_EPS)).reshape(B, T, RWKV_WIDTH) * p['rwkv_gn_g'] + p['rwkv_gn_b']
    bonus = jnp.sum(rh[None] * kt * heads(p['rwkv_r_k']), axis=-1, keepdims=True).sum(0) * vh
    out = (yn + bonus.reshape(B, T, RWKV_WIDTH)) * g
    return out.astype(rkv.dtype), S_f, S_b


def mixers(h, p, ctx, rope):
    B, T, _ = h.shape
    q_dn, kv_dn, k_rope, xf, rkv, w_lo, a_lo, g_lo = _split(h @ p['w_in'], IN_SIZES)
    q = (rmsnorm(q_dn, p['g_q_norm']) @ p['w_uq']).reshape(B, T, MLA_HEADS, MLA_NOPE + MLA_ROPE)
    q_nope, q_rope = q[..., :MLA_NOPE], q[..., MLA_NOPE:]
    c_kv = rmsnorm(kv_dn, p['g_kv_norm'])
    k_nope, v = up_kv(c_kv, p['w_ukv'])
    if ctx is None:
        k_nope_all, k_rope_all, v_all = k_nope, k_rope, v
        s0_f = jnp.zeros((B, RWKV_HEADS, RWKV_HEAD_DIM, RWKV_HEAD_DIM), jnp.float32)
        s0_b = s0_f
    else:
        ctx_ckv, ctx_krope, s0_f, s0_b = ctx
        cos, sin = rope
        q_rope = apply_rope(q_rope, cos[:, None], sin[:, None])
        k_rope_lat = apply_rope(k_rope, cos, sin)
        ck_nope, cv = up_kv(ctx_ckv.astype(h.dtype), p['w_ukv'])
        k_nope_all = jnp.concatenate([ck_nope, k_nope], axis=1)
        k_rope_all = jnp.concatenate([ctx_krope.astype(h.dtype), k_rope_lat], axis=1)
        v_all = jnp.concatenate([cv, v], axis=1)
    attn = block_attention(q_nope, q_rope, k_nope_all, k_rope_all, v_all)
    four = fourier_mix(xf)
    rw, S_f, S_b = rwkv_mix(rkv, w_lo, a_lo, g_lo, p, s0_f, s0_b)
    mix = jnp.concatenate([attn, four, rw], axis=-1)
    return mix, (c_kv, k_rope, S_f, S_b)


def conv_ffn(h, p):
    u = dwconv3(h @ p['ffn_w_up'], p['ffn_conv']) + p['ffn_conv_b']
    gate, val = jnp.split(u, 2, axis=-1)
    return (jax.nn.silu(gate) * val) @ p['ffn_w_down']


def trunk_layer(x, mod, p, ctx, rope):
    sh1, sc1, g1, sh2, sc2, g2 = jnp.split(mod[:, None, :].astype(x.dtype), 6, axis=-1)
    h = rmsnorm(x, p['g_pre_mix']) * (1.0 + sc1) + sh1
    mix, side = mixers(h, p, ctx, rope)
    x = x + g1 * rmsnorm(mix @ p['w_out'], p['g_post_mix'])
    h = rmsnorm(x, p['g_pre_ffn']) * (1.0 + sc2) + sh2
    x = x + g2 * rmsnorm(conv_ffn(h, p), p['g_post_ffn'])
    return x, side


def setup_inputs(seed: int = 0) -> dict:
    key = jax.random.key(seed)
    ks = jax.random.split(key, 40)

    def nrm(i, shape, scale):
        return jax.random.normal(ks[i], shape, jnp.float32) * scale

    L = DEPTH
    R = RWKV_WIDTH
    return {
        'x_prompt': nrm(0, (BATCH, SEQ, D_MODEL), 1.0),
        'x_sample': nrm(1, (DEC_BATCH, DEC_SEQ, D_MODEL), 1.0),
        'cache_mla_ckv': nrm(2, (DEC_BATCH, L, PAST_LEN, KV_LORA), 1.0),
        'cache_mla_krope': nrm(3, (DEC_BATCH, L, PAST_LEN, MLA_ROPE), 1.0),
        'state_rwkv': nrm(4, (DEC_BATCH, L, 2, RWKV_HEADS, RWKV_HEAD_DIM, RWKV_HEAD_DIM), 0.1),
        'c': nrm(5, (DEC_BATCH, D_MODEL), 1.0),
        'c_ctx': nrm(6, (D_MODEL,), 1.0),
        'w_mod': nrm(7, (L, D_MODEL, 6 * D_MODEL), 0.5 * D_MODEL ** -0.5),
        'b_mod': nrm(8, (L, 6 * D_MODEL), 0.01),
        'g_pre_mix': 1.0 + nrm(9, (L, D_MODEL), 0.05),
        'g_post_mix': 1.0 + nrm(10, (L, D_MODEL), 0.05),
        'g_pre_ffn': 1.0 + nrm(11, (L, D_MODEL), 0.05),
        'g_post_ffn': 1.0 + nrm(12, (L, D_MODEL), 0.05),
        'w_in': nrm(13, (L, D_MODEL, IN_WIDTH), D_MODEL ** -0.5),
        'g_q_norm': 1.0 + nrm(14, (L, Q_LORA), 0.05),
        'w_uq': nrm(15, (L, Q_LORA, MLA_HEADS * (MLA_NOPE + MLA_ROPE)), Q_LORA ** -0.5),
        'g_kv_norm': 1.0 + nrm(16, (L, KV_LORA), 0.05),
        'w_ukv': nrm(17, (L, KV_LORA, MLA_HEADS * (MLA_NOPE + MLA_V)), KV_LORA ** -0.5),
        'rwkv_conv': nrm(18, (L, CONV_W, 3 * R), CONV_W ** -0.5),
        'rwkv_w0': nrm(19, (L, 2, R), 1.0),
        'rwkv_w2': nrm(20, (L, 2, W_LORA, R), 0.5 * W_LORA ** -0.5),
        'rwkv_a0': nrm(21, (L, 2, R), 0.5),
        'rwkv_a2': nrm(22, (L, 2, A_LORA, R), 0.5 * A_LORA ** -0.5),
        'rwkv_g2': nrm(23, (L, G_LORA, R), G_LORA ** -0.5),
        'rwkv_k_k': 0.85 + nrm(24, (L, R), 0.05),
        'rwkv_k_a': 1.0 + nrm(25, (L, R), 0.05),
        'rwkv_r_k': nrm(26, (L, R), 0.1),
        'rwkv_gn_g': 1.0 + nrm(27, (L, R), 0.05),
        'rwkv_gn_b': nrm(28, (L, R), 0.01),
        'w_out': nrm(29, (L, MIX_WIDTH, D_MODEL), MIX_WIDTH ** -0.5),
        'ffn_w_up': nrm(30, (L, D_MODEL, 2 * D_FF), D_MODEL ** -0.5),
        'ffn_conv': nrm(31, (L, CONV_W, 2 * D_FF), CONV_W ** -0.5),
        'ffn_conv_b': nrm(32, (L, 2 * D_FF), 0.01),
        'ffn_w_down': nrm(33, (L, D_FF, D_MODEL), D_FF ** -0.5),
    }


def reference(x_prompt, x_sample, cache_mla_ckv, cache_mla_krope, state_rwkv, c, c_ctx,
              w_mod, b_mod, g_pre_mix, g_post_mix, g_pre_ffn, g_post_ffn,
              w_in, g_q_norm, w_uq, g_kv_norm, w_ukv,
              rwkv_conv, rwkv_w0, rwkv_w2, rwkv_a0, rwkv_a2, rwkv_g2,
              rwkv_k_k, rwkv_k_a, rwkv_r_k, rwkv_gn_g, rwkv_gn_b,
              w_out, ffn_w_up, ffn_conv, ffn_conv_b, ffn_w_down):
    rope = rope_tables(x_sample.shape[1], x_sample.dtype)
    xp, xs = x_prompt, x_sample
    ckv_out, krope_out, state_out = [], [], []
    for l in range(DEPTH):
        p = {
            'g_pre_mix': g_pre_mix[l], 'g_post_mix': g_post_mix[l],
            'g_pre_ffn': g_pre_ffn[l], 'g_post_ffn': g_post_ffn[l],
            'w_in': w_in[l], 'g_q_norm': g_q_norm[l], 'w_uq': w_uq[l],
            'g_kv_norm': g_kv_norm[l], 'w_ukv': w_ukv[l],
            'rwkv_conv': rwkv_conv[l], 'rwkv_w0': rwkv_w0[l], 'rwkv_w2': rwkv_w2[l],
            'rwkv_a0': rwkv_a0[l], 'rwkv_a2': rwkv_a2[l], 'rwkv_g2': rwkv_g2[l],
            'rwkv_k_k': rwkv_k_k[l], 'rwkv_k_a': rwkv_k_a[l], 'rwkv_r_k': rwkv_r_k[l],
            'rwkv_gn_g': rwkv_gn_g[l], 'rwkv_gn_b': rwkv_gn_b[l],
            'w_out': w_out[l], 'ffn_w_up': ffn_w_up[l], 'ffn_conv': ffn_conv[l],
            'ffn_conv_b': ffn_conv_b[l], 'ffn_w_down': ffn_w_down[l],
        }
        mod_ctx = jax.nn.silu(c_ctx)[None, :] @ w_mod[l] + b_mod[l]
        mod_lat = jax.nn.silu(c) @ w_mod[l] + b_mod[l]
        xp, (ckv, kr, s_f, s_b) = trunk_layer(xp, mod_ctx, p, None, None)
        ckv_out.append(ckv)
        krope_out.append(kr)
        state_out.append(jnp.stack([s_f, s_b], axis=1))
        ctx = (cache_mla_ckv[:, l], cache_mla_krope[:, l], state_rwkv[:, l, 0], state_rwkv[:, l, 1])
        xs, _ = trunk_layer(xs, mod_lat, p, ctx, rope)
    new_mla_ckv = jnp.stack(ckv_out, axis=1)
    new_mla_krope = jnp.stack(krope_out, axis=1)
    new_rwkv_state = jnp.stack(state_out, axis=1)
    return (xp, xs, new_mla_ckv, new_mla_krope, new_rwkv_state)
```

```cpp
#include <hip/hip_runtime.h>
#include <cstdio>
#include <cstdint>
namespace pg8 {
#define PG8_LAS __attribute__((address_space(3)))
typedef unsigned short bf16_t;
typedef short bf16x8 __attribute__((ext_vector_type(8)));
typedef float f32x4 __attribute__((ext_vector_type(4)));
typedef unsigned u32x4 __attribute__((ext_vector_type(4)));
constexpr int BM = 256, BK = 64, HALF = 128, HTB = HALF * BK * 2  , STAGE_BYTES = 8 * HTB, NXCD = 8, WGM = 8;

__host__ __device__ __forceinline__ int lds_byte(int r, int c) { const int st = (r >> 4) * 2 + (c >> 5), rr = r & 15, cc = c & 31, ob = rr * 64 + cc * 2; return st * 1024 + (ob ^ (((ob >> 9) & 1) << 5)); }
__host__ __device__ __forceinline__ void stage_rc(int b, int& R, int& C) { const int st = b / 1024, sb = b % 1024, swz = sb ^ (((sb >> 9) & 1) << 5); R = (st >> 1) * 16 + swz / 64; C = (st & 1) * 32 + (swz % 64) / 2; }
__host__ __device__ __forceinline__ int perm32(int rho) { const int n = rho >> 4, i = rho & 15; return 8 * (i >> 2) + 4 * n + (i & 3); }

struct Unit { int pm, pn; };
struct Gemm { const bf16_t* A; const bf16_t* Bt; int M, N, K; };

struct StaticOrder {
    int nM, nN, nwg, G, c;
    __host__ __device__ void init(int M, int N, int G_, int c_) { nM = M / BM; nN = N / BM; nwg = nM * nN; G = G_; c = c_; }
    __host__ __device__ bool next(int i, Unit& u) const {
        const long L = (long)i * G + c; if (L >= nwg) return false;
        int wgid = (int)L; { const int q = nwg / NXCD, r = nwg % NXCD, xcd = wgid % NXCD, off = wgid / NXCD; wgid = (xcd < r ? xcd * (q + 1) : r * (q + 1) + (xcd - r) * q) + off; }
        const int nig = WGM * nN, gid = wgid / nig, fm = gid * WGM, gsz = (nM - fm) < WGM ? (nM - fm) : WGM;
        u.pm = fm + ((wgid % nig) % gsz); u.pn = (wgid % nig) / gsz; return true;
    }
    __device__ __forceinline__ void a_ready(const Unit&) const {}
    __device__ __forceinline__ void done(const Unit&) const {}
};

__device__ __forceinline__ unsigned cvt_pk_bf16(float lo, float hi) { unsigned r; asm volatile("v_cvt_pk_bf16_f32 %0, %1, %2" : "=v"(r) : "v"(lo), "v"(hi)); return r; }
typedef float f32x2 __attribute__((ext_vector_type(2)));
struct EpiF32 {
    static constexpr bool PERM = false, AFTER_DRAIN = false;
    float* C; int ldc; const float* bias;
    __device__ __forceinline__ void operator()(const f32x4 (&acc)[2][2][4][2], const Unit& u, int wr, int wc, int fr, int fq) const {
        const int row0 = u.pm * BM + wr * 64 + fr, col0 = u.pn * BM + wc * 32 + 4 * fq;
        f32x4 bv[2][2];
#pragma unroll
        for (int bj = 0; bj < 2; ++bj)
#pragma unroll
            for (int n = 0; n < 2; ++n) bv[bj][n] = bias ? *(const f32x4*)(bias + col0 + bj * HALF + n * 16) : (f32x4){0.f, 0.f, 0.f, 0.f};
#pragma unroll
        for (int ai = 0; ai < 2; ++ai)
#pragma unroll
            for (int m = 0; m < 4; ++m) { float* rowp = C + (size_t)(row0 + ai * HALF + m * 16) * ldc + col0;
#pragma unroll
                for (int bj = 0; bj < 2; ++bj)
#pragma unroll
                    for (int n = 0; n < 2; ++n) *(f32x4*)(rowp + bj * HALF + n * 16) = acc[ai][bj][m][n] + bv[bj][n]; }
    }
};
struct EpiAny {
    static constexpr bool PERM = true, AFTER_DRAIN = false;
    void* O; int ldc; int f32;
    __device__ __forceinline__ void operator()(const f32x4 (&acc)[2][2][4][2], const Unit& u, int wr, int wc, int fr, int fq) const {
        const int row0 = u.pm * BM + wr * 64 + fr, col0 = u.pn * BM + wc * 32 + 8 * fq;
        if (f32) {
#pragma unroll
            for (int ai = 0; ai < 2; ++ai)
#pragma unroll
                for (int m = 0; m < 4; ++m) { float* rowp = (float*)O + (size_t)(row0 + ai * HALF + m * 16) * ldc + col0;
#pragma unroll
                    for (int bj = 0; bj < 2; ++bj) { *(f32x4*)(rowp + bj * HALF) = acc[ai][bj][m][0]; *(f32x4*)(rowp + bj * HALF + 4) = acc[ai][bj][m][1]; } }
        } else {
#pragma unroll
            for (int ai = 0; ai < 2; ++ai)
#pragma unroll
                for (int m = 0; m < 4; ++m) { bf16_t* rowp = (bf16_t*)O + (size_t)(row0 + ai * HALF + m * 16) * ldc + col0;
#pragma unroll
                    for (int bj = 0; bj < 2; ++bj) { const f32x4 v0 = acc[ai][bj][m][0], v1 = acc[ai][bj][m][1];
                        u32x4 w; w.x = cvt_pk_bf16(v0[0], v0[1]); w.y = cvt_pk_bf16(v0[2], v0[3]); w.z = cvt_pk_bf16(v1[0], v1[1]); w.w = cvt_pk_bf16(v1[2], v1[3]);
                        *(u32x4*)(rowp + bj * HALF) = w; } }
        }
    }
};
template <class Epi, class Sched, bool ALIGN_EPI = false, bool SP2 = false>
__device__ __forceinline__ void gemm_phase(PG8_LAS unsigned char* lds, const Gemm g, const Sched& S, const Epi& E) {
    int tid_ = threadIdx.x; asm volatile("" : "+v"(tid_));
    const int tid = tid_, wid = __builtin_amdgcn_readfirstlane(tid >> 6), lane = tid & 63, wr = wid >> 2, wc = wid & 3, fr = lane & 15, fq = lane >> 4;
    const int K = g.K, nt = K / BK;
    unsigned voffA[2], voffB[2];
#pragma unroll
    for (int i = 0; i < 2; ++i) { int R, C; stage_rc(tid * 16 + i * 8192, R, C); const int Rb = Epi::PERM ? ((R & ~31) + perm32(R & 31)) : R;
        voffA[i] = (unsigned)(R * K + C) * 2u; voffB[i] = (unsigned)(Rb * K + C) * 2u; }
    const size_t kstep = (size_t)(BK * 2);
    const size_t hstep = (size_t)HALF * K * 2;
    const size_t tstep = 2 * hstep;
    const unsigned ldsw = (unsigned)wid * 1024u;
    const int aoff = lds_byte(wr * 64 + fr, fq * 8), boff = lds_byte(wc * 32 + fr, fq * 8);
#define PG8_SA(b, h) (((b) * 2 + (h)) * HTB)
#define PG8_SB(b, h) ((4 + (b) * 2 + (h)) * HTB)
#define PG8_STAGE(bufoff, gbase, voff) do { _Pragma("unroll") for (int _i = 0; _i < 2; ++_i) \
        __builtin_amdgcn_global_load_lds((const unsigned*)((const char*)(gbase) + (voff)[_i]), (PG8_LAS unsigned*)(lds + (bufoff) + ldsw + _i * 8192), 16, 0, 0); } while (0)
#define PG8_LDA(dst, b, h) do { _Pragma("unroll") for (int m = 0; m < 4; ++m) _Pragma("unroll") for (int k = 0; k < 2; ++k) dst[m][k] = *(const PG8_LAS bf16x8*)(lds + PG8_SA(b, h) + aoff + m * 2048 + k * 1024); } while (0)
#define PG8_LDB(dst, b, h) do { _Pragma("unroll") for (int n = 0; n < 2; ++n) _Pragma("unroll") for (int k = 0; k < 2; ++k) dst[n][k] = *(const PG8_LAS bf16x8*)(lds + PG8_SB(b, h) + boff + n * 2048 + k * 1024); } while (0)
#define PG8_MMA(ai, bj, At, Bt) do { __builtin_amdgcn_s_setprio(1); _Pragma("unroll") for (int m = 0; m < 4; ++m) _Pragma("unroll") for (int n = 0; n < 2; ++n) _Pragma("unroll") for (int k = 0; k < 2; ++k) \
        acc[ai][bj][m][n] = __builtin_amdgcn_mfma_f32_16x16x32_bf16(Bt[n][k], At[m][k], acc[ai][bj][m][n], 0, 0, 0); __builtin_amdgcn_s_setprio(0); } while (0)
#define PG8_WAIT_V(n) asm volatile("s_waitcnt vmcnt(" #n ")" ::: "memory")
#define PG8_WAIT_L(n) asm volatile("s_waitcnt lgkmcnt(" #n ")" ::: "memory")
#define PG8_BAR __builtin_amdgcn_s_barrier()
#define PG8_SCHED __builtin_amdgcn_sched_barrier(0)
    Unit cur, nxt; int ui = 0;
    if (!S.next(0, cur)) return;
    f32x4 acc[2][2][4][2];
#pragma unroll
    for (int a = 0; a < 2; ++a)
#pragma unroll
        for (int b = 0; b < 2; ++b)
#pragma unroll
            for (int m = 0; m < 4; ++m)
#pragma unroll
                for (int n = 0; n < 2; ++n) acc[a][b][m][n] = (f32x4){0.f, 0.f, 0.f, 0.f};
    bf16x8 At[4][2], B0[2][2], B1[2][2];
    const char* cA = (const char*)g.A + (size_t)cur.pm * tstep; const char* cB = (const char*)g.Bt + (size_t)cur.pn * tstep;
    S.a_ready(cur);
    if constexpr (SP2) {
        PG8_STAGE(PG8_SB(0, 0), cB, voffB); PG8_STAGE(PG8_SB(0, 1), cB + hstep, voffB); PG8_STAGE(PG8_SA(0, 0), cA, voffA); PG8_STAGE(PG8_SA(0, 1), cA + hstep, voffA);
        if (wr == 1) PG8_BAR;
        PG8_WAIT_V(2); PG8_BAR;
        PG8_STAGE(PG8_SB(1, 0), cB + kstep, voffB); PG8_STAGE(PG8_SA(1, 0), cA + kstep, voffA); PG8_STAGE(PG8_SB(1, 1), cB + hstep + kstep, voffB);
        PG8_WAIT_V(6); PG8_BAR;
    } else {
        PG8_STAGE(PG8_SB(0, 0), cB, voffB); PG8_STAGE(PG8_SA(0, 0), cA, voffA); PG8_STAGE(PG8_SB(0, 1), cB + hstep, voffB); PG8_STAGE(PG8_SA(0, 1), cA + hstep, voffA);
        if (wr == 1) PG8_BAR;
        PG8_WAIT_V(4); PG8_BAR;
        PG8_STAGE(PG8_SB(1, 0), cB + kstep, voffB); PG8_STAGE(PG8_SA(1, 0), cA + kstep, voffA); PG8_STAGE(PG8_SB(1, 1), cB + hstep + kstep, voffB);
        PG8_WAIT_V(6); PG8_BAR;
    }
    for (;;) {
        const bool has_next = S.next(ui + 1, nxt);
        const char* nA = has_next ? (const char*)g.A + (size_t)nxt.pm * tstep : cA; const char* nB = has_next ? (const char*)g.Bt + (size_t)nxt.pn * tstep : cB;
        for (int t = 0; t < nt; t += 2) {
            const bool last = (t == nt - 2);
            const char* a1 = cA + (size_t)(t + 1) * kstep;
            const char* a2 = last ? nA : cA + (size_t)(t + 2) * kstep; const char* b2 = last ? nB : cB + (size_t)(t + 2) * kstep;
            const char* a3 = a2 + kstep; const char* b3 = b2 + kstep;
            if (last && has_next) S.a_ready(nxt);
            if constexpr (SP2) {
            PG8_LDB(B0, 0, 0); PG8_LDB(B1, 0, 1); PG8_SCHED; PG8_LDA(At, 0, 0); PG8_STAGE(PG8_SA(1, 1), a1 + hstep, voffA);
            PG8_WAIT_V(8); PG8_WAIT_L(0); PG8_BAR; PG8_MMA(0, 0, At, B0); PG8_MMA(0, 1, At, B1); PG8_BAR; PG8_SCHED;
            PG8_LDA(At, 0, 1); PG8_STAGE(PG8_SB(0, 0), b2, voffB); PG8_STAGE(PG8_SB(0, 1), b2 + hstep, voffB); PG8_STAGE(PG8_SA(0, 0), a2, voffA);
            PG8_WAIT_V(8); PG8_WAIT_L(0); PG8_BAR; PG8_MMA(1, 0, At, B0); PG8_MMA(1, 1, At, B1); PG8_BAR; PG8_SCHED;
            PG8_LDB(B0, 1, 0); PG8_LDB(B1, 1, 1); PG8_SCHED; PG8_LDA(At, 1, 0); PG8_STAGE(PG8_SA(0, 1), a2 + hstep, voffA);
            PG8_WAIT_V(8); PG8_WAIT_L(0); PG8_BAR; PG8_MMA(0, 0, At, B0); PG8_MMA(0, 1, At, B1); PG8_BAR; PG8_SCHED;
            PG8_LDA(At, 1, 1); PG8_STAGE(PG8_SB(1, 0), b3, voffB); PG8_STAGE(PG8_SB(1, 1), b3 + hstep, voffB); PG8_STAGE(PG8_SA(1, 0), a3, voffA);
            PG8_WAIT_V(8); PG8_WAIT_L(0); PG8_BAR; PG8_MMA(1, 0, At, B0); PG8_MMA(1, 1, At, B1); PG8_BAR; PG8_SCHED;
            } else {
            PG8_LDB(B0, 0, 0); PG8_SCHED; PG8_LDA(At, 0, 0); PG8_STAGE(PG8_SA(1, 1), a1 + hstep, voffA);
            PG8_WAIT_L(8); PG8_BAR; PG8_WAIT_L(0); PG8_MMA(0, 0, At, B0); PG8_BAR; PG8_SCHED;
            PG8_LDB(B1, 0, 1); PG8_STAGE(PG8_SB(0, 0), b2, voffB);
            PG8_BAR; PG8_WAIT_L(0); PG8_MMA(0, 1, At, B1); PG8_BAR;
            PG8_LDA(At, 0, 1); PG8_STAGE(PG8_SA(0, 0), a2, voffA);
            PG8_BAR; PG8_WAIT_L(0); PG8_MMA(1, 0, At, B0); PG8_BAR; PG8_SCHED;
            PG8_STAGE(PG8_SB(0, 1), b2 + hstep, voffB);
            PG8_WAIT_V(6); PG8_BAR; PG8_MMA(1, 1, At, B1); PG8_BAR;
            PG8_LDB(B0, 1, 0); PG8_SCHED; PG8_LDA(At, 1, 0); PG8_STAGE(PG8_SA(0, 1), a2 + hstep, voffA);
            PG8_WAIT_L(8); PG8_BAR; PG8_WAIT_L(0); PG8_MMA(0, 0, At, B0); PG8_BAR; PG8_SCHED;
            PG8_LDB(B1, 1, 1); PG8_STAGE(PG8_SB(1, 0), b3, voffB);
            PG8_BAR; PG8_WAIT_L(0); PG8_MMA(0, 1, At, B1); PG8_BAR;
            PG8_LDA(At, 1, 1); PG8_STAGE(PG8_SA(1, 0), a3, voffA);
            PG8_BAR; PG8_WAIT_L(0); PG8_MMA(1, 0, At, B0); PG8_BAR; PG8_SCHED;
            PG8_STAGE(PG8_SB(1, 1), b3 + hstep, voffB);
            PG8_WAIT_V(6); PG8_BAR; PG8_MMA(1, 1, At, B1); PG8_BAR;
            }
        }
        if constexpr (ALIGN_EPI) { if (wr == 0) PG8_BAR; }
        if constexpr (!Epi::AFTER_DRAIN) { E(acc, cur, wr, wc, fr, fq); S.done(cur); }
        if (!has_next) break;
#pragma unroll
        for (int a = 0; a < 2; ++a)
#pragma unroll
            for (int b = 0; b < 2; ++b)
#pragma unroll
                for (int m = 0; m < 4; ++m)
#pragma unroll
                    for (int n = 0; n < 2; ++n) acc[a][b][m][n] = (f32x4){0.f, 0.f, 0.f, 0.f};
        cur = nxt; cA = nA; cB = nB; ++ui;
        if constexpr (ALIGN_EPI) { if (wr == 1) PG8_BAR; }
    }
    PG8_WAIT_V(0);
    if constexpr (!ALIGN_EPI) { if (wr == 0) PG8_BAR; }
    PG8_BAR;
    if constexpr (Epi::AFTER_DRAIN) { E.fused(acc, cur, wr, wc, fr, fq, lds, wid, lane); S.done(cur); }
#undef PG8_SA
#undef PG8_SB
#undef PG8_STAGE
#undef PG8_LDA
#undef PG8_LDB
#undef PG8_MMA
#undef PG8_WAIT_V
#undef PG8_WAIT_L
#undef PG8_BAR
#undef PG8_SCHED
}
}

constexpr int DM = 2048, NTOK = 8192, NCTX = 4096, DEPTH = 4, NIN = 34;
constexpr int INW = 3136, INP = 3328;
constexpr int OFF_KV = 512, OFF_KR = 768, OFF_XF = 832, OFF_RKV = 1344, OFF_WLO = 2880, OFF_ALO = 2944, OFF_GLO = 3008;
constexpr int DFF = 5632, UPN = 11264, KVROWS = 9216, LORAN = 2560, QW = 1536;
constexpr float EPS = 1e-6f, GN_EPS = 64e-5f, DECAY_SCALE = 0.6065306597126334f;
enum { I_XP = 0, I_XS, I_CKV, I_CKR, I_ST, I_C, I_CCTX, I_WMOD, I_BMOD, I_GPREMIX, I_GPOSTMIX, I_GPREFFN, I_GPOSTFFN, I_WIN, I_GQ, I_WUQ, I_GKV, I_WUKV,
       I_RCONV, I_RW0, I_RW2, I_RA0, I_RA2, I_RG2, I_RKK, I_RKA, I_RRK, I_GNG, I_GNB, I_WOUT, I_WUP, I_FCONV, I_FCONVB, I_WDOWN };
constexpr size_t OUT_X = 0, OUT_CKV = (size_t)NTOK * DM, OUT_KR = OUT_CKV + (size_t)16 * 4 * 256 * 256, OUT_ST = OUT_KR + (size_t)16 * 4 * 256 * 64, OUT_END = OUT_ST + (size_t)16 * 4 * 2 * 8 * 64 * 64;

constexpr size_t A256(size_t x) { return (x + 255) & ~(size_t)255; }
constexpr size_t WS_CTL = 0, CTL_BYTES = 1u << 20;
constexpr size_t WS_MOD   = WS_CTL + CTL_BYTES;
constexpr size_t WS_ROPE  = WS_MOD + A256((size_t)4 * 5 * 12288 * 4);
constexpr size_t WS_P256  = WS_ROPE + A256((size_t)2 * 1024 * 32 * 4);
constexpr size_t WS_P1024 = WS_P256 + A256((size_t)256 * 512 * 2);
constexpr size_t WS_MBD   = WS_P1024 + A256((size_t)1024 * 2048 * 2);
constexpr size_t WS_WL    = WS_MBD + A256((size_t)1024 * 512 * 2);
constexpr size_t WS_WIN   = WS_WL + A256((size_t)4 * LORAN * 256 * 2);
constexpr size_t WS_WUQ   = WS_WIN + A256((size_t)4 * INP * DM * 2);
constexpr size_t WS_WUKV  = WS_WUQ + A256((size_t)4 * QW * 512 * 2);
constexpr size_t WS_WOUT  = WS_WUKV + A256((size_t)4 * 2048 * 256 * 2);
constexpr size_t WS_WUP   = WS_WOUT + A256((size_t)4 * DM * DM * 2);
constexpr size_t WS_WDN   = WS_WUP + A256((size_t)4 * UPN * DM * 2);
constexpr size_t WS_H     = WS_WDN + A256((size_t)4 * DM * DFF * 2);
constexpr size_t WS_PROJ  = WS_H + A256((size_t)NTOK * DM * 2);
constexpr size_t WS_QN    = WS_PROJ + A256((size_t)NTOK * INP * 4);
constexpr size_t WS_CKVA  = WS_QN + A256((size_t)NTOK * 512 * 2);
constexpr size_t WS_KR    = WS_CKVA + A256((size_t)KVROWS * 256 * 2);
constexpr size_t WS_XF    = WS_KR + A256((size_t)KVROWS * 64 * 2);
constexpr size_t WS_AL    = WS_XF + A256((size_t)NTOK * 512 * 2);
constexpr size_t WS_RC    = WS_AL + A256((size_t)NTOK * 256 * 2);
constexpr size_t WS_KC    = WS_RC + A256((size_t)NTOK * 512 * 4);
constexpr size_t WS_VC    = WS_KC + A256((size_t)NTOK * 512 * 4);
constexpr size_t WS_NK    = WS_VC + A256((size_t)NTOK * 512 * 4);
constexpr size_t WS_Q     = WS_NK + A256((size_t)NTOK * 8 * 4);
constexpr size_t WS_KV    = WS_Q + A256((size_t)NTOK * QW * 2);
constexpr size_t WS_LORA  = WS_KV + A256((size_t)KVROWS * 2048 * 2);
constexpr size_t WS_Y     = WS_LORA + A256((size_t)NTOK * LORAN * 4);
constexpr size_t WS_YF    = WS_Y + A256((size_t)NTOK * 1024 * 2);
constexpr size_t WS_YB    = WS_YF + A256((size_t)NTOK * 512 * 4);
constexpr size_t WS_BON   = WS_YB + A256((size_t)NTOK * 512 * 4);
constexpr size_t WS_MIX   = WS_BON + A256((size_t)2 * NTOK * 8 * 4);
constexpr size_t WS_O     = WS_MIX + A256((size_t)NTOK * DM * 2);
constexpr size_t WS_U     = WS_O + A256((size_t)NTOK * DM * 4);
constexpr size_t WS_ACT   = WS_U + A256((size_t)NTOK * UPN * 2);
constexpr size_t WS_END   = WS_ACT + A256((size_t)NTOK * DFF * 2);
constexpr int CW_TMO = 0, CW_CODE = 1, CW_QUEUE = 64  , CW_BAR = 4096;
constexpr int NPHASES = 2 + 11 * DEPTH;
constexpr int RING_OFF = 0, RING_BYTES = 131072, LDSCTL_OFF = RING_BYTES, MISC_OFF = LDSCTL_OFF + 320, LDS_BYTES = 147456, NWAVES = 8;

#define GAS __attribute__((address_space(1)))
#define LAS __attribute__((address_space(3)))
typedef unsigned short bf16;
typedef unsigned v4u __attribute__((ext_vector_type(4)));
typedef unsigned v2u __attribute__((ext_vector_type(2)));
typedef float f32x4 __attribute__((ext_vector_type(4)));
typedef float f32x2 __attribute__((ext_vector_type(2)));
typedef float f32x16 __attribute__((ext_vector_type(16)));
typedef short bf16x8 __attribute__((ext_vector_type(8)));
typedef short s16x4 __attribute__((ext_vector_type(4)));
typedef GAS unsigned gu32;
#define RLX_AGENT __ATOMIC_RELAXED, __HIP_MEMORY_SCOPE_AGENT
#define LDS_WAIT() asm volatile("s_waitcnt lgkmcnt(0)" ::: "memory")
#define VM_WAIT() asm volatile("s_waitcnt vmcnt(0)" ::: "memory")
#define SBAR() __builtin_amdgcn_sched_barrier(0)
__device__ __forceinline__ unsigned cvtpk(float lo, float hi) { unsigned r; asm volatile("v_cvt_pk_bf16_f32 %0, %1, %2" : "=v"(r) : "v"(lo), "v"(hi)); return r; }
__device__ __forceinline__ bf16 f2bf(float f) { return (bf16)(cvtpk(f, 0.f) & 0xffffu); }
__device__ __forceinline__ float bf2f(short s) { return __uint_as_float(((unsigned)(unsigned short)s) << 16); }
__device__ __forceinline__ float wave_sum(float v) {
#pragma unroll
    for (int o = 1; o < 64; o <<= 1) v += __shfl_xor(v, o);
    return v;
}
template <int CTRL> __device__ __forceinline__ float dpp_mov(float x) { return __int_as_float(__builtin_amdgcn_update_dpp(0, __float_as_int(x), CTRL, 0xf, 0xf, true)); }
__device__ __forceinline__ float allred16(float x) {
    x += dpp_mov<0xB1>(x);
    x += dpp_mov<0x4E>(x);
    x += dpp_mov<0x141>(x);
    x += dpp_mov<0x140>(x);
    return x;
}
__device__ __forceinline__ float sigmoidf_(float x) { return 1.0f / (1.0f + __expf(-x)); }
#define XB_TMO      128
#define XB_XCNT(j)  (256  + 64 * (j))
#define XB_XSUB(j)  (1280 + 64 * (j))
#define XB_XGEN(j)  (2304 + 64 * (j))
#define XB_TOP      3328
#define XB_TOPGEN   3392
#define XCD_BAR_WORDS 3456
#define XB_SPIN_CAP (1u << 18)

__device__ __forceinline__ unsigned xb_ld(unsigned* p)              { return __hip_atomic_load(p, __ATOMIC_RELAXED, __HIP_MEMORY_SCOPE_AGENT); }
__device__ __forceinline__ unsigned xb_add(unsigned* p, unsigned v) { return __hip_atomic_fetch_add(p, v, __ATOMIC_RELAXED, __HIP_MEMORY_SCOPE_AGENT); }
__device__ __forceinline__ unsigned xb_xcc_id() { return (unsigned)__builtin_amdgcn_s_getreg((3 << 11) | 20) & 0xFu; }
#define XB_SPIN(cond, bar) do { unsigned _sp = 0; while (cond) { __builtin_amdgcn_s_sleep(1); \
    if ((++_sp & 255u) == 0u) { if (xb_ld(&(bar)[XB_TMO])) break; if (_sp > XB_SPIN_CAP) { atomicAdd(&(bar)[XB_TMO], 1u); break; } } } } while (0)

struct XcdBarrier {
    unsigned* bar; unsigned x;
    volatile LAS unsigned* st;
};

__device__ __forceinline__ XcdBarrier xcd_barrier_post(unsigned* bar, volatile LAS unsigned* st) {
    XcdBarrier b; b.bar = bar; b.x = xb_xcc_id(); b.st = st;
    if (threadIdx.x == 0) (void)xb_add(&bar[XB_XCNT(b.x)], 1u);
    return b;
}
__device__ __forceinline__ void xcd_barrier_complete(unsigned* bar, unsigned x, unsigned& nloc, unsigned& nx) {
    const unsigned G = gridDim.x * gridDim.y * gridDim.z;
    unsigned sum, cnt, mine, sp = 0u;
    for (;;) {
        sum = 0u; cnt = 0u; mine = 0u;
#pragma unroll
        for (unsigned j = 0; j < 16; ++j) { const unsigned c = xb_ld(&bar[XB_XCNT(j)]); sum += c; cnt += (c > 0u) ? 1u : 0u; mine = (j == x) ? c : mine; }
        if (sum == G) break;
        __builtin_amdgcn_s_sleep(1);
        if ((++sp & 255u) == 0u) { if (xb_ld(&bar[XB_TMO])) break; if (sp > XB_SPIN_CAP) { atomicAdd(&bar[XB_TMO], 1u); break; } }
    }
    nloc = mine > 0u ? mine : 1u; nx = cnt > 0u ? cnt : 1u;
}

__device__ __forceinline__ void xcd_barrier(const XcdBarrier& b) {
    asm volatile("s_waitcnt vmcnt(0)" ::: "memory");
    __syncthreads();
    if (threadIdx.x == 0) {
        unsigned* bar = b.bar;
        __builtin_amdgcn_s_waitcnt(0);
        unsigned nloc = b.st[0], nx = b.st[1];
        if (nloc == 0u) { xcd_barrier_complete(bar, b.x, nloc, nx); b.st[0] = nloc; b.st[1] = nx; }
        const unsigned old = xb_add(&bar[XB_XSUB(b.x)], 1u);
        const unsigned gen = old / nloc;
        if (old + 1u == (gen + 1u) * nloc) {
            __builtin_amdgcn_fence(__ATOMIC_RELEASE, "agent");
            asm volatile("s_waitcnt vmcnt(0)" ::: "memory");
            const unsigned og = xb_add(&bar[XB_TOP], 1u);
            const unsigned tg = og / nx;
            if (og + 1u == (tg + 1u) * nx) xb_add(&bar[XB_TOPGEN], 1u);
            else XB_SPIN(xb_ld(&bar[XB_TOPGEN]) == tg, bar);
            __builtin_amdgcn_fence(__ATOMIC_ACQUIRE, "agent");
            xb_add(&bar[XB_XGEN(b.x)], 1u);
            asm volatile("s_waitcnt vmcnt(0)" ::: "memory");
        } else {
            XB_SPIN(xb_ld(&bar[XB_XGEN(b.x)]) == gen, bar);
            __builtin_amdgcn_fence(__ATOMIC_ACQUIRE, "agent");
            asm volatile("s_waitcnt vmcnt(0)" ::: "memory");
        }
    }
    __syncthreads();
}

struct Frame {
    LAS unsigned char* lds;
    volatile LAS unsigned* MISC;
    gu32* ctl;
    int tid, lane, wave, vcu, G;
    const float* const* in;
    float* out; unsigned char* ws;
};
#define WSP(T, off) ((T*)(F.ws + (off)))

__device__ __forceinline__ void p0_transpose_item(const float* W, int K, int N, bf16* WT, LAS float* scr, int item, int lane) {
    const int nblk = N / 32, kb = item / nblk, nb = item % nblk, k0 = 64 * kb, n0 = 32 * nb;
#pragma unroll 8
    for (int i = 0; i < 32; ++i) { const int kk = 2 * i + (lane >> 5); scr[kk * 33 + (lane & 31)] = W[(size_t)(k0 + kk) * N + n0 + (lane & 31)]; }
    LDS_WAIT(); asm volatile("" ::: "memory");
    const int c = lane & 7;
#pragma unroll
    for (int j = 0; j < 4; ++j) { const int n = (lane >> 3) + 8 * j; const LAS float* s = scr + (8 * c) * 33 + n;
        v4u o; o.x = cvtpk(s[0 * 33], s[1 * 33]); o.y = cvtpk(s[2 * 33], s[3 * 33]); o.z = cvtpk(s[4 * 33], s[5 * 33]); o.w = cvtpk(s[6 * 33], s[7 * 33]);
        *(GAS v4u*)(WT + (size_t)(n0 + n) * K + k0 + 8 * c) = o; }
    LDS_WAIT(); asm volatile("" ::: "memory");
}
__device__ __forceinline__ void p0_prologue(Frame& F) {
    LAS float* scr = (LAS float*)(F.lds + RING_OFF + F.wave * 16384);
    const int gw = F.vcu * NWAVES + F.wave, NGW = F.G * NWAVES;
    constexpr int I_IN = (DM / 64) * (INW / 32), I_UQ = (512 / 64) * (QW / 32), I_UKV = (256 / 64) * (2048 / 32), I_OUT = (DM / 64) * (DM / 32), I_UP = (DM / 64) * (UPN / 32), I_DN = (DFF / 64) * (DM / 32);
    constexpr int I_LAYER = I_IN + I_UQ + I_UKV + I_OUT + I_UP + I_DN;
    for (int it = gw; it < DEPTH * I_LAYER; it += NGW) {
        const int l = it / I_LAYER; int r = it % I_LAYER;
        if (r < I_IN) { p0_transpose_item(F.in[I_WIN] + (size_t)l * DM * INW, DM, INW, WSP(bf16, WS_WIN) + (size_t)l * INP * DM, scr, r, F.lane); continue; } r -= I_IN;
        if (r < I_UQ) { p0_transpose_item(F.in[I_WUQ] + (size_t)l * 512 * QW, 512, QW, WSP(bf16, WS_WUQ) + (size_t)l * QW * 512, scr, r, F.lane); continue; } r -= I_UQ;
        if (r < I_UKV) { p0_transpose_item(F.in[I_WUKV] + (size_t)l * 256 * 2048, 256, 2048, WSP(bf16, WS_WUKV) + (size_t)l * 2048 * 256, scr, r, F.lane); continue; } r -= I_UKV;
        if (r < I_OUT) { p0_transpose_item(F.in[I_WOUT] + (size_t)l * DM * DM, DM, DM, WSP(bf16, WS_WOUT) + (size_t)l * DM * DM, scr, r, F.lane); continue; } r -= I_OUT;
        if (r < I_UP) { p0_transpose_item(F.in[I_WUP] + (size_t)l * DM * UPN, DM, UPN, WSP(bf16, WS_WUP) + (size_t)l * UPN * DM, scr, r, F.lane); continue; } r -= I_UP;
        p0_transpose_item(F.in[I_WDOWN] + (size_t)l * DFF * DM, DFF, DM, WSP(bf16, WS_WDN) + (size_t)l * DM * DFF, scr, r, F.lane);
    }
    const long gt = (long)F.vcu * 512 + F.tid, NGT = (long)F.G * 512;
    for (long i = gt; i < (long)DEPTH * (INP - INW) * DM / 8; i += NGT) { const int l = (int)(i / ((INP - INW) * DM / 8)); const long r = i % ((INP - INW) * DM / 8);
        *(v4u*)(WSP(bf16, WS_WIN) + (size_t)l * INP * DM + (size_t)INW * DM + r * 8) = (v4u){0u, 0u, 0u, 0u}; }
    for (long i = gt; i < (long)DEPTH * LORAN * 256; i += NGT) { const int l = (int)(i / (LORAN * 256)), n = (int)((i / 256) % LORAN), k = (int)(i & 255);
        float v = 0.f;
        if (n < 1024) { if (k < 64) v = F.in[I_RW2][(((size_t)l * 2 + (n >> 9)) * 64 + k) * 512 + (n & 511)]; }
        else if (n < 2048) { if (k >= 64 && k < 128) v = F.in[I_RA2][(((size_t)l * 2 + ((n - 1024) >> 9)) * 64 + (k - 64)) * 512 + (n & 511)]; }
        else { if (k >= 128) v = F.in[I_RG2][((size_t)l * 128 + (k - 128)) * 512 + (n - 2048)]; }
        WSP(bf16, WS_WL)[i] = f2bf(v); }
    for (long i = gt; i < 1024 * 512; i += NGT) { const int n = (int)(i >> 9), k = (int)(i & 511), g = n >> 8, j = n & 255, g2 = k >> 7, c = k & 127;
        float v = 0.f; if (g == g2) { const int m = (c * (j & 127)) & 127; v = (j < 128) ? cospif((float)m * (1.0f / 64.0f)) : sinpif((float)m * (1.0f / 64.0f)); }
        WSP(bf16, WS_MBD)[i] = f2bf(v); }
    for (long i = gt; i < 256 * 512; i += NGT) { const int tp = (int)(i >> 9), t = (int)(i & 511), m = (tp * (t & 255)) & 255; const float sc = 0.005524271728019903f;
        const float v = (t < 256) ? cospif((float)m * (1.0f / 128.0f)) : -sinpif((float)m * (1.0f / 128.0f)); WSP(bf16, WS_P256)[i] = f2bf(v * sc); }
    for (long i = gt; i < 1024 * 2048; i += NGT) { const int tp = (int)(i >> 11), t = (int)(i & 2047), m = (tp * (t & 1023)) & 1023; const float sc = 0.0027621358640099515f;
        const float v = (t < 1024) ? cospif((float)m * (1.0f / 512.0f)) : -sinpif((float)m * (1.0f / 512.0f)); WSP(bf16, WS_P1024)[i] = f2bf(v * sc); }
    for (long i = gt; i < 1024 * 32; i += NGT) { const int t = (int)(i >> 5), ii = (int)(i & 31); const float pos = (ii < 16) ? (float)(t >> 6) : (float)(t & 63);
        const float inv = exp2f(-(float)(ii & 15) * (13.287712379549449f / 16.0f)); const float ang = pos * inv;
        WSP(float, WS_ROPE)[i] = cosf(ang); WSP(float, WS_ROPE)[1024 * 32 + i] = sinf(ang); }
    {
        LAS float* sc = (LAS float*)(F.lds);
        LAS float* red = (LAS float*)(F.lds + 40960);
        bool have = false;
        for (int it = F.vcu; it < DEPTH * 96; it += F.G) {
            if (!have) { __syncthreads();
                for (int i = F.tid; i < 5 * 2048; i += 512) { const int cd = i >> 11, k = i & 2047; const float x = (cd == 0) ? F.in[I_CCTX][k] : F.in[I_C][(cd - 1) * 2048 + k]; sc[i] = x * sigmoidf_(x); }
                __syncthreads(); have = true; }
            const int l = it / 96, ch = it % 96, kh = F.lane >> 5, c4 = F.lane & 31;
            const float* wp = F.in[I_WMOD] + (size_t)l * DM * 12288 + (size_t)ch * 128 + 4 * c4;
            f32x4 a0 = {0.f, 0.f, 0.f, 0.f}, a1 = a0, a2 = a0, a3 = a0, a4 = a0;
#pragma unroll 8
            for (int i = 0; i < 128; ++i) { const int k = 256 * F.wave + 2 * i + kh; const f32x4 wv = *(const f32x4*)(wp + (size_t)k * 12288);
                a0 += wv * sc[k]; a1 += wv * sc[2048 + k]; a2 += wv * sc[4096 + k]; a3 += wv * sc[6144 + k]; a4 += wv * sc[8192 + k]; }
            const int part = F.wave * 2 + kh;
            *(LAS f32x4*)(red + (part * 5 + 0) * 128 + 4 * c4) = a0; *(LAS f32x4*)(red + (part * 5 + 1) * 128 + 4 * c4) = a1; *(LAS f32x4*)(red + (part * 5 + 2) * 128 + 4 * c4) = a2;
            *(LAS f32x4*)(red + (part * 5 + 3) * 128 + 4 * c4) = a3; *(LAS f32x4*)(red + (part * 5 + 4) * 128 + 4 * c4) = a4;
            __syncthreads();
            for (int i = F.tid; i < 640; i += 512) { const int cd = i >> 7, col = i & 127; float s = F.in[I_BMOD][(size_t)l * 12288 + ch * 128 + col];
#pragma unroll
                for (int p = 0; p < 16; ++p) s += red[(p * 5 + cd) * 128 + col];
                WSP(float, WS_MOD)[((size_t)l * 5 + cd) * 12288 + ch * 128 + col] = s; }
            __syncthreads();
        }
    }
}

template <int MODE> __device__ __forceinline__ void norm_phase(Frame& F, int l) {
    LAS float* vA = (LAS float*)(F.lds); LAS float* vB = vA + 2048; LAS float* vC = vB + 2048;
    const float* MOD = WSP(float, WS_MOD);
    const bool doh = (MODE != 2) || (l < DEPTH - 1);
    for (int ch = F.vcu; ch < NTOK / 32; ch += F.G) {
        const int row0 = 32 * ch, cond = row0 < NCTX ? 0 : 1 + ((row0 - NCTX) >> 10);
        __syncthreads();
        { const int col = 4 * F.tid;
          if (MODE != 0) { const float* gate = MOD + ((size_t)l * 5 + cond) * 12288 + (MODE == 1 ? 4096 : 10240) + col; const float* gp = F.in[MODE == 1 ? I_GPOSTMIX : I_GPOSTFFN] + (size_t)l * DM + col;
              *(LAS f32x4*)(vA + col) = *(const f32x4*)gate * *(const f32x4*)gp; }
          if (doh) { const int ln = (MODE == 2) ? l + 1 : l; const float* mb = MOD + ((size_t)ln * 5 + cond) * 12288;
              const float* gpre = F.in[MODE == 1 ? I_GPREFFN : I_GPREMIX] + (size_t)ln * DM + col;
              const float* scp = mb + (MODE == 1 ? 8192 : 2048) + col; const float* shp = mb + (MODE == 1 ? 6144 : 0) + col;
              *(LAS f32x4*)(vB + col) = *(const f32x4*)gpre * (*(const f32x4*)scp + 1.0f); *(LAS f32x4*)(vC + col) = *(const f32x4*)shp; } }
        __syncthreads();
        for (int rr = 0; rr < 4; ++rr) {
            const int row = row0 + 4 * F.wave + rr;
            float* xrow = F.out + OUT_X + (size_t)row * DM;
            f32x4 x[8];
            if (MODE == 0) { const float* src = row < NCTX ? F.in[I_XP] + (size_t)row * DM : F.in[I_XS] + (size_t)(row - NCTX) * DM;
#pragma unroll
                for (int j = 0; j < 8; ++j) x[j] = *(const f32x4*)(src + 4 * F.lane + 256 * j); }
            else { const float* orow = WSP(float, WS_O) + (size_t)row * DM; f32x4 o[8]; float ss = 0.f;
#pragma unroll
                for (int j = 0; j < 8; ++j) { o[j] = *(const f32x4*)(orow + 4 * F.lane + 256 * j); x[j] = *(const f32x4*)(xrow + 4 * F.lane + 256 * j); ss += o[j].x * o[j].x + o[j].y * o[j].y + o[j].z * o[j].z + o[j].w * o[j].w; }
                const float rs = rsqrtf(wave_sum(ss) * (1.0f / DM) + EPS);
#pragma unroll
                for (int j = 0; j < 8; ++j) x[j] += *(const LAS f32x4*)(vA + 4 * F.lane + 256 * j) * (o[j] * rs); }
#pragma unroll
            for (int j = 0; j < 8; ++j) *(f32x4*)(xrow + 4 * F.lane + 256 * j) = x[j];
            if (doh) { float ss = 0.f;
#pragma unroll
                for (int j = 0; j < 8; ++j) ss += x[j].x * x[j].x + x[j].y * x[j].y + x[j].z * x[j].z + x[j].w * x[j].w;
                const float rs = rsqrtf(wave_sum(ss) * (1.0f / DM) + EPS);
                bf16* hrow = WSP(bf16, WS_H) + (size_t)row * DM;
#pragma unroll
                for (int j = 0; j < 8; ++j) { const f32x4 hv = (x[j] * rs) * *(const LAS f32x4*)(vB + 4 * F.lane + 256 * j) + *(const LAS f32x4*)(vC + 4 * F.lane + 256 * j);
                    v2u w; w.x = cvtpk(hv.x, hv.y); w.y = cvtpk(hv.z, hv.w); *(v2u*)(hrow + 4 * F.lane + 256 * j) = w; } }
        }
    }
}

__device__ __forceinline__ int kv_row(int row) { return row < NCTX ? row : NCTX + ((row - NCTX) >> 10) * 1280 + 256 + ((row - NCTX) & 1023); }
__device__ __forceinline__ void prep_phase(Frame& F, int l) {
    const int gw = F.vcu * NWAVES + F.wave, NGW = F.G * NWAVES, lane = F.lane;
    const float* PROJ = WSP(float, WS_PROJ);
    for (int row = gw; row < NTOK; row += NGW) {
        const float* pr = PROJ + (size_t)row * INP;
        const int kvr = kv_row(row);
        { f32x4 q0 = *(const f32x4*)(pr + 4 * lane), q1 = *(const f32x4*)(pr + 256 + 4 * lane);
          float ss = q0.x * q0.x + q0.y * q0.y + q0.z * q0.z + q0.w * q0.w + q1.x * q1.x + q1.y * q1.y + q1.z * q1.z + q1.w * q1.w;
          const float rs = rsqrtf(wave_sum(ss) * (1.0f / 512.0f) + EPS);
          const float* g = F.in[I_GQ] + (size_t)l * 512;
          q0 = q0 * rs * *(const f32x4*)(g + 4 * lane); q1 = q1 * rs * *(const f32x4*)(g + 256 + 4 * lane);
          bf16* qn = WSP(bf16, WS_QN) + (size_t)row * 512;
          v2u w; w.x = cvtpk(q0.x, q0.y); w.y = cvtpk(q0.z, q0.w); *(v2u*)(qn + 4 * lane) = w; w.x = cvtpk(q1.x, q1.y); w.y = cvtpk(q1.z, q1.w); *(v2u*)(qn + 256 + 4 * lane) = w; }
        { f32x4 kv = *(const f32x4*)(pr + OFF_KV + 4 * lane);
          const float rs = rsqrtf(wave_sum(kv.x * kv.x + kv.y * kv.y + kv.z * kv.z + kv.w * kv.w) * (1.0f / 256.0f) + EPS);
          kv = kv * rs * *(const f32x4*)(F.in[I_GKV] + (size_t)l * 256 + 4 * lane);
          v2u w; w.x = cvtpk(kv.x, kv.y); w.y = cvtpk(kv.z, kv.w); *(v2u*)(WSP(bf16, WS_CKVA) + (size_t)kvr * 256 + 4 * lane) = w;
          if (row < NCTX) *(f32x4*)(F.out + OUT_CKV + ((size_t)((row >> 8) * DEPTH + l) * 256 + (row & 255)) * 256 + 4 * lane) = kv; }
        { const float kr = pr[OFF_KR + lane]; float val = kr;
          if (row < NCTX) F.out[OUT_KR + ((size_t)((row >> 8) * DEPTH + l) * 256 + (row & 255)) * 64 + lane] = kr;
          else { const int t = (row - NCTX) & 1023, i = lane & 31; const float c = WSP(float, WS_ROPE)[t * 32 + i], s = WSP(float, WS_ROPE)[1024 * 32 + t * 32 + i];
              const float other = __shfl_xor(kr, 32); val = (lane < 32) ? kr * c - other * s : other * s + kr * c; }
          WSP(bf16, WS_KR)[(size_t)kvr * 64 + lane] = f2bf(val); }
        { bf16* xf = WSP(bf16, WS_XF) + (size_t)row * 512;
#pragma unroll
          for (int j = 0; j < 2; ++j) { const f32x4 v = *(const f32x4*)(pr + OFF_XF + 4 * lane + 256 * j); v2u w; w.x = cvtpk(v.x, v.y); w.y = cvtpk(v.z, v.w); *(v2u*)(xf + 4 * lane + 256 * j) = w; } }
        { bf16* al = WSP(bf16, WS_AL) + (size_t)row * 256;
          al[lane] = f2bf(tanhf(pr[OFF_WLO + lane])); al[64 + lane] = f2bf(pr[OFF_ALO + lane]);
          const f32x2 g = *(const f32x2*)(pr + OFF_GLO + 2 * lane); *(unsigned*)(al + 128 + 2 * lane) = cvtpk(sigmoidf_(g.x), sigmoidf_(g.y)); }
    }
    for (int it = gw; it < (NTOK / 32) * 24; it += NGW) {
        const int chunk = it / 24, grp = it % 24, row0 = 32 * chunk, which = grp >> 3, hh = grp & 7;
        const int s0 = row0 < NCTX ? (row0 & ~255) : NCTX + ((row0 - NCTX) & ~1023), send = s0 + (row0 < NCTX ? 256 : 1024);
        const int ch = 64 * grp + lane, cc = 64 * hh + lane;
        const float* cw = F.in[I_RCONV] + (size_t)l * 3 * 1536;
        const float w0 = cw[ch], w1 = cw[1536 + ch], w2 = cw[3072 + ch];
        const float kk = F.in[I_RKK][(size_t)l * 512 + cc];
        float* dst = WSP(float, which == 0 ? WS_RC : (which == 1 ? WS_KC : WS_VC));
        const float* src = PROJ + OFF_RKV + ch;
        float prev = row0 > s0 ? src[(size_t)(row0 - 1) * INP] : 0.f, cur = src[(size_t)row0 * INP];
#pragma unroll 4
        for (int i = 0; i < 32; ++i) { const int row = row0 + i; const float nxt = (row + 1 < send) ? src[(size_t)(row + 1) * INP] : 0.f;
            const float o = prev * w0 + cur * w1 + nxt * w2; dst[(size_t)row * 512 + cc] = o;
            if (which == 1) { const float kap = o * kk; const float ss = wave_sum(kap * kap); if (lane == 0) WSP(float, WS_NK)[row * 8 + hh] = rsqrtf(ss + EPS); }
            prev = cur; cur = nxt; }
    }
    { const long gt = (long)F.vcu * 512 + F.tid, NGT = (long)F.G * 512;
      for (long i = gt; i < 1024 * 64; i += NGT) { const int r = (int)(i >> 6), c4 = (int)(i & 63) * 4, b = r >> 8, j = r & 255;
          const f32x4 v = *(const f32x4*)(F.in[I_CKV] + (((size_t)b * DEPTH + l) * 256 + j) * 256 + c4); v2u w; w.x = cvtpk(v.x, v.y); w.y = cvtpk(v.z, v.w);
          *(v2u*)(WSP(bf16, WS_CKVA) + (size_t)(NCTX + b * 1280 + j) * 256 + c4) = w; }
      for (long i = gt; i < 1024 * 16; i += NGT) { const int r = (int)(i >> 4), c4 = (int)(i & 15) * 4, b = r >> 8, j = r & 255;
          const f32x4 v = *(const f32x4*)(F.in[I_CKR] + (((size_t)b * DEPTH + l) * 256 + j) * 64 + c4); v2u w; w.x = cvtpk(v.x, v.y); w.y = cvtpk(v.z, v.w);
          *(v2u*)(WSP(bf16, WS_KR) + (size_t)(NCTX + b * 1280 + j) * 64 + c4) = w; } }
}

__device__ __forceinline__ void post_phase(Frame& F, int l) {
    const int gw = F.vcu * NWAVES + F.wave, NGW = F.G * NWAVES, lane = F.lane;
    for (int row = gw; row < NTOK; row += NGW) {
#pragma unroll
        for (int h = 0; h < 8; ++h) { const int c = 64 * h + lane;
            const float y = WSP(float, WS_YF)[(size_t)row * 512 + c] + WSP(float, WS_YB)[(size_t)row * 512 + c];
            const float mu = wave_sum(y) * (1.0f / 64.0f); const float d = y - mu; const float var = wave_sum(d * d) * (1.0f / 64.0f);
            const float yn = d * rsqrtf(var + GN_EPS) * F.in[I_GNG][(size_t)l * 512 + c] + F.in[I_GNB][(size_t)l * 512 + c];
            const float bonus = WSP(float, WS_BON)[(size_t)row * 8 + h] + WSP(float, WS_BON)[(size_t)NTOK * 8 + (size_t)row * 8 + h];
            const float o = (yn + bonus * WSP(float, WS_VC)[(size_t)row * 512 + c]) * WSP(float, WS_LORA)[(size_t)row * LORAN + 2048 + c];
            WSP(bf16, WS_MIX)[(size_t)row * DM + 1536 + c] = f2bf(o); }
    }
}

__device__ __forceinline__ void ffn_act_phase(Frame& F, int l) {
    const int gw = F.vcu * NWAVES + F.wave, NGW = F.G * NWAVES, lane = F.lane;
    const bf16* U = WSP(bf16, WS_U);
    for (int it = gw; it < (NTOK / 32) * 11; it += NGW) {
        const int chunk = it / 11, slab = it % 11, row0 = 32 * chunk, col = 512 * slab + 8 * lane;
        const int s0 = row0 < NCTX ? (row0 & ~255) : NCTX + ((row0 - NCTX) & ~1023), send = s0 + (row0 < NCTX ? 256 : 1024);
        const float* cw = F.in[I_FCONV] + (size_t)l * 3 * UPN; const float* cb = F.in[I_FCONVB] + (size_t)l * UPN;
        float wg[3][8], wv[3][8], bg[8], bv[8];
#pragma unroll
        for (int j = 0; j < 3; ++j)
#pragma unroll
            for (int e = 0; e < 8; ++e) { wg[j][e] = cw[(size_t)j * UPN + col + e]; wv[j][e] = cw[(size_t)j * UPN + DFF + col + e]; }
#pragma unroll
        for (int e = 0; e < 8; ++e) { bg[e] = cb[col + e]; bv[e] = cb[DFF + col + e]; }
        const bf16x8 z8 = {0, 0, 0, 0, 0, 0, 0, 0};
        bf16x8 pg = row0 > s0 ? *(const bf16x8*)(U + (size_t)(row0 - 1) * UPN + col) : z8, pv = row0 > s0 ? *(const bf16x8*)(U + (size_t)(row0 - 1) * UPN + DFF + col) : z8;
        bf16x8 cg = *(const bf16x8*)(U + (size_t)row0 * UPN + col), cv = *(const bf16x8*)(U + (size_t)row0 * UPN + DFF + col);
#pragma unroll 2
        for (int i = 0; i < 32; ++i) { const int row = row0 + i; const bool hn = row + 1 < send;
            const bf16x8 ng = hn ? *(const bf16x8*)(U + (size_t)(row + 1) * UPN + col) : z8, nv = hn ? *(const bf16x8*)(U + (size_t)(row + 1) * UPN + DFF + col) : z8;
            float r[8];
#pragma unroll
            for (int e = 0; e < 8; ++e) { const float g = bf2f(pg[e]) * wg[0][e] + bf2f(cg[e]) * wg[1][e] + bf2f(ng[e]) * wg[2][e] + bg[e];
                const float v = bf2f(pv[e]) * wv[0][e] + bf2f(cv[e]) * wv[1][e] + bf2f(nv[e]) * wv[2][e] + bv[e]; r[e] = g * sigmoidf_(g) * v; }
            v4u w; w.x = cvtpk(r[0], r[1]); w.y = cvtpk(r[2], r[3]); w.z = cvtpk(r[4], r[5]); w.w = cvtpk(r[6], r[7]);
            *(v4u*)(WSP(bf16, WS_ACT) + (size_t)row * DFF + col) = w;
            pg = cg; pv = cv; cg = ng; cv = nv; }
    }
}

__device__ __forceinline__ void scan_unit(Frame& F, int l, int s, int h, int d) {
    const int tid = F.tid, lane = F.lane, wv = F.wave;
    const int T = s < 16 ? 256 : 1024, row0 = s < 16 ? 256 * s : NCTX + 1024 * (s - 16), NCH = T / 32;
    LAS float* SV = (LAS float*)F.lds;
    LAS float* YS = (LAS float*)(F.lds + 98304);
    const int rp = lane >> 4, kq = lane & 15, rowA = 8 * wv + 2 * rp;
    f32x4 st0 = {0.f, 0.f, 0.f, 0.f}, st1 = st0;
    if (s >= 16) { const float* sp = F.in[I_ST] + ((((size_t)(s - 16) * DEPTH + l) * 2 + d) * 8 + h) * 4096 + rowA * 64 + 4 * kq; st0 = *(const f32x4*)sp; st1 = *(const f32x4*)(sp + 64); }
    const int si = tid >> 4, sn = (tid & 15) * 4, cbase = 64 * h + sn;
    const f32x4 w0v = *(const f32x4*)(F.in[I_RW0] + ((size_t)l * 2 + d) * 512 + cbase), a0v = *(const f32x4*)(F.in[I_RA0] + ((size_t)l * 2 + d) * 512 + cbase);
    const f32x4 kkv = *(const f32x4*)(F.in[I_RKK] + (size_t)l * 512 + cbase), kav = *(const f32x4*)(F.in[I_RKA] + (size_t)l * 512 + cbase), rkv = *(const f32x4*)(F.in[I_RRK] + (size_t)l * 512 + cbase);
    float* Yout = WSP(float, d == 0 ? WS_YF : WS_YB); float* BON = WSP(float, WS_BON) + (size_t)d * NTOK * 8;
    const float* RC = WSP(float, WS_RC); const float* KC = WSP(float, WS_KC); const float* VC = WSP(float, WS_VC); const float* NK = WSP(float, WS_NK); const float* LORA = WSP(float, WS_LORA);
    f32x4 gr, gk, gv, gwp, gap; float gnk;
#define SCAN_ROW(c) (row0 + (d == 0 ? 32 * (c) + si : T - 1 - (32 * (c) + si)))
#define SCAN_LOADG(c) do { const size_t row_ = (size_t)SCAN_ROW(c); gr = *(const f32x4*)(RC + row_ * 512 + cbase); gk = *(const f32x4*)(KC + row_ * 512 + cbase); gv = *(const f32x4*)(VC + row_ * 512 + cbase); \
        gwp = *(const f32x4*)(LORA + row_ * LORAN + d * 512 + cbase); gap = *(const f32x4*)(LORA + row_ * LORAN + 1024 + d * 512 + cbase); gnk = NK[row_ * 8 + h]; } while (0)
#define SCAN_WRITES(buf, c) do { const f32x4 kh_ = gk * kkv * gnk; f32x4 w_, a_; \
        _Pragma("unroll") for (int e = 0; e < 4; ++e) { w_[e] = __expf(-DECAY_SCALE * sigmoidf_(w0v[e] + gwp[e])); a_[e] = sigmoidf_(a0v[e] + gap[e]); } \
        const f32x4 b_ = a_ * kh_, kt_ = gk * ((a_ - 1.0f) * kav + 1.0f); const f32x4 bb_ = gr * rkv * kt_; \
        const float bon_ = allred16((bb_.x + bb_.y) + (bb_.z + bb_.w)); if ((tid & 15) == 0) BON[(size_t)SCAN_ROW(c) * 8 + h] = bon_; \
        LAS float* p_ = SV + (buf) * 12288 + si * 384 + sn; *(LAS f32x4*)(p_) = w_; *(LAS f32x4*)(p_ + 64) = kh_; *(LAS f32x4*)(p_ + 128) = b_; *(LAS f32x4*)(p_ + 192) = kt_; \
        *(LAS f32x4*)(p_ + 256) = gr; *(LAS f32x4*)(p_ + 320) = gv; } while (0)
    SCAN_LOADG(0); SCAN_WRITES(0, 0); __syncthreads();
    for (int c = 0; c < NCH; ++c) {
        if (c + 1 < NCH) SCAN_LOADG(c + 1);
        const LAS float* sv = SV + (c & 1) * 12288; LAS float* ys = YS + (c & 1) * 2048;
        f32x4 w4 = *(const LAS f32x4*)(sv + 4 * kq), kh4 = *(const LAS f32x4*)(sv + 64 + 4 * kq), b4 = *(const LAS f32x4*)(sv + 128 + 4 * kq), kt4 = *(const LAS f32x4*)(sv + 192 + 4 * kq), r4 = *(const LAS f32x4*)(sv + 256 + 4 * kq);
        f32x2 v2 = *(const LAS f32x2*)(sv + 320 + rowA);
#pragma unroll 4
        for (int i = 0; i < 32; ++i) {
            const LAS float* pn = sv + ((i + 1) & 31) * 384;
            const f32x4 nw = *(const LAS f32x4*)(pn + 4 * kq), nkh = *(const LAS f32x4*)(pn + 64 + 4 * kq), nb = *(const LAS f32x4*)(pn + 128 + 4 * kq), nkt = *(const LAS f32x4*)(pn + 192 + 4 * kq), nr = *(const LAS f32x4*)(pn + 256 + 4 * kq);
            const f32x2 nv = *(const LAS f32x2*)(pn + 320 + rowA);
            float sk0 = (st0.x * kh4.x + st0.y * kh4.y) + (st0.z * kh4.z + st0.w * kh4.w), sk1 = (st1.x * kh4.x + st1.y * kh4.y) + (st1.z * kh4.z + st1.w * kh4.w);
            sk0 = allred16(sk0); sk1 = allred16(sk1);
            st0 = st0 * w4 - b4 * sk0 + kt4 * v2.x; st1 = st1 * w4 - b4 * sk1 + kt4 * v2.y;
            float y0 = (st0.x * r4.x + st0.y * r4.y) + (st0.z * r4.z + st0.w * r4.w), y1 = (st1.x * r4.x + st1.y * r4.y) + (st1.z * r4.z + st1.w * r4.w);
            y0 = allred16(y0); y1 = allred16(y1);
            if (kq == 0) *(LAS f32x2*)(ys + i * 64 + rowA) = (f32x2){y0, y1};
            w4 = nw; kh4 = nkh; b4 = nb; kt4 = nkt; r4 = nr; v2 = nv;
        }
        if (c + 1 < NCH) SCAN_WRITES((c + 1) & 1, c + 1);
        __syncthreads();
        *(f32x4*)(Yout + (size_t)SCAN_ROW(c) * 512 + cbase) = *(const LAS f32x4*)(ys + si * 64 + sn);
    }
    if (s < 16) { float* op = F.out + OUT_ST + ((((size_t)s * DEPTH + l) * 2 + d) * 8 + h) * 4096 + rowA * 64 + 4 * kq; *(f32x4*)op = st0; *(f32x4*)(op + 64) = st1; }
#undef SCAN_ROW
#undef SCAN_LOADG
#undef SCAN_WRITES
}

constexpr float ATT_SCALE = 0.07216878364870322f;
constexpr float ATT_THR = 8.f;
#define KSWZ(row, colB) ((row) * 256 + ((colB) ^ (((row) & 7) << 4)))
__device__ __forceinline__ int crow(int r, int hi) { return (r & 3) + 8 * (r >> 2) + 4 * hi; }
__device__ __forceinline__ void partialSM(f32x16& p0, f32x16& p1, float& m_reg, float& mn, float& alpha) {
    constexpr float C = ATT_SCALE * 1.4426950408889634f;
    float pmax = p0[0];
#pragma unroll
    for (int r = 1; r < 16; ++r) pmax = fmaxf(pmax, p0[r]);
#pragma unroll
    for (int r = 0; r < 16; ++r) pmax = fmaxf(pmax, p1[r]);
    { auto rr = __builtin_amdgcn_permlane32_swap(__float_as_uint(pmax), __float_as_uint(pmax), false, false); pmax = fmaxf(__uint_as_float(rr[0]), __uint_as_float(rr[1])); }
    if (__builtin_expect(__all(pmax - m_reg <= ATT_THR / ATT_SCALE), 1)) { mn = m_reg; alpha = 1.f; }
    else { mn = fmaxf(m_reg, pmax); alpha = __builtin_amdgcn_exp2f((m_reg - mn) * C); m_reg = mn; }
    const float mnC = -mn * C;
#pragma unroll
    for (int r = 0; r < 16; ++r) p0[r] = __builtin_amdgcn_exp2f(fmaf(p0[r], C, mnC));
#pragma unroll
    for (int r = 0; r < 16; ++r) p1[r] = __builtin_amdgcn_exp2f(fmaf(p1[r], C, mnC));
}
__device__ __forceinline__ void finishSM(f32x16& p0, f32x16& p1, float alpha, float& l_reg, bf16x8& pa0, bf16x8& pa1, bf16x8& pa2, bf16x8& pa3) {
    float ps = 0;
#pragma unroll
    for (int r = 0; r < 16; ++r) ps += p0[r];
#pragma unroll
    for (int r = 0; r < 16; ++r) ps += p1[r];
    { auto rr = __builtin_amdgcn_permlane32_swap(__float_as_uint(ps), __float_as_uint(ps), false, false); ps = __uint_as_float(rr[0]) + __uint_as_float(rr[1]); }
    l_reg = l_reg * alpha + ps;
#define PK4(P, BASE, OUT) do { unsigned a0 = cvtpk(P[BASE + 0], P[BASE + 1]), a1 = cvtpk(P[BASE + 2], P[BASE + 3]);   \
    unsigned b0 = cvtpk(P[BASE + 4], P[BASE + 5]), b1 = cvtpk(P[BASE + 6], P[BASE + 7]);                              \
    auto r0 = __builtin_amdgcn_permlane32_swap(a0, b0, false, false); auto r1 = __builtin_amdgcn_permlane32_swap(a1, b1, false, false); \
    v4u w = {r0[0], r1[0], r0[1], r1[1]}; OUT = *reinterpret_cast<bf16x8*>(&w); } while (0)
    PK4(p0, 0, pa0); PK4(p0, 8, pa1); PK4(p1, 0, pa2); PK4(p1, 8, pa3);
#undef PK4
}
__device__ __forceinline__ int v_st(int k, int c) { const int kk = (k & ~0xC) | ((k & 4) << 1) | ((k & 8) >> 1); return ((kk >> 3) * 4 + (c >> 5)) * 512 + ((kk & 7) * 32 + (c & 31)) * 2; }
__device__ __forceinline__ int v_rd_base(int lane) { return ((lane & 3) << 3) | (((lane >> 2) & 3) << 6) | (((lane >> 4) & 1) << 5) | (((lane >> 5) & 1) << 8); }
constexpr int v_rd_off(int d0, int ks, int half) { return d0 * 512 + ks * 4096 + half * 2048; }
template <int OFF> __device__ __forceinline__ s16x4 tr_read(int vb) { s16x4 r; asm volatile("ds_read_b64_tr_b16 %0, %1 offset:%2" : "=&v"(r) : "v"(vb), "i"(OFF) : "memory"); return r; }
template <int D0> __device__ __forceinline__ void pv_one(f32x16& od, int vb, bf16x8 pa0, bf16x8 pa1, bf16x8 pa2, bf16x8 pa3) {
    const s16x4 l0 = tr_read<v_rd_off(D0, 0, 0)>(vb), h0 = tr_read<v_rd_off(D0, 0, 1)>(vb), l1 = tr_read<v_rd_off(D0, 1, 0)>(vb), h1 = tr_read<v_rd_off(D0, 1, 1)>(vb);
    const s16x4 l2 = tr_read<v_rd_off(D0, 2, 0)>(vb), h2 = tr_read<v_rd_off(D0, 2, 1)>(vb), l3 = tr_read<v_rd_off(D0, 3, 0)>(vb), h3 = tr_read<v_rd_off(D0, 3, 1)>(vb);
    asm volatile("s_waitcnt lgkmcnt(0)" ::: "memory"); SBAR();
#define PK(L, H) (bf16x8){L[0], L[1], L[2], L[3], H[0], H[1], H[2], H[3]}
    od = __builtin_amdgcn_mfma_f32_32x32x16_bf16(pa0, PK(l0, h0), od, 0, 0, 0);
    od = __builtin_amdgcn_mfma_f32_32x32x16_bf16(pa1, PK(l1, h1), od, 0, 0, 0);
    od = __builtin_amdgcn_mfma_f32_32x32x16_bf16(pa2, PK(l2, h2), od, 0, 0, 0);
    od = __builtin_amdgcn_mfma_f32_32x32x16_bf16(pa3, PK(l3, h3), od, 0, 0, 0);
#undef PK
}
__device__ __forceinline__ void pv_d0(f32x16* o, int vb, bf16x8 pa0, bf16x8 pa1, bf16x8 pa2, bf16x8 pa3) {
    pv_one<0>(o[0], vb, pa0, pa1, pa2, pa3); pv_one<1>(o[1], vb, pa0, pa1, pa2, pa3); pv_one<2>(o[2], vb, pa0, pa1, pa2, pa3); pv_one<3>(o[3], vb, pa0, pa1, pa2, pa3);
}
__device__ __forceinline__ bf16x8 pack8(const float* x) { v4u w = {cvtpk(x[0], x[1]), cvtpk(x[2], x[3]), cvtpk(x[4], x[5]), cvtpk(x[6], x[7])}; return *reinterpret_cast<bf16x8*>(&w); }

#define GLDS16(gp, lp) __builtin_amdgcn_global_load_lds((const unsigned*)(gp), (LAS unsigned*)(lp), 16, 0, 0)
constexpr int AT_BUF = 40960;
__device__ __forceinline__ void attn_unit(Frame& F, int s, int h, int qb) {
    const int wid = F.wave, lane = F.lane, r32 = lane & 31, hi = lane >> 5;
    const int grow0 = (s < 16 ? 256 * s : NCTX + 1024 * (s - 16)) + 256 * qb;
    const int kvr0 = s < 16 ? 256 * s : NCTX + 1280 * (s - 16), NT = s < 16 ? 4 : 20;
    LAS char* L0 = (LAS char*)F.lds;
    LAS float* wsx = (LAS float*)(L0 + 2 * AT_BUF) + wid * 64; LAS float* li_l = wsx; LAS float* al_l = wsx + 32;
    bf16x8 qr[12];
    { const bf16* Qw = WSP(bf16, WS_Q) + (size_t)(grow0 + wid * 32 + r32) * QW + h * 192 + hi * 8;
#pragma unroll
      for (int d0 = 0; d0 < 12; ++d0) qr[d0] = *(const bf16x8*)(Qw + d0 * 16); }
    if (s >= 16) {
        const int t = 256 * qb + wid * 32 + r32; const float* ct = WSP(float, WS_ROPE) + t * 32; const float* stb = ct + 1024 * 32;
#pragma unroll
        for (int pr = 0; pr < 2; ++pr) { const int ib = 16 * pr + 8 * hi; float n1[8], n2[8];
#pragma unroll
            for (int j = 0; j < 8; ++j) { const float c = ct[ib + j], sn = stb[ib + j], x1 = bf2f(qr[8 + pr][j]), x2 = bf2f(qr[10 + pr][j]); n1[j] = x1 * c - x2 * sn; n2[j] = x1 * sn + x2 * c; }
            qr[8 + pr] = pack8(n1); qr[10 + pr] = pack8(n2); }
    }
    const bf16* KVb = WSP(bf16, WS_KV) + (size_t)kvr0 * 2048 + h * 256; const bf16* KRb = WSP(bf16, WS_KR) + (size_t)kvr0 * 64;
    int okn[2], ov[2], okr;
#pragma unroll
    for (int j = 0; j < 2; ++j) { const int p = 2 * wid + j;
        { const int row = 4 * p + (lane >> 4), ch = (lane & 15) ^ (row & 7); okn[j] = row * 2048 + 8 * ch; }
        { const int st = 2 * p + (lane >> 5), kk = 8 * (st >> 2) + ((lane & 31) >> 2), k = (kk & ~0xC) | ((kk & 4) << 1) | ((kk & 8) >> 1), col = 32 * (st & 3) + 8 * (lane & 3); ov[j] = k * 2048 + 128 + col; } }
    { const int row = 8 * wid + (lane >> 3), ch = (lane & 7) ^ ((row >> 1) & 7); okr = row * 64 + 8 * ch; }
#define AT_ISSUE(kt, b) do { LAS char* B_ = L0 + (b) * AT_BUF; const bf16* kv_ = KVb + (size_t)(kt) * (64 * 2048); \
        GLDS16(kv_ + ov[0], B_ + (2 * wid) * 1024); GLDS16(kv_ + ov[1], B_ + (2 * wid + 1) * 1024); \
        GLDS16(kv_ + okn[0], B_ + 16384 + (2 * wid) * 1024); GLDS16(kv_ + okn[1], B_ + 16384 + (2 * wid + 1) * 1024); \
        GLDS16(KRb + (size_t)(kt) * (64 * 64) + okr, B_ + 32768 + wid * 1024); } while (0)
    const int vb0 = (int)(unsigned)(size_t)L0 + v_rd_base(lane);
    float m_reg = -1e30f, l_reg = 0.f; f32x16 o[4];
#pragma unroll
    for (int d = 0; d < 4; ++d)
#pragma unroll
        for (int r = 0; r < 16; ++r) o[d][r] = 0.f;
    AT_ISSUE(0, 0);
    for (int kt = 0; kt < NT; ++kt) {
        VM_WAIT(); __syncthreads();
        if (kt + 1 < NT) AT_ISSUE(kt + 1, (kt + 1) & 1);
        const LAS char* Kn_lds = L0 + (kt & 1) * AT_BUF + 16384; const LAS char* Kr_lds = L0 + (kt & 1) * AT_BUF + 32768;
        f32x16 p0, p1;
#pragma unroll
        for (int r = 0; r < 16; ++r) { p0[r] = 0.f; p1[r] = 0.f; }
#pragma unroll
        for (int d0 = 0; d0 < 8; ++d0) { const int cb = (d0 * 16 + hi * 8) * 2;
            const bf16x8 b0 = *(const LAS bf16x8*)(Kn_lds + KSWZ(r32, cb)), b1 = *(const LAS bf16x8*)(Kn_lds + KSWZ(32 + r32, cb));
            p0 = __builtin_amdgcn_mfma_f32_32x32x16_bf16(b0, qr[d0], p0, 0, 0, 0); p1 = __builtin_amdgcn_mfma_f32_32x32x16_bf16(b1, qr[d0], p1, 0, 0, 0);
            if ((d0 & 3) == 3) SBAR(); }
#pragma unroll
        for (int d0 = 0; d0 < 4; ++d0) { const int ko = r32 * 128 + (((2 * d0 + hi) ^ ((r32 >> 1) & 7)) << 4);
            const bf16x8 b0 = *(const LAS bf16x8*)(Kr_lds + ko), b1 = *(const LAS bf16x8*)(Kr_lds + 32 * 128 + ko);
            p0 = __builtin_amdgcn_mfma_f32_32x32x16_bf16(b0, qr[8 + d0], p0, 0, 0, 0); p1 = __builtin_amdgcn_mfma_f32_32x32x16_bf16(b1, qr[8 + d0], p1, 0, 0, 0); }
        SBAR();
        float mn, alpha; bf16x8 pa0, pa1, pa2, pa3;
        partialSM(p0, p1, m_reg, mn, alpha);
        if (__any(alpha < 1.f)) { if (hi == 0) al_l[r32] = alpha; LDS_WAIT();
#pragma unroll
            for (int d = 0; d < 4; ++d)
#pragma unroll
                for (int r = 0; r < 16; ++r) o[d][r] *= al_l[crow(r, hi)]; }
        finishSM(p0, p1, alpha, l_reg, pa0, pa1, pa2, pa3); SBAR();
        pv_d0(o, vb0 + (kt & 1) * AT_BUF, pa0, pa1, pa2, pa3);
    }
    if (hi == 0) li_l[r32] = l_reg; LDS_WAIT();
    bf16* Ow = WSP(bf16, WS_MIX) + (size_t)(grow0 + wid * 32) * DM + h * 128 + r32;
#pragma unroll
    for (int r = 0; r < 16; ++r) { const int orow = crow(r, hi); const float rl = __builtin_amdgcn_rcpf(li_l[orow]);
#pragma unroll
        for (int d0 = 0; d0 < 4; ++d0) Ow[(size_t)orow * DM + d0 * 32] = f2bf(o[d0][r] * rl); }
#undef AT_ISSUE
}

__device__ __forceinline__ void four_unit(Frame& F, int s, int g, int ob) {
    const int wid = F.wave, lane = F.lane, r32 = lane & 31, hi = lane >> 5;
    const int T = s < 16 ? 256 : 1024, row0 = s < 16 ? 256 * s : NCTX + 1024 * (s - 16), NTH = T / 64, NT = 2 * NTH, ldp = 2 * T;
    LAS char* L0 = (LAS char*)F.lds;
    const bf16* Pw = (s < 16 ? WSP(bf16, WS_P256) : WSP(bf16, WS_P1024)) + (size_t)(256 * ob + wid * 32 + r32) * ldp + hi * 8;
    const bf16* Y = WSP(bf16, WS_Y) + (size_t)row0 * 1024 + g * 256;
    int ov[2];
#pragma unroll
    for (int j = 0; j < 2; ++j) { const int p = 2 * wid + j, st = 2 * p + (lane >> 5), kk = 8 * (st >> 2) + ((lane & 31) >> 2), k = (kk & ~0xC) | ((kk & 4) << 1) | ((kk & 8) >> 1), col = 32 * (st & 3) + 8 * (lane & 3); ov[j] = k * 1024 + col; }
    const int vb0 = (int)(unsigned)(size_t)L0 + v_rd_base(lane);
    bf16x8 na0, na1, na2, na3;
#define FO_ISSUE(kt, b) do { const int part_ = (kt) >= NTH ? 1 : 0; const bf16* yp_ = Y + (size_t)(64 * ((kt) - part_ * NTH)) * 1024 + part_ * 128; \
        GLDS16(yp_ + ov[0], L0 + (b) * 16384 + (2 * wid) * 1024); GLDS16(yp_ + ov[1], L0 + (b) * 16384 + (2 * wid + 1) * 1024); } while (0)
#define FO_LOADP(kt) do { na0 = *(const bf16x8*)(Pw + 64 * (kt)); na1 = *(const bf16x8*)(Pw + 64 * (kt) + 16); na2 = *(const bf16x8*)(Pw + 64 * (kt) + 32); na3 = *(const bf16x8*)(Pw + 64 * (kt) + 48); } while (0)
    f32x16 o[4];
#pragma unroll
    for (int d = 0; d < 4; ++d)
#pragma unroll
        for (int r = 0; r < 16; ++r) o[d][r] = 0.f;
    FO_ISSUE(0, 0); FO_LOADP(0);
    for (int kt = 0; kt < NT; ++kt) {
        VM_WAIT(); __syncthreads();
        const bf16x8 pa0 = na0, pa1 = na1, pa2 = na2, pa3 = na3;
        if (kt + 1 < NT) { FO_ISSUE(kt + 1, (kt + 1) & 1); FO_LOADP(kt + 1); }
        pv_d0(o, vb0 + (kt & 1) * 16384, pa0, pa1, pa2, pa3);
    }
    bf16* Ow = WSP(bf16, WS_MIX) + (size_t)(row0 + 256 * ob + wid * 32) * DM + 1024 + g * 128 + r32;
#pragma unroll
    for (int r = 0; r < 16; ++r) { const int orow = crow(r, hi);
#pragma unroll
        for (int d0 = 0; d0 < 4; ++d0) Ow[(size_t)orow * DM + d0 * 32] = f2bf(o[d0][r]); }
#undef FO_ISSUE
#undef FO_LOADP
}

constexpr int NUNITS = 704;
__device__ __forceinline__ void mixer_phase(Frame& F, int l) {
    gu32* ctr = F.ctl + CW_QUEUE + 64 * l;
    for (;;) {
        __syncthreads();
        if (F.tid == 0) F.MISC[0] = __hip_atomic_fetch_add(ctr, 1u, RLX_AGENT);
        __syncthreads();
        const int u = (int)F.MISC[0];
        if (u >= NUNITS) break;
        int ty, a, b, c;
        if (u < 64) { ty = 0; a = 16 + (u >> 4); b = (u & 15) >> 1; c = u & 1; }
        else if (u < 192) { const int i = u - 64; ty = 1; a = 16 + (i >> 5); b = (i >> 2) & 7; c = i & 3; }
        else if (u < 256) { const int i = u - 192; ty = 2; a = 16 + (i >> 4); b = (i >> 2) & 3; c = i & 3; }
        else if (u < 512) { const int i = u - 256; ty = 0; a = i >> 4; b = (i & 15) >> 1; c = i & 1; }
        else if (u < 640) { const int i = u - 512; ty = 1; a = i >> 3; b = i & 7; c = 0; }
        else { const int i = u - 640; ty = 2; a = i >> 2; b = i & 3; c = 0; }
        { int t_ = threadIdx.x; asm volatile("" : "+v"(t_)); F.tid = t_; F.lane = t_ & 63; F.wave = __builtin_amdgcn_readfirstlane(t_ >> 6); }
        if (ty == 0) scan_unit(F, l, a, b, c); else if (ty == 1) attn_unit(F, a, b, c); else four_unit(F, a, b, c);
    }
}

#ifndef MK_MODE
#define MK_MODE 0
#endif
struct Args { const float* in[NIN]; float* out; unsigned char* ws; int ph_lo, ph_hi, li, pad; };
__global__ void __launch_bounds__(NWAVES * 64, 2) mk_fwd(Args args) {
    extern __shared__ __attribute__((aligned(16))) unsigned char lds_raw[];
    Frame F;
    F.lds = (LAS unsigned char*)lds_raw;
    F.MISC = (volatile LAS unsigned*)(F.lds + MISC_OFF);
    F.tid = threadIdx.x; F.lane = F.tid & 63; F.wave = __builtin_amdgcn_readfirstlane(F.tid >> 6);
    F.G = gridDim.x; { const int bx = blockIdx.x; F.vcu = (F.G % 8 == 0) ? (bx % 8) * (F.G / 8) + bx / 8 : bx; }
    F.in = args.in; F.out = args.out; F.ws = args.ws; F.ctl = (gu32*)(args.ws + WS_CTL);
    for (int u = F.tid; u < (LDS_BYTES - LDSCTL_OFF) / 4; u += NWAVES * 64) ((LAS unsigned*)(F.lds + LDSCTL_OFF))[u] = 0u;
    __syncthreads();
    const int lo = args.ph_lo, hi = args.ph_hi;
    XcdBarrier bar; bar.bar = (unsigned*)(F.ctl + CW_BAR) + args.li * XCD_BAR_WORDS; bar.x = 0; bar.st = nullptr;
    if (hi - lo > 1) bar = xcd_barrier_post((unsigned*)(F.ctl + CW_BAR) + args.li * XCD_BAR_WORDS, F.MISC + 8);
#ifdef ONLY
#define KIND_ON(x) ((x) == ONLY)
#else
#define KIND_ON(x) true
#endif
#define IN(k) (lo <= (k) && (k) < hi)
#define RELANE() do { int t_ = threadIdx.x; asm volatile("" : "+v"(t_)); F.tid = t_; F.lane = t_ & 63; F.wave = __builtin_amdgcn_readfirstlane(t_ >> 6); } while (0)
#define SEAM(k) do { if (IN(k) && IN((k) + 1)) xcd_barrier(bar); } while (0)
    const int cb = (int)blockIdx.x;

    if (KIND_ON(0) && IN(0)) { RELANE(); p0_prologue(F); SEAM(0); }
    if (KIND_ON(1) && IN(1)) { RELANE(); norm_phase<0>(F, 0); SEAM(1); }
    for (int l = 0; l < DEPTH; ++l) {
        const int pb = 2 + 11 * l;
        if (KIND_ON(2) && IN(pb + 0)) {
            pg8::Gemm g{WSP(bf16, WS_H), WSP(bf16, WS_WIN) + (size_t)l * INP * DM, NTOK, INP, DM}; pg8::StaticOrder S; S.init(NTOK, INP, F.G, cb);
            pg8::EpiAny E{(void*)WSP(float, WS_PROJ), INP, 1};
            pg8::gemm_phase<pg8::EpiAny, pg8::StaticOrder, true, true>(F.lds + RING_OFF, g, S, E);
            SEAM(pb + 0);
        }
        if (KIND_ON(3) && IN(pb + 1)) { RELANE(); prep_phase(F, l); SEAM(pb + 1); }
        if (KIND_ON(4) && IN(pb + 2)) {
            for (int gi = 0; gi < 4; ++gi) {
                const bf16* A_; const bf16* B_; void* O_; int M_, N_, K_, f_, rot_;
                if (gi == 0) { A_ = WSP(bf16, WS_QN); B_ = WSP(bf16, WS_WUQ) + (size_t)l * QW * 512; O_ = WSP(bf16, WS_Q); M_ = NTOK; N_ = QW; K_ = 512; f_ = 0; rot_ = 0; }
                else if (gi == 1) { A_ = WSP(bf16, WS_XF); B_ = WSP(bf16, WS_MBD); O_ = WSP(bf16, WS_Y); M_ = NTOK; N_ = 1024; K_ = 512; f_ = 0; rot_ = 192; }
                else if (gi == 2) { A_ = WSP(bf16, WS_CKVA); B_ = WSP(bf16, WS_WUKV) + (size_t)l * 2048 * 256; O_ = WSP(bf16, WS_KV); M_ = KVROWS; N_ = 2048; K_ = 256; f_ = 0; rot_ = 64; }
                else { A_ = WSP(bf16, WS_AL); B_ = WSP(bf16, WS_WL) + (size_t)l * LORAN * 256; O_ = WSP(float, WS_LORA); M_ = NTOK; N_ = LORAN; K_ = 256; f_ = 1; rot_ = 96; }
                pg8::Gemm g{A_, B_, M_, N_, K_}; pg8::StaticOrder S; S.init(M_, N_, F.G, (cb + F.G - rot_ % F.G) % F.G);
                pg8::EpiAny E{O_, N_, f_};
                pg8::gemm_phase<pg8::EpiAny, pg8::StaticOrder, true, true>(F.lds + RING_OFF, g, S, E);
            }
            SEAM(pb + 2);
        }
        if (KIND_ON(5) && IN(pb + 3)) { RELANE(); mixer_phase(F, l); SEAM(pb + 3); }
        if (KIND_ON(6) && IN(pb + 4)) { RELANE(); post_phase(F, l); SEAM(pb + 4); }
        if (KIND_ON(7) && IN(pb + 5)) {
            pg8::Gemm g{WSP(bf16, WS_MIX), WSP(bf16, WS_WOUT) + (size_t)l * DM * DM, NTOK, DM, DM}; pg8::StaticOrder S; S.init(NTOK, DM, F.G, cb);
            pg8::EpiAny E{(void*)WSP(float, WS_O), DM, 1};
            pg8::gemm_phase<pg8::EpiAny, pg8::StaticOrder, true, true>(F.lds + RING_OFF, g, S, E);
            SEAM(pb + 5);
        }
        if (KIND_ON(8) && IN(pb + 6)) { RELANE(); norm_phase<1>(F, l); SEAM(pb + 6); }
        if (KIND_ON(9) && IN(pb + 7)) {
            pg8::Gemm g{WSP(bf16, WS_H), WSP(bf16, WS_WUP) + (size_t)l * UPN * DM, NTOK, UPN, DM}; pg8::StaticOrder S; S.init(NTOK, UPN, F.G, cb);
            pg8::EpiAny E{(void*)WSP(bf16, WS_U), UPN, 0};
            pg8::gemm_phase<pg8::EpiAny, pg8::StaticOrder, true, true>(F.lds + RING_OFF, g, S, E);
            SEAM(pb + 7);
        }
        if (KIND_ON(10) && IN(pb + 8)) { RELANE(); ffn_act_phase(F, l); SEAM(pb + 8); }
        if (KIND_ON(11) && IN(pb + 9)) {
            pg8::Gemm g{WSP(bf16, WS_ACT), WSP(bf16, WS_WDN) + (size_t)l * DM * DFF, NTOK, DM, DFF}; pg8::StaticOrder S; S.init(NTOK, DM, F.G, cb);
            pg8::EpiAny E{(void*)WSP(float, WS_O), DM, 1};
            pg8::gemm_phase<pg8::EpiAny, pg8::StaticOrder, true, true>(F.lds + RING_OFF, g, S, E);
            SEAM(pb + 9);
        }
        if (KIND_ON(12) && IN(pb + 10)) { RELANE(); norm_phase<2>(F, l); SEAM(pb + 10); }
    }
#undef IN
#undef SEAM
}

extern "C" void kernel_launch(void* const* d_in, const int* in_sizes, int n_in, void* d_out, int out_size, void* d_ws, size_t ws_size, hipStream_t stream) {
    static int grid = 0;
    if (grid == 0) {
        if (n_in != NIN || (size_t)out_size != OUT_END || ws_size < WS_END) { fprintf(stderr, "kernel_launch: built for %d inputs, %zu outputs, >= %zu bytes of workspace; got n_in %d, out %d, ws %zu; nothing launched\n", NIN, (size_t)OUT_END, (size_t)WS_END, n_in, out_size, ws_size); grid = -1; return; }
        int dev = 0, cus = 0, per_cu = 0;
        if (hipGetDevice(&dev) != hipSuccess || hipDeviceGetAttribute(&cus, hipDeviceAttributeMultiprocessorCount, dev) != hipSuccess) { fprintf(stderr, "kernel_launch: device query failed\n"); grid = -1; return; }
        if (hipFuncSetAttribute((const void*)mk_fwd, hipFuncAttributeMaxDynamicSharedMemorySize, LDS_BYTES) != hipSuccess) { fprintf(stderr, "kernel_launch: hipFuncSetAttribute failed\n"); grid = -1; return; }
        if (hipOccupancyMaxActiveBlocksPerMultiprocessor(&per_cu, (const void*)mk_fwd, NWAVES * 64, LDS_BYTES) != hipSuccess || per_cu < 1)
            fprintf(stderr, "kernel_launch: note: occupancy query reports %d workgroups per CU\n", per_cu);
        (void)hipGetLastError();
        grid = cus;
    }
    if (grid < 0) return;
    if (hipMemsetAsync((char*)d_ws + WS_CTL, 0, CTL_BYTES, stream) != hipSuccess) { fprintf(stderr, "kernel_launch: memset failed\n"); return; }
    Args a{};
    for (int i = 0; i < NIN; ++i) a.in[i] = (const float*)d_in[i];
    a.out = (float*)d_out; a.ws = (unsigned char*)d_ws; a.pad = 0;
#if MK_MODE == 1
    const int nl = 1; const int cuts[2] = {0, NPHASES};
#else
    const int nl = NPHASES; int cuts[NPHASES + 1]; for (int i = 0; i <= NPHASES; ++i) cuts[i] = i;
#endif
    for (int li = 0; li < nl; ++li) {
        a.ph_lo = cuts[li]; a.ph_hi = cuts[li + 1]; a.li = li;
        hipLaunchKernelGGL(mk_fwd, dim3(grid), dim3(NWAVES * 64), LDS_BYTES, stream, a);
        const hipError_t le = hipPeekAtLastError();
        if (le != hipSuccess) { fprintf(stderr, "kernel_launch: launch %d failed: %s\n", li, hipGetErrorName(le)); break; }
    }
}
```

```cpp
#include <hip/hip_runtime.h>
#include <cstdio>
#include <cstdint>
namespace pg8 {
#define PG8_LAS __attribute__((address_space(3)))
typedef unsigned short bf16_t;
typedef short bf16x8 __attribute__((ext_vector_type(8)));
typedef float f32x4 __attribute__((ext_vector_type(4)));
typedef unsigned u32x4 __attribute__((ext_vector_type(4)));
constexpr int BM = 256, BK = 64, HALF = 128, HTB = HALF * BK * 2  , STAGE_BYTES = 8 * HTB, NXCD = 8, WGM = 8;

__host__ __device__ __forceinline__ int lds_byte(int r, int c) { const int st = (r >> 4) * 2 + (c >> 5), rr = r & 15, cc = c & 31, ob = rr * 64 + cc * 2; return st * 1024 + (ob ^ (((ob >> 9) & 1) << 5)); }
__host__ __device__ __forceinline__ void stage_rc(int b, int& R, int& C) { const int st = b / 1024, sb = b % 1024, swz = sb ^ (((sb >> 9) & 1) << 5); R = (st >> 1) * 16 + swz / 64; C = (st & 1) * 32 + (swz % 64) / 2; }
__host__ __device__ __forceinline__ int perm32(int rho) { const int n = rho >> 4, i = rho & 15; return 8 * (i >> 2) + 4 * n + (i & 3); }

struct Unit { int pm, pn; };
struct Gemm { const bf16_t* A; const bf16_t* Bt; int M, N, K; };

struct StaticOrder {
    int nM, nN, nwg, G, c;
    __host__ __device__ void init(int M, int N, int G_, int c_) { nM = M / BM; nN = N / BM; nwg = nM * nN; G = G_; c = c_; }
    __host__ __device__ bool next(int i, Unit& u) const {
        const long L = (long)i * G + c; if (L >= nwg) return false;
        int wgid = (int)L; { const int q = nwg / NXCD, r = nwg % NXCD, xcd = wgid % NXCD, off = wgid / NXCD; wgid = (xcd < r ? xcd * (q + 1) : r * (q + 1) + (xcd - r) * q) + off; }
        const int nig = WGM * nN, gid = wgid / nig, fm = gid * WGM, gsz = (nM - fm) < WGM ? (nM - fm) : WGM;
        u.pm = fm + ((wgid % nig) % gsz); u.pn = (wgid % nig) / gsz; return true;
    }
    __device__ __forceinline__ void a_ready(const Unit&) const {}
    __device__ __forceinline__ void done(const Unit&) const {}
};

__device__ __forceinline__ unsigned cvt_pk_bf16(float lo, float hi) { unsigned r; asm volatile("v_cvt_pk_bf16_f32 %0, %1, %2" : "=v"(r) : "v"(lo), "v"(hi)); return r; }
typedef float f32x2 __attribute__((ext_vector_type(2)));
struct EpiF32 {
    static constexpr bool PERM = false, AFTER_DRAIN = false;
    float* C; int ldc; const float* bias;
    __device__ __forceinline__ void operator()(const f32x4 (&acc)[2][2][4][2], const Unit& u, int wr, int wc, int fr, int fq) const {
        const int row0 = u.pm * BM + wr * 64 + fr, col0 = u.pn * BM + wc * 32 + 4 * fq;
        f32x4 bv[2][2];
#pragma unroll
        for (int bj = 0; bj < 2; ++bj)
#pragma unroll
            for (int n = 0; n < 2; ++n) bv[bj][n] = bias ? *(const f32x4*)(bias + col0 + bj * HALF + n * 16) : (f32x4){0.f, 0.f, 0.f, 0.f};
#pragma unroll
        for (int ai = 0; ai < 2; ++ai)
#pragma unroll
            for (int m = 0; m < 4; ++m) { float* rowp = C + (size_t)(row0 + ai * HALF + m * 16) * ldc + col0;
#pragma unroll
                for (int bj = 0; bj < 2; ++bj)
#pragma unroll
                    for (int n = 0; n < 2; ++n) *(f32x4*)(rowp + bj * HALF + n * 16) = acc[ai][bj][m][n] + bv[bj][n]; }
    }
};
struct EpiAny {
    static constexpr bool PERM = true, AFTER_DRAIN = false;
    void* O; int ldc; int f32;
    __device__ __forceinline__ void operator()(const f32x4 (&acc)[2][2][4][2], const Unit& u, int wr, int wc, int fr, int fq) const {
        const int row0 = u.pm * BM + wr * 64 + fr, col0 = u.pn * BM + wc * 32 + 8 * fq;
        if (f32) {
#pragma unroll
            for (int ai = 0; ai < 2; ++ai)
#pragma unroll
                for (int m = 0; m < 4; ++m) { float* rowp = (float*)O + (size_t)(row0 + ai * HALF + m * 16) * ldc + col0;
#pragma unroll
                    for (int bj = 0; bj < 2; ++bj) { *(f32x4*)(rowp + bj * HALF) = acc[ai][bj][m][0]; *(f32x4*)(rowp + bj * HALF + 4) = acc[ai][bj][m][1]; } }
        } else {
#pragma unroll
            for (int ai = 0; ai < 2; ++ai)
#pragma unroll
                for (int m = 0; m < 4; ++m) { bf16_t* rowp = (bf16_t*)O + (size_t)(row0 + ai * HALF + m * 16) * ldc + col0;
#pragma unroll
                    for (int bj = 0; bj < 2; ++bj) { const f32x4 v0 = acc[ai][bj][m][0], v1 = acc[ai][bj][m][1];
                        u32x4 w; w.x = cvt_pk_bf16(v0[0], v0[1]); w.y = cvt_pk_bf16(v0[2], v0[3]); w.z = cvt_pk_bf16(v1[0], v1[1]); w.w = cvt_pk_bf16(v1[2], v1[3]);
                        *(u32x4*)(rowp + bj * HALF) = w; } }
        }
    }
};
template <class Epi, class Sched, bool ALIGN_EPI = false, bool SP2 = false>
__device__ __forceinline__ void gemm_phase(PG8_LAS unsigned char* lds, const Gemm g, const Sched& S, const Epi& E) {
    int tid_ = threadIdx.x; asm volatile("" : "+v"(tid_));
    const int tid = tid_, wid = __builtin_amdgcn_readfirstlane(tid >> 6), lane = tid & 63, wr = wid >> 2, wc = wid & 3, fr = lane & 15, fq = lane >> 4;
    const int K = g.K, nt = K / BK;
    unsigned voffA[2], voffB[2];
#pragma unroll
    for (int i = 0; i < 2; ++i) { int R, C; stage_rc(tid * 16 + i * 8192, R, C); const int Rb = Epi::PERM ? ((R & ~31) + perm32(R & 31)) : R;
        voffA[i] = (unsigned)(R * K + C) * 2u; voffB[i] = (unsigned)(Rb * K + C) * 2u; }
    const size_t kstep = (size_t)(BK * 2);
    const size_t hstep = (size_t)HALF * K * 2;
    const size_t tstep = 2 * hstep;
    const unsigned ldsw = (unsigned)wid * 1024u;
    const int aoff = lds_byte(wr * 64 + fr, fq * 8), boff = lds_byte(wc * 32 + fr, fq * 8);
#define PG8_SA(b, h) (((b) * 2 + (h)) * HTB)
#define PG8_SB(b, h) ((4 + (b) * 2 + (h)) * HTB)
#define PG8_STAGE(bufoff, gbase, voff) do { _Pragma("unroll") for (int _i = 0; _i < 2; ++_i) \
        __builtin_amdgcn_global_load_lds((const unsigned*)((const char*)(gbase) + (voff)[_i]), (PG8_LAS unsigned*)(lds + (bufoff) + ldsw + _i * 8192), 16, 0, 0); } while (0)
#define PG8_LDA(dst, b, h) do { _Pragma("unroll") for (int m = 0; m < 4; ++m) _Pragma("unroll") for (int k = 0; k < 2; ++k) dst[m][k] = *(const PG8_LAS bf16x8*)(lds + PG8_SA(b, h) + aoff + m * 2048 + k * 1024); } while (0)
#define PG8_LDB(dst, b, h) do { _Pragma("unroll") for (int n = 0; n < 2; ++n) _Pragma("unroll") for (int k = 0; k < 2; ++k) dst[n][k] = *(const PG8_LAS bf16x8*)(lds + PG8_SB(b, h) + boff + n * 2048 + k * 1024); } while (0)
#define PG8_MMA(ai, bj, At, Bt) do { __builtin_amdgcn_s_setprio(1); _Pragma("unroll") for (int m = 0; m < 4; ++m) _Pragma("unroll") for (int n = 0; n < 2; ++n) _Pragma("unroll") for (int k = 0; k < 2; ++k) \
        acc[ai][bj][m][n] = __builtin_amdgcn_mfma_f32_16x16x32_bf16(Bt[n][k], At[m][k], acc[ai][bj][m][n], 0, 0, 0); __builtin_amdgcn_s_setprio(0); } while (0)
#define PG8_WAIT_V(n) asm volatile("s_waitcnt vmcnt(" #n ")" ::: "memory")
#define PG8_WAIT_L(n) asm volatile("s_waitcnt lgkmcnt(" #n ")" ::: "memory")
#define PG8_BAR __builtin_amdgcn_s_barrier()
#define PG8_SCHED __builtin_amdgcn_sched_barrier(0)
    Unit cur, nxt; int ui = 0;
    if (!S.next(0, cur)) return;
    f32x4 acc[2][2][4][2];
#pragma unroll
    for (int a = 0; a < 2; ++a)
#pragma unroll
        for (int b = 0; b < 2; ++b)
#pragma unroll
            for (int m = 0; m < 4; ++m)
#pragma unroll
                for (int n = 0; n < 2; ++n) acc[a][b][m][n] = (f32x4){0.f, 0.f, 0.f, 0.f};
    bf16x8 At[4][2], B0[2][2], B1[2][2];
    const char* cA = (const char*)g.A + (size_t)cur.pm * tstep; const char* cB = (const char*)g.Bt + (size_t)cur.pn * tstep;
    S.a_ready(cur);
    if constexpr (SP2) {
        PG8_STAGE(PG8_SB(0, 0), cB, voffB); PG8_STAGE(PG8_SB(0, 1), cB + hstep, voffB); PG8_STAGE(PG8_SA(0, 0), cA, voffA); PG8_STAGE(PG8_SA(0, 1), cA + hstep, voffA);
        if (wr == 1) PG8_BAR;
        PG8_WAIT_V(2); PG8_BAR;
        PG8_STAGE(PG8_SB(1, 0), cB + kstep, voffB); PG8_STAGE(PG8_SA(1, 0), cA + kstep, voffA); PG8_STAGE(PG8_SB(1, 1), cB + hstep + kstep, voffB);
        PG8_WAIT_V(6); PG8_BAR;
    } else {
        PG8_STAGE(PG8_SB(0, 0), cB, voffB); PG8_STAGE(PG8_SA(0, 0), cA, voffA); PG8_STAGE(PG8_SB(0, 1), cB + hstep, voffB); PG8_STAGE(PG8_SA(0, 1), cA + hstep, voffA);
        if (wr == 1) PG8_BAR;
        PG8_WAIT_V(4); PG8_BAR;
        PG8_STAGE(PG8_SB(1, 0), cB + kstep, voffB); PG8_STAGE(PG8_SA(1, 0), cA + kstep, voffA); PG8_STAGE(PG8_SB(1, 1), cB + hstep + kstep, voffB);
        PG8_WAIT_V(6); PG8_BAR;
    }
    for (;;) {
        const bool has_next = S.next(ui + 1, nxt);
        const char* nA = has_next ? (const char*)g.A + (size_t)nxt.pm * tstep : cA; const char* nB = has_next ? (const char*)g.Bt + (size_t)nxt.pn * tstep : cB;
        for (int t = 0; t < nt; t += 2) {
            const bool last = (t == nt - 2);
            const char* a1 = cA + (size_t)(t + 1) * kstep;
            const char* a2 = last ? nA : cA + (size_t)(t + 2) * kstep; const char* b2 = last ? nB : cB + (size_t)(t + 2) * kstep;
            const char* a3 = a2 + kstep; const char* b3 = b2 + kstep;
            if (last && has_next) S.a_ready(nxt);
            if constexpr (SP2) {
            PG8_LDB(B0, 0, 0); PG8_LDB(B1, 0, 1); PG8_SCHED; PG8_LDA(At, 0, 0); PG8_STAGE(PG8_SA(1, 1), a1 + hstep, voffA);
            PG8_WAIT_V(8); PG8_WAIT_L(0); PG8_BAR; PG8_MMA(0, 0, At, B0); PG8_MMA(0, 1, At, B1); PG8_BAR; PG8_SCHED;
            PG8_LDA(At, 0, 1); PG8_STAGE(PG8_SB(0, 0), b2, voffB); PG8_STAGE(PG8_SB(0, 1), b2 + hstep, voffB); PG8_STAGE(PG8_SA(0, 0), a2, voffA);
            PG8_WAIT_V(8); PG8_WAIT_L(0); PG8_BAR; PG8_MMA(1, 0, At, B0); PG8_MMA(1, 1, At, B1); PG8_BAR; PG8_SCHED;
            PG8_LDB(B0, 1, 0); PG8_LDB(B1, 1, 1); PG8_SCHED; PG8_LDA(At, 1, 0); PG8_STAGE(PG8_SA(0, 1), a2 + hstep, voffA);
            PG8_WAIT_V(8); PG8_WAIT_L(0); PG8_BAR; PG8_MMA(0, 0, At, B0); PG8_MMA(0, 1, At, B1); PG8_BAR; PG8_SCHED;
            PG8_LDA(At, 1, 1); PG8_STAGE(PG8_SB(1, 0), b3, voffB); PG8_STAGE(PG8_SB(1, 1), b3 + hstep, voffB); PG8_STAGE(PG8_SA(1, 0), a3, voffA);
            PG8_WAIT_V(8); PG8_WAIT_L(0); PG8_BAR; PG8_MMA(1, 0, At, B0); PG8_MMA(1, 1, At, B1); PG8_BAR; PG8_SCHED;
            } else {
            PG8_LDB(B0, 0, 0); PG8_SCHED; PG8_LDA(At, 0, 0); PG8_STAGE(PG8_SA(1, 1), a1 + hstep, voffA);
            PG8_WAIT_L(8); PG8_BAR; PG8_WAIT_L(0); PG8_MMA(0, 0, At, B0); PG8_BAR; PG8_SCHED;
            PG8_LDB(B1, 0, 1); PG8_STAGE(PG8_SB(0, 0), b2, voffB);
            PG8_BAR; PG8_WAIT_L(0); PG8_MMA(0, 1, At, B1); PG8_BAR;
            PG8_LDA(At, 0, 1); PG8_STAGE(PG8_SA(0, 0), a2, voffA);
            PG8_BAR; PG8_WAIT_L(0); PG8_MMA(1, 0, At, B0); PG8_BAR; PG8_SCHED;
            PG8_STAGE(PG8_SB(0, 1), b2 + hstep, voffB);
            PG8_WAIT_V(6); PG8_BAR; PG8_MMA(1, 1, At, B1); PG8_BAR;
            PG8_LDB(B0, 1, 0); PG8_SCHED; PG8_LDA(At, 1, 0); PG8_STAGE(PG8_SA(0, 1), a2 + hstep, voffA);
            PG8_WAIT_L(8); PG8_BAR; PG8_WAIT_L(0); PG8_MMA(0, 0, At, B0); PG8_BAR; PG8_SCHED;
            PG8_LDB(B1, 1, 1); PG8_STAGE(PG8_SB(1, 0), b3, voffB);
            PG8_BAR; PG8_WAIT_L(0); PG8_MMA(0, 1, At, B1); PG8_BAR;
            PG8_LDA(At, 1, 1); PG8_STAGE(PG8_SA(1, 0), a3, voffA);
            PG8_BAR; PG8_WAIT_L(0); PG8_MMA(1, 0, At, B0); PG8_BAR; PG8_SCHED;
            PG8_STAGE(PG8_SB(1, 1), b3 + hstep, voffB);
            PG8_WAIT_V(6); PG8_BAR; PG8_MMA(1, 1, At, B1); PG8_BAR;
            }
        }
        if constexpr (ALIGN_EPI) { if (wr == 0) PG8_BAR; }
        if constexpr (!Epi::AFTER_DRAIN) { E(acc, cur, wr, wc, fr, fq); S.done(cur); }
        if (!has_next) break;
#pragma unroll
        for (int a = 0; a < 2; ++a)
#pragma unroll
            for (int b = 0; b < 2; ++b)
#pragma unroll
                for (int m = 0; m < 4; ++m)
#pragma unroll
                    for (int n = 0; n < 2; ++n) acc[a][b][m][n] = (f32x4){0.f, 0.f, 0.f, 0.f};
        cur = nxt; cA = nA; cB = nB; ++ui;
        if constexpr (ALIGN_EPI) { if (wr == 1) PG8_BAR; }
    }
    PG8_WAIT_V(0);
    if constexpr (!ALIGN_EPI) { if (wr == 0) PG8_BAR; }
    PG8_BAR;
    if constexpr (Epi::AFTER_DRAIN) { E.fused(acc, cur, wr, wc, fr, fq, lds, wid, lane); S.done(cur); }
#undef PG8_SA
#undef PG8_SB
#undef PG8_STAGE
#undef PG8_LDA
#undef PG8_LDB
#undef PG8_MMA
#undef PG8_WAIT_V
#undef PG8_WAIT_L
#undef PG8_BAR
#undef PG8_SCHED
}
}

constexpr int DM = 2048, NTOK = 8192, NCTX = 4096, DEPTH = 4, NIN = 34;
constexpr int INW = 3136, INP = 3328;
constexpr int OFF_KV = 512, OFF_KR = 768, OFF_XF = 832, OFF_RKV = 1344, OFF_WLO = 2880, OFF_ALO = 2944, OFF_GLO = 3008;
constexpr int DFF = 5632, UPN = 11264, KVROWS = 9216, LORAN = 2560, QW = 1536;
constexpr float EPS = 1e-6f, GN_EPS = 64e-5f, DECAY_SCALE = 0.6065306597126334f;
enum { I_XP = 0, I_XS, I_CKV, I_CKR, I_ST, I_C, I_CCTX, I_WMOD, I_BMOD, I_GPREMIX, I_GPOSTMIX, I_GPREFFN, I_GPOSTFFN, I_WIN, I_GQ, I_WUQ, I_GKV, I_WUKV,
       I_RCONV, I_RW0, I_RW2, I_RA0, I_RA2, I_RG2, I_RKK, I_RKA, I_RRK, I_GNG, I_GNB, I_WOUT, I_WUP, I_FCONV, I_FCONVB, I_WDOWN };
constexpr size_t OUT_X = 0, OUT_CKV = (size_t)NTOK * DM, OUT_KR = OUT_CKV + (size_t)16 * 4 * 256 * 256, OUT_ST = OUT_KR + (size_t)16 * 4 * 256 * 64, OUT_END = OUT_ST + (size_t)16 * 4 * 2 * 8 * 64 * 64;

constexpr size_t A256(size_t x) { return (x + 255) & ~(size_t)255; }
constexpr size_t WS_CTL = 0, CTL_BYTES = 1u << 20;
constexpr size_t WS_MOD   = WS_CTL + CTL_BYTES;
constexpr size_t WS_ROPE  = WS_MOD + A256((size_t)4 * 5 * 12288 * 4);
constexpr size_t WS_P256  = WS_ROPE + A256((size_t)2 * 1024 * 32 * 4);
constexpr size_t WS_P1024 = WS_P256 + A256((size_t)256 * 512 * 2);
constexpr size_t WS_MBD   = WS_P1024 + A256((size_t)1024 * 2048 * 2);
constexpr size_t WS_WL    = WS_MBD + A256((size_t)1024 * 512 * 2);
constexpr size_t WS_WIN   = WS_WL + A256((size_t)4 * LORAN * 256 * 2);
constexpr size_t WS_WUQ   = WS_WIN + A256((size_t)4 * INP * DM * 2);
constexpr size_t WS_WUKV  = WS_WUQ + A256((size_t)4 * QW * 512 * 2);
constexpr size_t WS_WOUT  = WS_WUKV + A256((size_t)4 * 2048 * 256 * 2);
constexpr size_t WS_WUP   = WS_WOUT + A256((size_t)4 * DM * DM * 2);
constexpr size_t WS_WDN   = WS_WUP + A256((size_t)4 * UPN * DM * 2);
constexpr size_t WS_H     = WS_WDN + A256((size_t)4 * DM * DFF * 2);
constexpr size_t WS_PROJ  = WS_H + A256((size_t)NTOK * DM * 2);
constexpr size_t WS_QN    = WS_PROJ + A256((size_t)NTOK * INP * 4);
constexpr size_t WS_CKVA  = WS_QN + A256((size_t)NTOK * 512 * 2);
constexpr size_t WS_KR    = WS_CKVA + A256((size_t)KVROWS * 256 * 2);
constexpr size_t WS_XF    = WS_KR + A256((size_t)KVROWS * 64 * 2);
constexpr size_t WS_AL    = WS_XF + A256((size_t)NTOK * 512 * 2);
constexpr size_t WS_RC    = WS_AL + A256((size_t)NTOK * 256 * 2);
constexpr size_t WS_KC    = WS_RC + A256((size_t)NTOK * 512 * 4);
constexpr size_t WS_VC    = WS_KC + A256((size_t)NTOK * 512 * 4);
constexpr size_t WS_NK    = WS_VC + A256((size_t)NTOK * 512 * 4);
constexpr size_t WS_Q     = WS_NK + A256((size_t)NTOK * 8 * 4);
constexpr size_t WS_KV    = WS_Q + A256((size_t)NTOK * QW * 2);
constexpr size_t WS_LORA  = WS_KV + A256((size_t)KVROWS * 2048 * 2);
constexpr size_t WS_Y     = WS_LORA + A256((size_t)NTOK * LORAN * 4);
constexpr size_t WS_YF    = WS_Y + A256((size_t)NTOK * 1024 * 2);
constexpr size_t WS_YB    = WS_YF + A256((size_t)NTOK * 512 * 4);
constexpr size_t WS_BON   = WS_YB + A256((size_t)NTOK * 512 * 4);
constexpr size_t WS_MIX   = WS_BON + A256((size_t)2 * NTOK * 8 * 4);
constexpr size_t WS_O     = WS_MIX + A256((size_t)NTOK * DM * 2);
constexpr size_t WS_U     = WS_O + A256((size_t)NTOK * DM * 4);
constexpr size_t WS_ACT   = WS_U + A256((size_t)NTOK * UPN * 2);
constexpr size_t WS_END   = WS_ACT + A256((size_t)NTOK * DFF * 2);
constexpr int CW_TMO = 0, CW_CODE = 1, CW_QUEUE = 64  , CW_BAR = 4096;
constexpr int NPHASES = 2 + 11 * DEPTH;
constexpr int RING_OFF = 0, RING_BYTES = 131072, LDSCTL_OFF = RING_BYTES, MISC_OFF = LDSCTL_OFF + 320, LDS_BYTES = 147456, NWAVES = 8;

#define GAS __attribute__((address_space(1)))
#define LAS __attribute__((address_space(3)))
typedef unsigned short bf16;
typedef unsigned v4u __attribute__((ext_vector_type(4)));
typedef unsigned v2u __attribute__((ext_vector_type(2)));
typedef float f32x4 __attribute__((ext_vector_type(4)));
typedef float f32x2 __attribute__((ext_vector_type(2)));
typedef float f32x16 __attribute__((ext_vector_type(16)));
typedef short bf16x8 __attribute__((ext_vector_type(8)));
typedef short s16x4 __attribute__((ext_vector_type(4)));
typedef GAS unsigned gu32;
#define RLX_AGENT __ATOMIC_RELAXED, __HIP_MEMORY_SCOPE_AGENT
#define LDS_WAIT() asm volatile("s_waitcnt lgkmcnt(0)" ::: "memory")
#define VM_WAIT() asm volatile("s_waitcnt vmcnt(0)" ::: "memory")
#define SBAR() __builtin_amdgcn_sched_barrier(0)
__device__ __forceinline__ unsigned cvtpk(float lo, float hi) { unsigned r; asm volatile("v_cvt_pk_bf16_f32 %0, %1, %2" : "=v"(r) : "v"(lo), "v"(hi)); return r; }
__device__ __forceinline__ bf16 f2bf(float f) { return (bf16)(cvtpk(f, 0.f) & 0xffffu); }
__device__ __forceinline__ float bf2f(short s) { return __uint_as_float(((unsigned)(unsigned short)s) << 16); }
__device__ __forceinline__ float wave_sum(float v) {
#pragma unroll
    for (int o = 1; o < 64; o <<= 1) v += __shfl_xor(v, o);
    return v;
}
template <int CTRL> __device__ __forceinline__ float dpp_mov(float x) { return __int_as_float(__builtin_amdgcn_update_dpp(0, __float_as_int(x), CTRL, 0xf, 0xf, true)); }
__device__ __forceinline__ float allred16(float x) {
    x += dpp_mov<0xB1>(x);
    x += dpp_mov<0x4E>(x);
    x += dpp_mov<0x141>(x);
    x += dpp_mov<0x140>(x);
    return x;
}
__device__ __forceinline__ float sigmoidf_(float x) { return 1.0f / (1.0f + __expf(-x)); }
#define XB_TMO      128
#define XB_XCNT(j)  (256  + 64 * (j))
#define XB_XSUB(j)  (1280 + 64 * (j))
#define XB_XGEN(j)  (2304 + 64 * (j))
#define XB_TOP      3328
#define XB_TOPGEN   3392
#define XCD_BAR_WORDS 3456
#define XB_SPIN_CAP (1u << 18)

__device__ __forceinline__ unsigned xb_ld(unsigned* p)              { return __hip_atomic_load(p, __ATOMIC_RELAXED, __HIP_MEMORY_SCOPE_AGENT); }
__device__ __forceinline__ unsigned xb_add(unsigned* p, unsigned v) { return __hip_atomic_fetch_add(p, v, __ATOMIC_RELAXED, __HIP_MEMORY_SCOPE_AGENT); }
__device__ __forceinline__ unsigned xb_xcc_id() { return (unsigned)__builtin_amdgcn_s_getreg((3 << 11) | 20) & 0xFu; }
#define XB_SPIN(cond, bar) do { unsigned _sp = 0; while (cond) { __builtin_amdgcn_s_sleep(1); \
    if ((++_sp & 255u) == 0u) { if (xb_ld(&(bar)[XB_TMO])) break; if (_sp > XB_SPIN_CAP) { atomicAdd(&(bar)[XB_TMO], 1u); break; } } } } while (0)

struct XcdBarrier {
    unsigned* bar; unsigned x;
    volatile LAS unsigned* st;
};

__device__ __forceinline__ XcdBarrier xcd_barrier_post(unsigned* bar, volatile LAS unsigned* st) {
    XcdBarrier b; b.bar = bar; b.x = xb_xcc_id(); b.st = st;
    if (threadIdx.x == 0) (void)xb_add(&bar[XB_XCNT(b.x)], 1u);
    return b;
}
__device__ __forceinline__ void xcd_barrier_complete(unsigned* bar, unsigned x, unsigned& nloc, unsigned& nx) {
    const unsigned G = gridDim.x * gridDim.y * gridDim.z;
    unsigned sum, cnt, mine, sp = 0u;
    for (;;) {
        sum = 0u; cnt = 0u; mine = 0u;
#pragma unroll
        for (unsigned j = 0; j < 16; ++j) { const unsigned c = xb_ld(&bar[XB_XCNT(j)]); sum += c; cnt += (c > 0u) ? 1u : 0u; mine = (j == x) ? c : mine; }
        if (sum == G) break;
        __builtin_amdgcn_s_sleep(1);
        if ((++sp & 255u) == 0u) { if (xb_ld(&bar[XB_TMO])) break; if (sp > XB_SPIN_CAP) { atomicAdd(&bar[XB_TMO], 1u); break; } }
    }
    nloc = mine > 0u ? mine : 1u; nx = cnt > 0u ? cnt : 1u;
}

__device__ __forceinline__ void xcd_barrier(const XcdBarrier& b) {
    asm volatile("s_waitcnt vmcnt(0)" ::: "memory");
    __syncthreads();
    if (threadIdx.x == 0) {
        unsigned* bar = b.bar;
        __builtin_amdgcn_s_waitcnt(0);
        unsigned nloc = b.st[0], nx = b.st[1];
        if (nloc == 0u) { xcd_barrier_complete(bar, b.x, nloc, nx); b.st[0] = nloc; b.st[1] = nx; }
        const unsigned old = xb_add(&bar[XB_XSUB(b.x)], 1u);
        const unsigned gen = old / nloc;
        if (old + 1u == (gen + 1u) * nloc) {
            __builtin_amdgcn_fence(__ATOMIC_RELEASE, "agent");
            asm volatile("s_waitcnt vmcnt(0)" ::: "memory");
            const unsigned og = xb_add(&bar[XB_TOP], 1u);
            const unsigned tg = og / nx;
            if (og + 1u == (tg + 1u) * nx) xb_add(&bar[XB_TOPGEN], 1u);
            else XB_SPIN(xb_ld(&bar[XB_TOPGEN]) == tg, bar);
            __builtin_amdgcn_fence(__ATOMIC_ACQUIRE, "agent");
            xb_add(&bar[XB_XGEN(b.x)], 1u);
            asm volatile("s_waitcnt vmcnt(0)" ::: "memory");
        } else {
            XB_SPIN(xb_ld(&bar[XB_XGEN(b.x)]) == gen, bar);
            __builtin_amdgcn_fence(__ATOMIC_ACQUIRE, "agent");
            asm volatile("s_waitcnt vmcnt(0)" ::: "memory");
        }
    }
    __syncthreads();
}

struct Frame {
    LAS unsigned char* lds;
    volatile LAS unsigned* MISC;
    gu32* ctl;
    int tid, lane, wave, vcu, G;
    const float* const* in;
    float* out; unsigned char* ws;
};
#define WSP(T, off) ((T*)(F.ws + (off)))

__device__ __forceinline__ void p0_transpose_item(const float* W, int K, int N, bf16* WT, LAS float* scr, int item, int lane) {
    const int nblk = N / 32, kb = item / nblk, nb = item % nblk, k0 = 64 * kb, n0 = 32 * nb;
#pragma unroll 8
    for (int i = 0; i < 32; ++i) { const int kk = 2 * i + (lane >> 5); scr[kk * 33 + (lane & 31)] = W[(size_t)(k0 + kk) * N + n0 + (lane & 31)]; }
    LDS_WAIT(); asm volatile("" ::: "memory");
    const int c = lane & 7;
#pragma unroll
    for (int j = 0; j < 4; ++j) { const int n = (lane >> 3) + 8 * j; const LAS float* s = scr + (8 * c) * 33 + n;
        v4u o; o.x = cvtpk(s[0 * 33], s[1 * 33]); o.y = cvtpk(s[2 * 33], s[3 * 33]); o.z = cvtpk(s[4 * 33], s[5 * 33]); o.w = cvtpk(s[6 * 33], s[7 * 33]);
        *(GAS v4u*)(WT + (size_t)(n0 + n) * K + k0 + 8 * c) = o; }
    LDS_WAIT(); asm volatile("" ::: "memory");
}
__device__ __forceinline__ void p0_prologue(Frame& F) {
    LAS float* scr = (LAS float*)(F.lds + RING_OFF + F.wave * 16384);
    const int gw = F.vcu * NWAVES + F.wave, NGW = F.G * NWAVES;
    constexpr int I_IN = (DM / 64) * (INW / 32), I_UQ = (512 / 64) * (QW / 32), I_UKV = (256 / 64) * (2048 / 32), I_OUT = (DM / 64) * (DM / 32), I_UP = (DM / 64) * (UPN / 32), I_DN = (DFF / 64) * (DM / 32);
    constexpr int I_LAYER = I_IN + I_UQ + I_UKV + I_OUT + I_UP + I_DN;
    for (int it = gw; it < DEPTH * I_LAYER; it += NGW) {
        const int l = it / I_LAYER; int r = it % I_LAYER;
        if (r < I_IN) { p0_transpose_item(F.in[I_WIN] + (size_t)l * DM * INW, DM, INW, WSP(bf16, WS_WIN) + (size_t)l * INP * DM, scr, r, F.lane); continue; } r -= I_IN;
        if (r < I_UQ) { p0_transpose_item(F.in[I_WUQ] + (size_t)l * 512 * QW, 512, QW, WSP(bf16, WS_WUQ) + (size_t)l * QW * 512, scr, r, F.lane); continue; } r -= I_UQ;
        if (r < I_UKV) { p0_transpose_item(F.in[I_WUKV] + (size_t)l * 256 * 2048, 256, 2048, WSP(bf16, WS_WUKV) + (size_t)l * 2048 * 256, scr, r, F.lane); continue; } r -= I_UKV;
        if (r < I_OUT) { p0_transpose_item(F.in[I_WOUT] + (size_t)l * DM * DM, DM, DM, WSP(bf16, WS_WOUT) + (size_t)l * DM * DM, scr, r, F.lane); continue; } r -= I_OUT;
        if (r < I_UP) { p0_transpose_item(F.in[I_WUP] + (size_t)l * DM * UPN, DM, UPN, WSP(bf16, WS_WUP) + (size_t)l * UPN * DM, scr, r, F.lane); continue; } r -= I_UP;
        p0_transpose_item(F.in[I_WDOWN] + (size_t)l * DFF * DM, DFF, DM, WSP(bf16, WS_WDN) + (size_t)l * DM * DFF, scr, r, F.lane);
    }
    const long gt = (long)F.vcu * 512 + F.tid, NGT = (long)F.G * 512;
    for (long i = gt; i < (long)DEPTH * (INP - INW) * DM / 8; i += NGT) { const int l = (int)(i / ((INP - INW) * DM / 8)); const long r = i % ((INP - INW) * DM / 8);
        *(v4u*)(WSP(bf16, WS_WIN) + (size_t)l * INP * DM + (size_t)INW * DM + r * 8) = (v4u){0u, 0u, 0u, 0u}; }
    for (long i = gt; i < (long)DEPTH * LORAN * 256; i += NGT) { const int l = (int)(i / (LORAN * 256)), n = (int)((i / 256) % LORAN), k = (int)(i & 255);
        float v = 0.f;
        if (n < 1024) { if (k < 64) v = F.in[I_RW2][(((size_t)l * 2 + (n >> 9)) * 64 + k) * 512 + (n & 511)]; }
        else if (n < 2048) { if (k >= 64 && k < 128) v = F.in[I_RA2][(((size_t)l * 2 + ((n - 1024) >> 9)) * 64 + (k - 64)) * 512 + (n & 511)]; }
        else { if (k >= 128) v = F.in[I_RG2][((size_t)l * 128 + (k - 128)) * 512 + (n - 2048)]; }
        WSP(bf16, WS_WL)[i] = f2bf(v); }
    for (long i = gt; i < 1024 * 512; i += NGT) { const int n = (int)(i >> 9), k = (int)(i & 511), g = n >> 8, j = n & 255, g2 = k >> 7, c = k & 127;
        float v = 0.f; if (g == g2) { const int m = (c * (j & 127)) & 127; v = (j < 128) ? cospif((float)m * (1.0f / 64.0f)) : sinpif((float)m * (1.0f / 64.0f)); }
        WSP(bf16, WS_MBD)[i] = f2bf(v); }
    for (long i = gt; i < 256 * 512; i += NGT) { const int tp = (int)(i >> 9), t = (int)(i & 511), m = (tp * (t & 255)) & 255; const float sc = 0.005524271728019903f;
        const float v = (t < 256) ? cospif((float)m * (1.0f / 128.0f)) : -sinpif((float)m * (1.0f / 128.0f)); WSP(bf16, WS_P256)[i] = f2bf(v * sc); }
    for (long i = gt; i < 1024 * 2048; i += NGT) { const int tp = (int)(i >> 11), t = (int)(i & 2047), m = (tp * (t & 1023)) & 1023; const float sc = 0.0027621358640099515f;
        const float v = (t < 1024) ? cospif((float)m * (1.0f / 512.0f)) : -sinpif((float)m * (1.0f / 512.0f)); WSP(bf16, WS_P1024)[i] = f2bf(v * sc); }
    for (long i = gt; i < 1024 * 32; i += NGT) { const int t = (int)(i >> 5), ii = (int)(i & 31); const float pos = (ii < 16) ? (float)(t >> 6) : (float)(t & 63);
        const float inv = exp2f(-(float)(ii & 15) * (13.287712379549449f / 16.0f)); const float ang = pos * inv;
        WSP(float, WS_ROPE)[i] = cosf(ang); WSP(float, WS_ROPE)[1024 * 32 + i] = sinf(ang); }
    {
        LAS float* sc = (LAS float*)(F.lds);
        LAS float* red = (LAS float*)(F.lds + 40960);
        bool have = false;
        for (int it = F.vcu; it < DEPTH * 96; it += F.G) {
            if (!have) { __syncthreads();
                for (int i = F.tid; i < 5 * 2048; i += 512) { const int cd = i >> 11, k = i & 2047; const float x = (cd == 0) ? F.in[I_CCTX][k] : F.in[I_C][(cd - 1) * 2048 + k]; sc[i] = x * sigmoidf_(x); }
                __syncthreads(); have = true; }
            const int l = it / 96, ch = it % 96, kh = F.lane >> 5, c4 = F.lane & 31;
            const float* wp = F.in[I_WMOD] + (size_t)l * DM * 12288 + (size_t)ch * 128 + 4 * c4;
            f32x4 a0 = {0.f, 0.f, 0.f, 0.f}, a1 = a0, a2 = a0, a3 = a0, a4 = a0;
#pragma unroll 8
            for (int i = 0; i < 128; ++i) { const int k = 256 * F.wave + 2 * i + kh; const f32x4 wv = *(const f32x4*)(wp + (size_t)k * 12288);
                a0 += wv * sc[k]; a1 += wv * sc[2048 + k]; a2 += wv * sc[4096 + k]; a3 += wv * sc[6144 + k]; a4 += wv * sc[8192 + k]; }
            const int part = F.wave * 2 + kh;
            *(LAS f32x4*)(red + (part * 5 + 0) * 128 + 4 * c4) = a0; *(LAS f32x4*)(red + (part * 5 + 1) * 128 + 4 * c4) = a1; *(LAS f32x4*)(red + (part * 5 + 2) * 128 + 4 * c4) = a2;
            *(LAS f32x4*)(red + (part * 5 + 3) * 128 + 4 * c4) = a3; *(LAS f32x4*)(red + (part * 5 + 4) * 128 + 4 * c4) = a4;
            __syncthreads();
            for (int i = F.tid; i < 640; i += 512) { const int cd = i >> 7, col = i & 127; float s = F.in[I_BMOD][(size_t)l * 12288 + ch * 128 + col];
#pragma unroll
                for (int p = 0; p < 16; ++p) s += red[(p * 5 + cd) * 128 + col];
                WSP(float, WS_MOD)[((size_t)l * 5 + cd) * 12288 + ch * 128 + col] = s; }
            __syncthreads();
        }
    }
}

template <int MODE> __device__ __forceinline__ void norm_phase(Frame& F, int l) {
    LAS float* vA = (LAS float*)(F.lds); LAS float* vB = vA + 2048; LAS float* vC = vB + 2048;
    const float* MOD = WSP(float, WS_MOD);
    const bool doh = (MODE != 2) || (l < DEPTH - 1);
    for (int ch = F.vcu; ch < NTOK / 32; ch += F.G) {
        const int row0 = 32 * ch, cond = row0 < NCTX ? 0 : 1 + ((row0 - NCTX) >> 10);
        __syncthreads();
        { const int col = 4 * F.tid;
          if (MODE != 0) { const float* gate = MOD + ((size_t)l * 5 + cond) * 12288 + (MODE == 1 ? 4096 : 10240) + col; const float* gp = F.in[MODE == 1 ? I_GPOSTMIX : I_GPOSTFFN] + (size_t)l * DM + col;
              *(LAS f32x4*)(vA + col) = *(const f32x4*)gate * *(const f32x4*)gp; }
          if (doh) { const int ln = (MODE == 2) ? l + 1 : l; const float* mb = MOD + ((size_t)ln * 5 + cond) * 12288;
              const float* gpre = F.in[MODE == 1 ? I_GPREFFN : I_GPREMIX] + (size_t)ln * DM + col;
              const float* scp = mb + (MODE == 1 ? 8192 : 2048) + col; const float* shp = mb + (MODE == 1 ? 6144 : 0) + col;
              *(LAS f32x4*)(vB + col) = *(const f32x4*)gpre * (*(const f32x4*)scp + 1.0f); *(LAS f32x4*)(vC + col) = *(const f32x4*)shp; } }
        __syncthreads();
        for (int rr = 0; rr < 4; ++rr) {
            const int row = row0 + 4 * F.wave + rr;
            float* xrow = F.out + OUT_X + (size_t)row * DM;
            f32x4 x[8];
            if (MODE == 0) { const float* src = row < NCTX ? F.in[I_XP] + (size_t)row * DM : F.in[I_XS] + (size_t)(row - NCTX) * DM;
#pragma unroll
                for (int j = 0; j < 8; ++j) x[j] = *(const f32x4*)(src + 4 * F.lane + 256 * j); }
            else { const float* orow = WSP(float, WS_O) + (size_t)row * DM; f32x4 o[8]; float ss = 0.f;
#pragma unroll
                for (int j = 0; j < 8; ++j) { o[j] = *(const f32x4*)(orow + 4 * F.lane + 256 * j); x[j] = *(const f32x4*)(xrow + 4 * F.lane + 256 * j); ss += o[j].x * o[j].x + o[j].y * o[j].y + o[j].z * o[j].z + o[j].w * o[j].w; }
                const float rs = rsqrtf(wave_sum(ss) * (1.0f / DM) + EPS);
#pragma unroll
                for (int j = 0; j < 8; ++j) x[j] += *(const LAS f32x4*)(vA + 4 * F.lane + 256 * j) * (o[j] * rs); }
#pragma unroll
            for (int j = 0; j < 8; ++j) *(f32x4*)(xrow + 4 * F.lane + 256 * j) = x[j];
            if (doh) { float ss = 0.f;
#pragma unroll
                for (int j = 0; j < 8; ++j) ss += x[j].x * x[j].x + x[j].y * x[j].y + x[j].z * x[j].z + x[j].w * x[j].w;
                const float rs = rsqrtf(wave_sum(ss) * (1.0f / DM) + EPS);
                bf16* hrow = WSP(bf16, WS_H) + (size_t)row * DM;
#pragma unroll
                for (int j = 0; j < 8; ++j) { const f32x4 hv = (x[j] * rs) * *(const LAS f32x4*)(vB + 4 * F.lane + 256 * j) + *(const LAS f32x4*)(vC + 4 * F.lane + 256 * j);
                    v2u w; w.x = cvtpk(hv.x, hv.y); w.y = cvtpk(hv.z, hv.w); *(v2u*)(hrow + 4 * F.lane + 256 * j) = w; } }
        }
    }
}

__device__ __forceinline__ int kv_row(int row) { return row < NCTX ? row : NCTX + ((row - NCTX) >> 10) * 1280 + 256 + ((row - NCTX) & 1023); }
__device__ __forceinline__ void prep_phase(Frame& F, int l) {
    const int gw = F.vcu * NWAVES + F.wave, NGW = F.G * NWAVES, lane = F.lane;
    const float* PROJ = WSP(float, WS_PROJ);
    for (int row = gw; row < NTOK; row += NGW) {
        const float* pr = PROJ + (size_t)row * INP;
        const int kvr = kv_row(row);
        { f32x4 q0 = *(const f32x4*)(pr + 4 * lane), q1 = *(const f32x4*)(pr + 256 + 4 * lane);
          float ss = q0.x * q0.x + q0.y * q0.y + q0.z * q0.z + q0.w * q0.w + q1.x * q1.x + q1.y * q1.y + q1.z * q1.z + q1.w * q1.w;
          const float rs = rsqrtf(wave_sum(ss) * (1.0f / 512.0f) + EPS);
          const float* g = F.in[I_GQ] + (size_t)l * 512;
          q0 = q0 * rs * *(const f32x4*)(g + 4 * lane); q1 = q1 * rs * *(const f32x4*)(g + 256 + 4 * lane);
          bf16* qn = WSP(bf16, WS_QN) + (size_t)row * 512;
          v2u w; w.x = cvtpk(q0.x, q0.y); w.y = cvtpk(q0.z, q0.w); *(v2u*)(qn + 4 * lane) = w; w.x = cvtpk(q1.x, q1.y); w.y = cvtpk(q1.z, q1.w); *(v2u*)(qn + 256 + 4 * lane) = w; }
        { f32x4 kv = *(const f32x4*)(pr + OFF_KV + 4 * lane);
          const float rs = rsqrtf(wave_sum(kv.x * kv.x + kv.y * kv.y + kv.z * kv.z + kv.w * kv.w) * (1.0f / 256.0f) + EPS);
          kv = kv * rs * *(const f32x4*)(F.in[I_GKV] + (size_t)l * 256 + 4 * lane);
          v2u w; w.x = cvtpk(kv.x, kv.y); w.y = cvtpk(kv.z, kv.w); *(v2u*)(WSP(bf16, WS_CKVA) + (size_t)kvr * 256 + 4 * lane) = w;
          if (row < NCTX) *(f32x4*)(F.out + OUT_CKV + ((size_t)((row >> 8) * DEPTH + l) * 256 + (row & 255)) * 256 + 4 * lane) = kv; }
        { const float kr = pr[OFF_KR + lane]; float val = kr;
          if (row < NCTX) F.out[OUT_KR + ((size_t)((row >> 8) * DEPTH + l) * 256 + (row & 255)) * 64 + lane] = kr;
          else { const int t = (row - NCTX) & 1023, i = lane & 31; const float c = WSP(float, WS_ROPE)[t * 32 + i], s = WSP(float, WS_ROPE)[1024 * 32 + t * 32 + i];
              const float other = __shfl_xor(kr, 32); val = (lane < 32) ? kr * c - other * s : other * s + kr * c; }
          WSP(bf16, WS_KR)[(size_t)kvr * 64 + lane] = f2bf(val); }
        { bf16* xf = WSP(bf16, WS_XF) + (size_t)row * 512;
#pragma unroll
          for (int j = 0; j < 2; ++j) { const f32x4 v = *(const f32x4*)(pr + OFF_XF + 4 * lane + 256 * j); v2u w; w.x = cvtpk(v.x, v.y); w.y = cvtpk(v.z, v.w); *(v2u*)(xf + 4 * lane + 256 * j) = w; } }
        { bf16* al = WSP(bf16, WS_AL) + (size_t)row * 256;
          al[lane] = f2bf(tanhf(pr[OFF_WLO + lane])); al[64 + lane] = f2bf(pr[OFF_ALO + lane]);
          const f32x2 g = *(const f32x2*)(pr + OFF_GLO + 2 * lane); *(unsigned*)(al + 128 + 2 * lane) = cvtpk(sigmoidf_(g.x), sigmoidf_(g.y)); }
    }
    for (int it = gw; it < (NTOK / 32) * 24; it += NGW) {
        const int chunk = it / 24, grp = it % 24, row0 = 32 * chunk, which = grp >> 3, hh = grp & 7;
        const int s0 = row0 < NCTX ? (row0 & ~255) : NCTX + ((row0 - NCTX) & ~1023), send = s0 + (row0 < NCTX ? 256 : 1024);
        const int ch = 64 * grp + lane, cc = 64 * hh + lane;
        const float* cw = F.in[I_RCONV] + (size_t)l * 3 * 1536;
        const float w0 = cw[ch], w1 = cw[1536 + ch], w2 = cw[3072 + ch];
        const float kk = F.in[I_RKK][(size_t)l * 512 + cc];
        float* dst = WSP(float, which == 0 ? WS_RC : (which == 1 ? WS_KC : WS_VC));
        const float* src = PROJ + OFF_RKV + ch;
        float prev = row0 > s0 ? src[(size_t)(row0 - 1) * INP] : 0.f, cur = src[(size_t)row0 * INP];
#pragma unroll 4
        for (int i = 0; i < 32; ++i) { const int row = row0 + i; const float nxt = (row + 1 < send) ? src[(size_t)(row + 1) * INP] : 0.f;
            const float o = prev * w0 + cur * w1 + nxt * w2; dst[(size_t)row * 512 + cc] = o;
            if (which == 1) { const float kap = o * kk; const float ss = wave_sum(kap * kap); if (lane == 0) WSP(float, WS_NK)[row * 8 + hh] = rsqrtf(ss + EPS); }
            prev = cur; cur = nxt; }
    }
    { const long gt = (long)F.vcu * 512 + F.tid, NGT = (long)F.G * 512;
      for (long i = gt; i < 1024 * 64; i += NGT) { const int r = (int)(i >> 6), c4 = (int)(i & 63) * 4, b = r >> 8, j = r & 255;
          const f32x4 v = *(const f32x4*)(F.in[I_CKV] + (((size_t)b * DEPTH + l) * 256 + j) * 256 + c4); v2u w; w.x = cvtpk(v.x, v.y); w.y = cvtpk(v.z, v.w);
          *(v2u*)(WSP(bf16, WS_CKVA) + (size_t)(NCTX + b * 1280 + j) * 256 + c4) = w; }
      for (long i = gt; i < 1024 * 16; i += NGT) { const int r = (int)(i >> 4), c4 = (int)(i & 15) * 4, b = r >> 8, j = r & 255;
          const f32x4 v = *(const f32x4*)(F.in[I_CKR] + (((size_t)b * DEPTH + l) * 256 + j) * 64 + c4); v2u w; w.x = cvtpk(v.x, v.y); w.y = cvtpk(v.z, v.w);
          *(v2u*)(WSP(bf16, WS_KR) + (size_t)(NCTX + b * 1280 + j) * 64 + c4) = w; } }
}

__device__ __forceinline__ void post_phase(Frame& F, int l) {
    const int gw = F.vcu * NWAVES + F.wave, NGW = F.G * NWAVES, lane = F.lane;
    for (int row = gw; row < NTOK; row += NGW) {
#pragma unroll
        for (int h = 0; h < 8; ++h) { const int c = 64 * h + lane;
            const float y = WSP(float, WS_YF)[(size_t)row * 512 + c] + WSP(float, WS_YB)[(size_t)row * 512 + c];
            const float mu = wave_sum(y) * (1.0f / 64.0f); const float d = y - mu; const float var = wave_sum(d * d) * (1.0f / 64.0f);
            const float yn = d * rsqrtf(var + GN_EPS) * F.in[I_GNG][(size_t)l * 512 + c] + F.in[I_GNB][(size_t)l * 512 + c];
            const float bonus = WSP(float, WS_BON)[(size_t)row * 8 + h] + WSP(float, WS_BON)[(size_t)NTOK * 8 + (size_t)row * 8 + h];
            const float o = (yn + bonus * WSP(float, WS_VC)[(size_t)row * 512 + c]) * WSP(float, WS_LORA)[(size_t)row * LORAN + 2048 + c];
            WSP(bf16, WS_MIX)[(size_t)row * DM + 1536 + c] = f2bf(o); }
    }
}

__device__ __forceinline__ void ffn_act_phase(Frame& F, int l) {
    const int gw = F.vcu * NWAVES + F.wave, NGW = F.G * NWAVES, lane = F.lane;
    const bf16* U = WSP(bf16, WS_U);
    for (int it = gw; it < (NTOK / 32) * 11; it += NGW) {
        const int chunk = it / 11, slab = it % 11, row0 = 32 * chunk, col = 512 * slab + 8 * lane;
        const int s0 = row0 < NCTX ? (row0 & ~255) : NCTX + ((row0 - NCTX) & ~1023), send = s0 + (row0 < NCTX ? 256 : 1024);
        const float* cw = F.in[I_FCONV] + (size_t)l * 3 * UPN; const float* cb = F.in[I_FCONVB] + (size_t)l * UPN;
        float wg[3][8], wv[3][8], bg[8], bv[8];
#pragma unroll
        for (int j = 0; j < 3; ++j)
#pragma unroll
            for (int e = 0; e < 8; ++e) { wg[j][e] = cw[(size_t)j * UPN + col + e]; wv[j][e] = cw[(size_t)j * UPN + DFF + col + e]; }
#pragma unroll
        for (int e = 0; e < 8; ++e) { bg[e] = cb[col + e]; bv[e] = cb[DFF + col + e]; }
        const bf16x8 z8 = {0, 0, 0, 0, 0, 0, 0, 0};
        bf16x8 pg = row0 > s0 ? *(const bf16x8*)(U + (size_t)(row0 - 1) * UPN + col) : z8, pv = row0 > s0 ? *(const bf16x8*)(U + (size_t)(row0 - 1) * UPN + DFF + col) : z8;
        bf16x8 cg = *(const bf16x8*)(U + (size_t)row0 * UPN + col), cv = *(const bf16x8*)(U + (size_t)row0 * UPN + DFF + col);
#pragma unroll 2
        for (int i = 0; i < 32; ++i) { const int row = row0 + i; const bool hn = row + 1 < send;
            const bf16x8 ng = hn ? *(const bf16x8*)(U + (size_t)(row + 1) * UPN + col) : z8, nv = hn ? *(const bf16x8*)(U + (size_t)(row + 1) * UPN + DFF + col) : z8;
            float r[8];
#pragma unroll
            for (int e = 0; e < 8; ++e) { const float g = bf2f(pg[e]) * wg[0][e] + bf2f(cg[e]) * wg[1][e] + bf2f(ng[e]) * wg[2][e] + bg[e];
                const float v = bf2f(pv[e]) * wv[0][e] + bf2f(cv[e]) * wv[1][e] + bf2f(nv[e]) * wv[2][e] + bv[e]; r[e] = g * sigmoidf_(g) * v; }
            v4u w; w.x = cvtpk(r[0], r[1]); w.y = cvtpk(r[2], r[3]); w.z = cvtpk(r[4], r[5]); w.w = cvtpk(r[6], r[7]);
            *(v4u*)(WSP(bf16, WS_ACT) + (size_t)row * DFF + col) = w;
            pg = cg; pv = cv; cg = ng; cv = nv; }
    }
}

__device__ __forceinline__ void scan_unit(Frame& F, int l, int s, int h, int d) {
    const int tid = F.tid, lane = F.lane, wv = F.wave;
    const int T = s < 16 ? 256 : 1024, row0 = s < 16 ? 256 * s : NCTX + 1024 * (s - 16), NCH = T / 32;
    LAS float* SV = (LAS float*)F.lds;
    LAS float* YS = (LAS float*)(F.lds + 98304);
    const int rp = lane >> 4, kq = lane & 15, rowA = 8 * wv + 2 * rp;
    f32x4 st0 = {0.f, 0.f, 0.f, 0.f}, st1 = st0;
    if (s >= 16) { const float* sp = F.in[I_ST] + ((((size_t)(s - 16) * DEPTH + l) * 2 + d) * 8 + h) * 4096 + rowA * 64 + 4 * kq; st0 = *(const f32x4*)sp; st1 = *(const f32x4*)(sp + 64); }
    const int si = tid >> 4, sn = (tid & 15) * 4, cbase = 64 * h + sn;
    const f32x4 w0v = *(const f32x4*)(F.in[I_RW0] + ((size_t)l * 2 + d) * 512 + cbase), a0v = *(const f32x4*)(F.in[I_RA0] + ((size_t)l * 2 + d) * 512 + cbase);
    const f32x4 kkv = *(const f32x4*)(F.in[I_RKK] + (size_t)l * 512 + cbase), kav = *(const f32x4*)(F.in[I_RKA] + (size_t)l * 512 + cbase), rkv = *(const f32x4*)(F.in[I_RRK] + (size_t)l * 512 + cbase);
    float* Yout = WSP(float, d == 0 ? WS_YF : WS_YB); float* BON = WSP(float, WS_BON) + (size_t)d * NTOK * 8;
    const float* RC = WSP(float, WS_RC); const float* KC = WSP(float, WS_KC); const float* VC = WSP(float, WS_VC); const float* NK = WSP(float, WS_NK); const float* LORA = WSP(float, WS_LORA);
    f32x4 gr, gk, gv, gwp, gap; float gnk;
#define SCAN_ROW(c) (row0 + (d == 0 ? 32 * (c) + si : T - 1 - (32 * (c) + si)))
#define SCAN_LOADG(c) do { const size_t row_ = (size_t)SCAN_ROW(c); gr = *(const f32x4*)(RC + row_ * 512 + cbase); gk = *(const f32x4*)(KC + row_ * 512 + cbase); gv = *(const f32x4*)(VC + row_ * 512 + cbase); \
        gwp = *(const f32x4*)(LORA + row_ * LORAN + d * 512 + cbase); gap = *(const f32x4*)(LORA + row_ * LORAN + 1024 + d * 512 + cbase); gnk = NK[row_ * 8 + h]; } while (0)
#define SCAN_WRITES(buf, c) do { const f32x4 kh_ = gk * kkv * gnk; f32x4 w_, a_; \
        _Pragma("unroll") for (int e = 0; e < 4; ++e) { w_[e] = __expf(-DECAY_SCALE * sigmoidf_(w0v[e] + gwp[e])); a_[e] = sigmoidf_(a0v[e] + gap[e]); } \
        const f32x4 b_ = a_ * kh_, kt_ = gk * ((a_ - 1.0f) * kav + 1.0f); const f32x4 bb_ = gr * rkv * kt_; \
        const float bon_ = allred16((bb_.x + bb_.y) + (bb_.z + bb_.w)); if ((tid & 15) == 0) BON[(size_t)SCAN_ROW(c) * 8 + h] = bon_; \
        LAS float* p_ = SV + (buf) * 12288 + si * 384 + sn; *(LAS f32x4*)(p_) = w_; *(LAS f32x4*)(p_ + 64) = kh_; *(LAS f32x4*)(p_ + 128) = b_; *(LAS f32x4*)(p_ + 192) = kt_; \
        *(LAS f32x4*)(p_ + 256) = gr; *(LAS f32x4*)(p_ + 320) = gv; } while (0)
    SCAN_LOADG(0); SCAN_WRITES(0, 0); __syncthreads();
    for (int c = 0; c < NCH; ++c) {
        if (c + 1 < NCH) SCAN_LOADG(c + 1);
        const LAS float* sv = SV + (c & 1) * 12288; LAS float* ys = YS + (c & 1) * 2048;
        f32x4 w4 = *(const LAS f32x4*)(sv + 4 * kq), kh4 = *(const LAS f32x4*)(sv + 64 + 4 * kq), b4 = *(const LAS f32x4*)(sv + 128 + 4 * kq), kt4 = *(const LAS f32x4*)(sv + 192 + 4 * kq), r4 = *(const LAS f32x4*)(sv + 256 + 4 * kq);
        f32x2 v2 = *(const LAS f32x2*)(sv + 320 + rowA);
#pragma unroll 4
        for (int i = 0; i < 32; ++i) {
            const LAS float* pn = sv + ((i + 1) & 31) * 384;
            const f32x4 nw = *(const LAS f32x4*)(pn + 4 * kq), nkh = *(const LAS f32x4*)(pn + 64 + 4 * kq), nb = *(const LAS f32x4*)(pn + 128 + 4 * kq), nkt = *(const LAS f32x4*)(pn + 192 + 4 * kq), nr = *(const LAS f32x4*)(pn + 256 + 4 * kq);
            const f32x2 nv = *(const LAS f32x2*)(pn + 320 + rowA);
            float sk0 = (st0.x * kh4.x + st0.y * kh4.y) + (st0.z * kh4.z + st0.w * kh4.w), sk1 = (st1.x * kh4.x + st1.y * kh4.y) + (st1.z * kh4.z + st1.w * kh4.w);
            sk0 = allred16(sk0); sk1 = allred16(sk1);
            st0 = st0 * w4 - b4 * sk0 + kt4 * v2.x; st1 = st1 * w4 - b4 * sk1 + kt4 * v2.y;
            float y0 = (st0.x * r4.x + st0.y * r4.y) + (st0.z * r4.z + st0.w * r4.w), y1 = (st1.x * r4.x + st1.y * r4.y) + (st1.z * r4.z + st1.w * r4.w);
            y0 = allred16(y0); y1 = allred16(y1);
            if (kq == 0) *(LAS f32x2*)(ys + i * 64 + rowA) = (f32x2){y0, y1};
            w4 = nw; kh4 = nkh; b4 = nb; kt4 = nkt; r4 = nr; v2 = nv;
        }
        if (c + 1 < NCH) SCAN_WRITES((c + 1) & 1, c + 1);
        __syncthreads();
        *(f32x4*)(Yout + (size_t)SCAN_ROW(c) * 512 + cbase) = *(const LAS f32x4*)(ys + si * 64 + sn);
    }
    if (s < 16) { float* op = F.out + OUT_ST + ((((size_t)s * DEPTH + l) * 2 + d) * 8 + h) * 4096 + rowA * 64 + 4 * kq; *(f32x4*)op = st0; *(f32x4*)(op + 64) = st1; }
#undef SCAN_ROW
#undef SCAN_LOADG
#undef SCAN_WRITES
}

constexpr float ATT_SCALE = 0.07216878364870322f;
constexpr float ATT_THR = 8.f;
#define KSWZ(row, colB) ((row) * 256 + ((colB) ^ (((row) & 7) << 4)))
__device__ __forceinline__ int crow(int r, int hi) { return (r & 3) + 8 * (r >> 2) + 4 * hi; }
__device__ __forceinline__ void partialSM(f32x16& p0, f32x16& p1, float& m_reg, float& mn, float& alpha) {
    constexpr float C = ATT_SCALE * 1.4426950408889634f;
    float pmax = p0[0];
#pragma unroll
    for (int r = 1; r < 16; ++r) pmax = fmaxf(pmax, p0[r]);
#pragma unroll
    for (int r = 0; r < 16; ++r) pmax = fmaxf(pmax, p1[r]);
    { auto rr = __builtin_amdgcn_permlane32_swap(__float_as_uint(pmax), __float_as_uint(pmax), false, false); pmax = fmaxf(__uint_as_float(rr[0]), __uint_as_float(rr[1])); }
    if (__builtin_expect(__all(pmax - m_reg <= ATT_THR / ATT_SCALE), 1)) { mn = m_reg; alpha = 1.f; }
    else { mn = fmaxf(m_reg, pmax); alpha = __builtin_amdgcn_exp2f((m_reg - mn) * C); m_reg = mn; }
    const float mnC = -mn * C;
#pragma unroll
    for (int r = 0; r < 16; ++r) p0[r] = __builtin_amdgcn_exp2f(fmaf(p0[r], C, mnC));
#pragma unroll
    for (int r = 0; r < 16; ++r) p1[r] = __builtin_amdgcn_exp2f(fmaf(p1[r], C, mnC));
}
__device__ __forceinline__ void finishSM(f32x16& p0, f32x16& p1, float alpha, float& l_reg, bf16x8& pa0, bf16x8& pa1, bf16x8& pa2, bf16x8& pa3) {
    float ps = 0;
#pragma unroll
    for (int r = 0; r < 16; ++r) ps += p0[r];
#pragma unroll
    for (int r = 0; r < 16; ++r) ps += p1[r];
    { auto rr = __builtin_amdgcn_permlane32_swap(__float_as_uint(ps), __float_as_uint(ps), false, false); ps = __uint_as_float(rr[0]) + __uint_as_float(rr[1]); }
    l_reg = l_reg * alpha + ps;
#define PK4(P, BASE, OUT) do { unsigned a0 = cvtpk(P[BASE + 0], P[BASE + 1]), a1 = cvtpk(P[BASE + 2], P[BASE + 3]);   \
    unsigned b0 = cvtpk(P[BASE + 4], P[BASE + 5]), b1 = cvtpk(P[BASE + 6], P[BASE + 7]);                              \
    auto r0 = __builtin_amdgcn_permlane32_swap(a0, b0, false, false); auto r1 = __builtin_amdgcn_permlane32_swap(a1, b1, false, false); \
    v4u w = {r0[0], r1[0], r0[1], r1[1]}; OUT = *reinterpret_cast<bf16x8*>(&w); } while (0)
    PK4(p0, 0, pa0); PK4(p0, 8, pa1); PK4(p1, 0, pa2); PK4(p1, 8, pa3);
#undef PK4
}
__device__ __forceinline__ int v_st(int k, int c) { const int kk = (k & ~0xC) | ((k & 4) << 1) | ((k & 8) >> 1); return ((kk >> 3) * 4 + (c >> 5)) * 512 + ((kk & 7) * 32 + (c & 31)) * 2; }
__device__ __forceinline__ int v_rd_base(int lane) { return ((lane & 3) << 3) | (((lane >> 2) & 3) << 6) | (((lane >> 4) & 1) << 5) | (((lane >> 5) & 1) << 8); }
constexpr int v_rd_off(int d0, int ks, int half) { return d0 * 512 + ks * 4096 + half * 2048; }
template <int OFF> __device__ __forceinline__ s16x4 tr_read(int vb) { s16x4 r; asm volatile("ds_read_b64_tr_b16 %0, %1 offset:%2" : "=&v"(r) : "v"(vb), "i"(OFF) : "memory"); return r; }
template <int D0> __device__ __forceinline__ void pv_one(f32x16& od, int vb, bf16x8 pa0, bf16x8 pa1, bf16x8 pa2, bf16x8 pa3) {
    const s16x4 l0 = tr_read<v_rd_off(D0, 0, 0)>(vb), h0 = tr_read<v_rd_off(D0, 0, 1)>(vb), l1 = tr_read<v_rd_off(D0, 1, 0)>(vb), h1 = tr_read<v_rd_off(D0, 1, 1)>(vb);
    const s16x4 l2 = tr_read<v_rd_off(D0, 2, 0)>(vb), h2 = tr_read<v_rd_off(D0, 2, 1)>(vb), l3 = tr_read<v_rd_off(D0, 3, 0)>(vb), h3 = tr_read<v_rd_off(D0, 3, 1)>(vb);
    asm volatile("s_waitcnt lgkmcnt(0)" ::: "memory"); SBAR();
#define PK(L, H) (bf16x8){L[0], L[1], L[2], L[3], H[0], H[1], H[2], H[3]}
    od = __builtin_amdgcn_mfma_f32_32x32x16_bf16(pa0, PK(l0, h0), od, 0, 0, 0);
    od = __builtin_amdgcn_mfma_f32_32x32x16_bf16(pa1, PK(l1, h1), od, 0, 0, 0);
    od = __builtin_amdgcn_mfma_f32_32x32x16_bf16(pa2, PK(l2, h2), od, 0, 0, 0);
    od = __builtin_amdgcn_mfma_f32_32x32x16_bf16(pa3, PK(l3, h3), od, 0, 0, 0);
#undef PK
}
__device__ __forceinline__ void pv_d0(f32x16* o, int vb, bf16x8 pa0, bf16x8 pa1, bf16x8 pa2, bf16x8 pa3) {
    pv_one<0>(o[0], vb, pa0, pa1, pa2, pa3); pv_one<1>(o[1], vb, pa0, pa1, pa2, pa3); pv_one<2>(o[2], vb, pa0, pa1, pa2, pa3); pv_one<3>(o[3], vb, pa0, pa1, pa2, pa3);
}
__device__ __forceinline__ bf16x8 pack8(const float* x) { v4u w = {cvtpk(x[0], x[1]), cvtpk(x[2], x[3]), cvtpk(x[4], x[5]), cvtpk(x[6], x[7])}; return *reinterpret_cast<bf16x8*>(&w); }

#define GLDS16(gp, lp) __builtin_amdgcn_global_load_lds((const unsigned*)(gp), (LAS unsigned*)(lp), 16, 0, 0)
constexpr int AT_BUF = 40960;
__device__ __forceinline__ void attn_unit(Frame& F, int s, int h, int qb) {
    const int wid = F.wave, lane = F.lane, r32 = lane & 31, hi = lane >> 5;
    const int grow0 = (s < 16 ? 256 * s : NCTX + 1024 * (s - 16)) + 256 * qb;
    const int kvr0 = s < 16 ? 256 * s : NCTX + 1280 * (s - 16), NT = s < 16 ? 4 : 20;
    LAS char* L0 = (LAS char*)F.lds;
    LAS float* wsx = (LAS float*)(L0 + 2 * AT_BUF) + wid * 64; LAS float* li_l = wsx; LAS float* al_l = wsx + 32;
    bf16x8 qr[12];
    { const bf16* Qw = WSP(bf16, WS_Q) + (size_t)(grow0 + wid * 32 + r32) * QW + h * 192 + hi * 8;
#pragma unroll
      for (int d0 = 0; d0 < 12; ++d0) qr[d0] = *(const bf16x8*)(Qw + d0 * 16); }
    if (s >= 16) {
        const int t = 256 * qb + wid * 32 + r32; const float* ct = WSP(float, WS_ROPE) + t * 32; const float* stb = ct + 1024 * 32;
#pragma unroll
        for (int pr = 0; pr < 2; ++pr) { const int ib = 16 * pr + 8 * hi; float n1[8], n2[8];
#pragma unroll
            for (int j = 0; j < 8; ++j) { const float c = ct[ib + j], sn = stb[ib + j], x1 = bf2f(qr[8 + pr][j]), x2 = bf2f(qr[10 + pr][j]); n1[j] = x1 * c - x2 * sn; n2[j] = x1 * sn + x2 * c; }
            qr[8 + pr] = pack8(n1); qr[10 + pr] = pack8(n2); }
    }
    const bf16* KVb = WSP(bf16, WS_KV) + (size_t)kvr0 * 2048 + h * 256; const bf16* KRb = WSP(bf16, WS_KR) + (size_t)kvr0 * 64;
    int okn[2], ov[2], okr;
#pragma unroll
    for (int j = 0; j < 2; ++j) { const int p = 2 * wid + j;
        { const int row = 4 * p + (lane >> 4), ch = (lane & 15) ^ (row & 7); okn[j] = row * 2048 + 8 * ch; }
        { const int st = 2 * p + (lane >> 5), kk = 8 * (st >> 2) + ((lane & 31) >> 2), k = (kk & ~0xC) | ((kk & 4) << 1) | ((kk & 8) >> 1), col = 32 * (st & 3) + 8 * (lane & 3); ov[j] = k * 2048 + 128 + col; } }
    { const int row = 8 * wid + (lane >> 3), ch = (lane & 7) ^ ((row >> 1) & 7); okr = row * 64 + 8 * ch; }
#define AT_ISSUE(kt, b) do { LAS char* B_ = L0 + (b) * AT_BUF; const bf16* kv_ = KVb + (size_t)(kt) * (64 * 2048); \
        GLDS16(kv_ + ov[0], B_ + (2 * wid) * 1024); GLDS16(kv_ + ov[1], B_ + (2 * wid + 1) * 1024); \
        GLDS16(kv_ + okn[0], B_ + 16384 + (2 * wid) * 1024); GLDS16(kv_ + okn[1], B_ + 16384 + (2 * wid + 1) * 1024); \
        GLDS16(KRb + (size_t)(kt) * (64 * 64) + okr, B_ + 32768 + wid * 1024); } while (0)
    const int vb0 = (int)(unsigned)(size_t)L0 + v_rd_base(lane);
    float m_reg = -1e30f, l_reg = 0.f; f32x16 o[4];
#pragma unroll
    for (int d = 0; d < 4; ++d)
#pragma unroll
        for (int r = 0; r < 16; ++r) o[d][r] = 0.f;
    AT_ISSUE(0, 0);
    for (int kt = 0; kt < NT; ++kt) {
        VM_WAIT(); __syncthreads();
        if (kt + 1 < NT) AT_ISSUE(kt + 1, (kt + 1) & 1);
        const LAS char* Kn_lds = L0 + (kt & 1) * AT_BUF + 16384; const LAS char* Kr_lds = L0 + (kt & 1) * AT_BUF + 32768;
        f32x16 p0, p1;
#pragma unroll
        for (int r = 0; r < 16; ++r) { p0[r] = 0.f; p1[r] = 0.f; }
#pragma unroll
        for (int d0 = 0; d0 < 8; ++d0) { const int cb = (d0 * 16 + hi * 8) * 2;
            const bf16x8 b0 = *(const LAS bf16x8*)(Kn_lds + KSWZ(r32, cb)), b1 = *(const LAS bf16x8*)(Kn_lds + KSWZ(32 + r32, cb));
            p0 = __builtin_amdgcn_mfma_f32_32x32x16_bf16(b0, qr[d0], p0, 0, 0, 0); p1 = __builtin_amdgcn_mfma_f32_32x32x16_bf16(b1, qr[d0], p1, 0, 0, 0);
            if ((d0 & 3) == 3) SBAR(); }
#pragma unroll
        for (int d0 = 0; d0 < 4; ++d0) { const int ko = r32 * 128 + (((2 * d0 + hi) ^ ((r32 >> 1) & 7)) << 4);
            const bf16x8 b0 = *(const LAS bf16x8*)(Kr_lds + ko), b1 = *(const LAS bf16x8*)(Kr_lds + 32 * 128 + ko);
            p0 = __builtin_amdgcn_mfma_f32_32x32x16_bf16(b0, qr[8 + d0], p0, 0, 0, 0); p1 = __builtin_amdgcn_mfma_f32_32x32x16_bf16(b1, qr[8 + d0], p1, 0, 0, 0); }
        SBAR();
        float mn, alpha; bf16x8 pa0, pa1, pa2, pa3;
        partialSM(p0, p1, m_reg, mn, alpha);
        if (__any(alpha < 1.f)) { if (hi == 0) al_l[r32] = alpha; LDS_WAIT();
#pragma unroll
            for (int d = 0; d < 4; ++d)
#pragma unroll
                for (int r = 0; r < 16; ++r) o[d][r] *= al_l[crow(r, hi)]; }
        finishSM(p0, p1, alpha, l_reg, pa0, pa1, pa2, pa3); SBAR();
        pv_d0(o, vb0 + (kt & 1) * AT_BUF, pa0, pa1, pa2, pa3);
    }
    if (hi == 0) li_l[r32] = l_reg; LDS_WAIT();
    bf16* Ow = WSP(bf16, WS_MIX) + (size_t)(grow0 + wid * 32) * DM + h * 128 + r32;
#pragma unroll
    for (int r = 0; r < 16; ++r) { const int orow = crow(r, hi); const float rl = __builtin_amdgcn_rcpf(li_l[orow]);
#pragma unroll
        for (int d0 = 0; d0 < 4; ++d0) Ow[(size_t)orow * DM + d0 * 32] = f2bf(o[d0][r] * rl); }
#undef AT_ISSUE
}

__device__ __forceinline__ void four_unit(Frame& F, int s, int g, int ob) {
    const int wid = F.wave, lane = F.lane, r32 = lane & 31, hi = lane >> 5;
    const int T = s < 16 ? 256 : 1024, row0 = s < 16 ? 256 * s : NCTX + 1024 * (s - 16), NTH = T / 64, NT = 2 * NTH, ldp = 2 * T;
    LAS char* L0 = (LAS char*)F.lds;
    const bf16* Pw = (s < 16 ? WSP(bf16, WS_P256) : WSP(bf16, WS_P1024)) + (size_t)(256 * ob + wid * 32 + r32) * ldp + hi * 8;
    const bf16* Y = WSP(bf16, WS_Y) + (size_t)row0 * 1024 + g * 256;
    int ov[2];
#pragma unroll
    for (int j = 0; j < 2; ++j) { const int p = 2 * wid + j, st = 2 * p + (lane >> 5), kk = 8 * (st >> 2) + ((lane & 31) >> 2), k = (kk & ~0xC) | ((kk & 4) << 1) | ((kk & 8) >> 1), col = 32 * (st & 3) + 8 * (lane & 3); ov[j] = k * 1024 + col; }
    const int vb0 = (int)(unsigned)(size_t)L0 + v_rd_base(lane);
    bf16x8 na0, na1, na2, na3;
#define FO_ISSUE(kt, b) do { const int part_ = (kt) >= NTH ? 1 : 0; const bf16* yp_ = Y + (size_t)(64 * ((kt) - part_ * NTH)) * 1024 + part_ * 128; \
        GLDS16(yp_ + ov[0], L0 + (b) * 16384 + (2 * wid) * 1024); GLDS16(yp_ + ov[1], L0 + (b) * 16384 + (2 * wid + 1) * 1024); } while (0)
#define FO_LOADP(kt) do { na0 = *(const bf16x8*)(Pw + 64 * (kt)); na1 = *(const bf16x8*)(Pw + 64 * (kt) + 16); na2 = *(const bf16x8*)(Pw + 64 * (kt) + 32); na3 = *(const bf16x8*)(Pw + 64 * (kt) + 48); } while (0)
    f32x16 o[4];
#pragma unroll
    for (int d = 0; d < 4; ++d)
#pragma unroll
        for (int r = 0; r < 16; ++r) o[d][r] = 0.f;
    FO_ISSUE(0, 0); FO_LOADP(0);
    for (int kt = 0; kt < NT; ++kt) {
        VM_WAIT(); __syncthreads();
        const bf16x8 pa0 = na0, pa1 = na1, pa2 = na2, pa3 = na3;
        if (kt + 1 < NT) { FO_ISSUE(kt + 1, (kt + 1) & 1); FO_LOADP(kt + 1); }
        pv_d0(o, vb0 + (kt & 1) * 16384, pa0, pa1, pa2, pa3);
    }
    bf16* Ow = WSP(bf16, WS_MIX) + (size_t)(row0 + 256 * ob + wid * 32) * DM + 1024 + g * 128 + r32;
#pragma unroll
    for (int r = 0; r < 16; ++r) { const int orow = crow(r, hi);
#pragma unroll
        for (int d0 = 0; d0 < 4; ++d0) Ow[(size_t)orow * DM + d0 * 32] = f2bf(o[d0][r]); }
#undef FO_ISSUE
#undef FO_LOADP
}

constexpr int NUNITS = 704;
__device__ __forceinline__ void mixer_phase(Frame& F, int l) {
    gu32* ctr = F.ctl + CW_QUEUE + 64 * l;
    for (;;) {
        __syncthreads();
        if (F.tid == 0) F.MISC[0] = __hip_atomic_fetch_add(ctr, 1u, RLX_AGENT);
        __syncthreads();
        const int u = (int)F.MISC[0];
        if (u >= NUNITS) break;
        int ty, a, b, c;
        if (u < 64) { ty = 0; a = 16 + (u >> 4); b = (u & 15) >> 1; c = u & 1; }
        else if (u < 192) { const int i = u - 64; ty = 1; a = 16 + (i >> 5); b = (i >> 2) & 7; c = i & 3; }
        else if (u < 256) { const int i = u - 192; ty = 2; a = 16 + (i >> 4); b = (i >> 2) & 3; c = i & 3; }
        else if (u < 512) { const int i = u - 256; ty = 0; a = i >> 4; b = (i & 15) >> 1; c = i & 1; }
        else if (u < 640) { const int i = u - 512; ty = 1; a = i >> 3; b = i & 7; c = 0; }
        else { const int i = u - 640; ty = 2; a = i >> 2; b = i & 3; c = 0; }
        { int t_ = threadIdx.x; asm volatile("" : "+v"(t_)); F.tid = t_; F.lane = t_ & 63; F.wave = __builtin_amdgcn_readfirstlane(t_ >> 6); }
        if (ty == 0) scan_unit(F, l, a, b, c); else if (ty == 1) attn_unit(F, a, b, c); else four_unit(F, a, b, c);
    }
}

#ifndef MK_MODE
#define MK_MODE 1
#endif
struct Args { const float* in[NIN]; float* out; unsigned char* ws; int ph_lo, ph_hi, li, pad; };
__global__ void __launch_bounds__(NWAVES * 64, 2) mk_fwd(Args args) {
    extern __shared__ __attribute__((aligned(16))) unsigned char lds_raw[];
    Frame F;
    F.lds = (LAS unsigned char*)lds_raw;
    F.MISC = (volatile LAS unsigned*)(F.lds + MISC_OFF);
    F.tid = threadIdx.x; F.lane = F.tid & 63; F.wave = __builtin_amdgcn_readfirstlane(F.tid >> 6);
    F.G = gridDim.x; { const int bx = blockIdx.x; F.vcu = (F.G % 8 == 0) ? (bx % 8) * (F.G / 8) + bx / 8 : bx; }
    F.in = args.in; F.out = args.out; F.ws = args.ws; F.ctl = (gu32*)(args.ws + WS_CTL);
    for (int u = F.tid; u < (LDS_BYTES - LDSCTL_OFF) / 4; u += NWAVES * 64) ((LAS unsigned*)(F.lds + LDSCTL_OFF))[u] = 0u;
    __syncthreads();
    const int lo = args.ph_lo, hi = args.ph_hi;
    XcdBarrier bar; bar.bar = (unsigned*)(F.ctl + CW_BAR) + args.li * XCD_BAR_WORDS; bar.x = 0; bar.st = nullptr;
    if (hi - lo > 1) bar = xcd_barrier_post((unsigned*)(F.ctl + CW_BAR) + args.li * XCD_BAR_WORDS, F.MISC + 8);
#ifdef ONLY
#define KIND_ON(x) ((x) == ONLY)
#else
#define KIND_ON(x) true
#endif
#define IN(k) (lo <= (k) && (k) < hi)
#define RELANE() do { int t_ = threadIdx.x; asm volatile("" : "+v"(t_)); F.tid = t_; F.lane = t_ & 63; F.wave = __builtin_amdgcn_readfirstlane(t_ >> 6); } while (0)
#define SEAM(k) do { if (IN(k) && IN((k) + 1)) xcd_barrier(bar); } while (0)
    const int cb = (int)blockIdx.x;

    if (KIND_ON(0) && IN(0)) { RELANE(); p0_prologue(F); SEAM(0); }
    if (KIND_ON(1) && IN(1)) { RELANE(); norm_phase<0>(F, 0); SEAM(1); }
    for (int l = 0; l < DEPTH; ++l) {
        const int pb = 2 + 11 * l;
        if (KIND_ON(2) && IN(pb + 0)) {
            pg8::Gemm g{WSP(bf16, WS_H), WSP(bf16, WS_WIN) + (size_t)l * INP * DM, NTOK, INP, DM}; pg8::StaticOrder S; S.init(NTOK, INP, F.G, cb);
            pg8::EpiAny E{(void*)WSP(float, WS_PROJ), INP, 1};
            pg8::gemm_phase<pg8::EpiAny, pg8::StaticOrder, true, true>(F.lds + RING_OFF, g, S, E);
            SEAM(pb + 0);
        }
        if (KIND_ON(3) && IN(pb + 1)) { RELANE(); prep_phase(F, l); SEAM(pb + 1); }
        if (KIND_ON(4) && IN(pb + 2)) {
            for (int gi = 0; gi < 4; ++gi) {
                const bf16* A_; const bf16* B_; void* O_; int M_, N_, K_, f_, rot_;
                if (gi == 0) { A_ = WSP(bf16, WS_QN); B_ = WSP(bf16, WS_WUQ) + (size_t)l * QW * 512; O_ = WSP(bf16, WS_Q); M_ = NTOK; N_ = QW; K_ = 512; f_ = 0; rot_ = 0; }
                else if (gi == 1) { A_ = WSP(bf16, WS_XF); B_ = WSP(bf16, WS_MBD); O_ = WSP(bf16, WS_Y); M_ = NTOK; N_ = 1024; K_ = 512; f_ = 0; rot_ = 192; }
                else if (gi == 2) { A_ = WSP(bf16, WS_CKVA); B_ = WSP(bf16, WS_WUKV) + (size_t)l * 2048 * 256; O_ = WSP(bf16, WS_KV); M_ = KVROWS; N_ = 2048; K_ = 256; f_ = 0; rot_ = 64; }
                else { A_ = WSP(bf16, WS_AL); B_ = WSP(bf16, WS_WL) + (size_t)l * LORAN * 256; O_ = WSP(float, WS_LORA); M_ = NTOK; N_ = LORAN; K_ = 256; f_ = 1; rot_ = 96; }
                pg8::Gemm g{A_, B_, M_, N_, K_}; pg8::StaticOrder S; S.init(M_, N_, F.G, (cb + F.G - rot_ % F.G) % F.G);
                pg8::EpiAny E{O_, N_, f_};
                pg8::gemm_phase<pg8::EpiAny, pg8::StaticOrder, true, true>(F.lds + RING_OFF, g, S, E);
            }
            SEAM(pb + 2);
        }
        if (KIND_ON(5) && IN(pb + 3)) { RELANE(); mixer_phase(F, l); SEAM(pb + 3); }
        if (KIND_ON(6) && IN(pb + 4)) { RELANE(); post_phase(F, l); SEAM(pb + 4); }
        if (KIND_ON(7) && IN(pb + 5)) {
            pg8::Gemm g{WSP(bf16, WS_MIX), WSP(bf16, WS_WOUT) + (size_t)l * DM * DM, NTOK, DM, DM}; pg8::StaticOrder S; S.init(NTOK, DM, F.G, cb);
            pg8::EpiAny E{(void*)WSP(float, WS_O), DM, 1};
            pg8::gemm_phase<pg8::EpiAny, pg8::StaticOrder, true, true>(F.lds + RING_OFF, g, S, E);
            SEAM(pb + 5);
        }
        if (KIND_ON(8) && IN(pb + 6)) { RELANE(); norm_phase<1>(F, l); SEAM(pb + 6); }
        if (KIND_ON(9) && IN(pb + 7)) {
            pg8::Gemm g{WSP(bf16, WS_H), WSP(bf16, WS_WUP) + (size_t)l * UPN * DM, NTOK, UPN, DM}; pg8::StaticOrder S; S.init(NTOK, UPN, F.G, cb);
            pg8::EpiAny E{(void*)WSP(bf16, WS_U), UPN, 0};
            pg8::gemm_phase<pg8::EpiAny, pg8::StaticOrder, true, true>(F.lds + RING_OFF, g, S, E);
            SEAM(pb + 7);
        }
        if (KIND_ON(10) && IN(pb + 8)) { RELANE(); ffn_act_phase(F, l); SEAM(pb + 8); }
        if (KIND_ON(11) && IN(pb + 9)) {
            pg8::Gemm g{WSP(bf16, WS_ACT), WSP(bf16, WS_WDN) + (size_t)l * DM * DFF, NTOK, DM, DFF}; pg8::StaticOrder S; S.init(NTOK, DM, F.G, cb);
            pg8::EpiAny E{(void*)WSP(float, WS_O), DM, 1};
            pg8::gemm_phase<pg8::EpiAny, pg8::StaticOrder, true, true>(F.lds + RING_OFF, g, S, E);
            SEAM(pb + 9);
        }
        if (KIND_ON(12) && IN(pb + 10)) { RELANE(); norm_phase<2>(F, l); SEAM(pb + 10); }
    }
#undef IN
#undef SEAM
}

extern "C" void kernel_launch(void* const* d_in, const int* in_sizes, int n_in, void* d_out, int out_size, void* d_ws, size_t ws_size, hipStream_t stream) {
    static int grid = 0;
    if (grid == 0) {
        if (n_in != NIN || (size_t)out_size != OUT_END || ws_size < WS_END) { fprintf(stderr, "kernel_launch: built for %d inputs, %zu outputs, >= %zu bytes of workspace; got n_in %d, out %d, ws %zu; nothing launched\n", NIN, (size_t)OUT_END, (size_t)WS_END, n_in, out_size, ws_size); grid = -1; return; }
        int dev = 0, cus = 0, per_cu = 0;
        if (hipGetDevice(&dev) != hipSuccess || hipDeviceGetAttribute(&cus, hipDeviceAttributeMultiprocessorCount, dev) != hipSuccess) { fprintf(stderr, "kernel_launch: device query failed\n"); grid = -1; return; }
        if (hipFuncSetAttribute((const void*)mk_fwd, hipFuncAttributeMaxDynamicSharedMemorySize, LDS_BYTES) != hipSuccess) { fprintf(stderr, "kernel_launch: hipFuncSetAttribute failed\n"); grid = -1; return; }
        if (hipOccupancyMaxActiveBlocksPerMultiprocessor(&per_cu, (const void*)mk_fwd, NWAVES * 64, LDS_BYTES) != hipSuccess || per_cu < 1)
            fprintf(stderr, "kernel_launch: note: occupancy query reports %d workgroups per CU\n", per_cu);
        (void)hipGetLastError();
        grid = cus;
    }
    if (grid < 0) return;
    if (hipMemsetAsync((char*)d_ws + WS_CTL, 0, CTL_BYTES, stream) != hipSuccess) { fprintf(stderr, "kernel_launch: memset failed\n"); return; }
    Args a{};
    for (int i = 0; i < NIN; ++i) a.in[i] = (const float*)d_in[i];
    a.out = (float*)d_out; a.ws = (unsigned char*)d_ws; a.pad = 0;
#if MK_MODE == 1
    const int nl = 1; const int cuts[2] = {0, NPHASES};
#else
    const int nl = NPHASES; int cuts[NPHASES + 1]; for (int i = 0; i <= NPHASES; ++i) cuts[i] = i;
#endif
    for (int li = 0; li < nl; ++li) {
        a.ph_lo = cuts[li]; a.ph_hi = cuts[li + 1]; a.li = li;
        hipLaunchKernelGGL(mk_fwd, dim3(grid), dim3(NWAVES * 64), LDS_BYTES, stream, a);
        const hipError_t le = hipPeekAtLastError();
        if (le != hipSuccess) { fprintf(stderr, "kernel_launch: launch %d failed: %s\n", li, hipGetErrorName(le)); break; }
    }
}
```

```cpp
#include <hip/hip_runtime.h>
#include <cstdio>
#include <cstdint>
namespace pg8 {
#define PG8_LAS __attribute__((address_space(3)))
typedef unsigned short bf16_t;
typedef short bf16x8 __attribute__((ext_vector_type(8)));
typedef float f32x4 __attribute__((ext_vector_type(4)));
typedef unsigned u32x4 __attribute__((ext_vector_type(4)));
constexpr int BM = 256, BK = 64, HALF = 128, HTB = HALF * BK * 2  , STAGE_BYTES = 8 * HTB, NXCD = 8, WGM = 8;

__host__ __device__ __forceinline__ int lds_byte(int r, int c) { const int st = (r >> 4) * 2 + (c >> 5), rr = r & 15, cc = c & 31, ob = rr * 64 + cc * 2; return st * 1024 + (ob ^ (((ob >> 9) & 1) << 5)); }
__host__ __device__ __forceinline__ void stage_rc(int b, int& R, int& C) { const int st = b / 1024, sb = b % 1024, swz = sb ^ (((sb >> 9) & 1) << 5); R = (st >> 1) * 16 + swz / 64; C = (st & 1) * 32 + (swz % 64) / 2; }
__host__ __device__ __forceinline__ int perm32(int rho) { const int n = rho >> 4, i = rho & 15; return 8 * (i >> 2) + 4 * n + (i & 3); }

struct Unit { int pm, pn; };
struct Gemm { const bf16_t* A; const bf16_t* Bt; int M, N, K, lda; };

struct StaticOrder {
    int nM, nN, nwg, G, c;
    __host__ __device__ void init(int M, int N, int G_, int c_) { nM = M / BM; nN = N / BM; nwg = nM * nN; G = G_; c = c_; }
    __host__ __device__ bool next(int i, Unit& u) const {
        const long L = (long)i * G + c; if (L >= nwg) return false;
        int wgid = (int)L; { const int q = nwg / NXCD, r = nwg % NXCD, xcd = wgid % NXCD, off = wgid / NXCD; wgid = (xcd < r ? xcd * (q + 1) : r * (q + 1) + (xcd - r) * q) + off; }
        const int nig = WGM * nN, gid = wgid / nig, fm = gid * WGM, gsz = (nM - fm) < WGM ? (nM - fm) : WGM;
        u.pm = fm + ((wgid % nig) % gsz); u.pn = (wgid % nig) / gsz; return true;
    }
    __device__ __forceinline__ void a_ready(const Unit&) const {}
    __device__ __forceinline__ void done(const Unit&) const {}
};

__device__ __forceinline__ unsigned cvt_pk_bf16(float lo, float hi) { unsigned r; asm volatile("v_cvt_pk_bf16_f32 %0, %1, %2" : "=v"(r) : "v"(lo), "v"(hi)); return r; }
typedef float f32x2 __attribute__((ext_vector_type(2)));
struct EpiF32 {
    static constexpr bool PERM = false, AFTER_DRAIN = false;
    float* C; int ldc; const float* bias;
    __device__ __forceinline__ void operator()(const f32x4 (&acc)[2][2][4][2], const Unit& u, int wr, int wc, int fr, int fq) const {
        const int row0 = u.pm * BM + wr * 64 + fr, col0 = u.pn * BM + wc * 32 + 4 * fq;
        f32x4 bv[2][2];
#pragma unroll
        for (int bj = 0; bj < 2; ++bj)
#pragma unroll
            for (int n = 0; n < 2; ++n) bv[bj][n] = bias ? *(const f32x4*)(bias + col0 + bj * HALF + n * 16) : (f32x4){0.f, 0.f, 0.f, 0.f};
#pragma unroll
        for (int ai = 0; ai < 2; ++ai)
#pragma unroll
            for (int m = 0; m < 4; ++m) { float* rowp = C + (size_t)(row0 + ai * HALF + m * 16) * ldc + col0;
#pragma unroll
                for (int bj = 0; bj < 2; ++bj)
#pragma unroll
                    for (int n = 0; n < 2; ++n) *(f32x4*)(rowp + bj * HALF + n * 16) = acc[ai][bj][m][n] + bv[bj][n]; }
    }
};
struct EpiAny {
    static constexpr bool PERM = true, AFTER_DRAIN = false;
    void* O; int ldc; int f32;
    __device__ __forceinline__ void operator()(const f32x4 (&acc)[2][2][4][2], const Unit& u, int wr, int wc, int fr, int fq) const {
        const int row0 = u.pm * BM + wr * 64 + fr, col0 = u.pn * BM + wc * 32 + 8 * fq;
        if (f32) {
#pragma unroll
            for (int ai = 0; ai < 2; ++ai)
#pragma unroll
                for (int m = 0; m < 4; ++m) { float* rowp = (float*)O + (size_t)(row0 + ai * HALF + m * 16) * ldc + col0;
#pragma unroll
                    for (int bj = 0; bj < 2; ++bj) { *(f32x4*)(rowp + bj * HALF) = acc[ai][bj][m][0]; *(f32x4*)(rowp + bj * HALF + 4) = acc[ai][bj][m][1]; } }
        } else {
#pragma unroll
            for (int ai = 0; ai < 2; ++ai)
#pragma unroll
                for (int m = 0; m < 4; ++m) { bf16_t* rowp = (bf16_t*)O + (size_t)(row0 + ai * HALF + m * 16) * ldc + col0;
#pragma unroll
                    for (int bj = 0; bj < 2; ++bj) { const f32x4 v0 = acc[ai][bj][m][0], v1 = acc[ai][bj][m][1];
                        u32x4 w; w.x = cvt_pk_bf16(v0[0], v0[1]); w.y = cvt_pk_bf16(v0[2], v0[3]); w.z = cvt_pk_bf16(v1[0], v1[1]); w.w = cvt_pk_bf16(v1[2], v1[3]);
                        *(u32x4*)(rowp + bj * HALF) = w; } }
        }
    }
};
template <class Epi, class Sched, bool ALIGN_EPI = false, bool SP2 = false>
__device__ __forceinline__ void gemm_phase(PG8_LAS unsigned char* lds, const Gemm g, const Sched& S, const Epi& E) {
    int tid_ = threadIdx.x; asm volatile("" : "+v"(tid_));
    const int tid = tid_, wid = __builtin_amdgcn_readfirstlane(tid >> 6), lane = tid & 63, wr = wid >> 2, wc = wid & 3, fr = lane & 15, fq = lane >> 4;
    const int K = g.K, nt = K / BK;
    unsigned voffA[2], voffB[2];
#pragma unroll
    for (int i = 0; i < 2; ++i) { int R, C; stage_rc(tid * 16 + i * 8192, R, C); const int Rb = Epi::PERM ? ((R & ~31) + perm32(R & 31)) : R;
        voffA[i] = (unsigned)(R * g.lda + C) * 2u; voffB[i] = (unsigned)(Rb * K + C) * 2u; }
    const size_t kstep = (size_t)(BK * 2);
    const size_t hstep = (size_t)HALF * K * 2;
    const size_t tstep = 2 * hstep;
    const size_t hstepA = (size_t)HALF * g.lda * 2, tstepA = 2 * hstepA;
    const unsigned ldsw = (unsigned)wid * 1024u;
    const int aoff = lds_byte(wr * 64 + fr, fq * 8), boff = lds_byte(wc * 32 + fr, fq * 8);
#define PG8_SA(b, h) (((b) * 2 + (h)) * HTB)
#define PG8_SB(b, h) ((4 + (b) * 2 + (h)) * HTB)
#define PG8_STAGE(bufoff, gbase, voff) do { _Pragma("unroll") for (int _i = 0; _i < 2; ++_i) \
        __builtin_amdgcn_global_load_lds((const unsigned*)((const char*)(gbase) + (voff)[_i]), (PG8_LAS unsigned*)(lds + (bufoff) + ldsw + _i * 8192), 16, 0, 0); } while (0)
#define PG8_LDA(dst, b, h) do { _Pragma("unroll") for (int m = 0; m < 4; ++m) _Pragma("unroll") for (int k = 0; k < 2; ++k) dst[m][k] = *(const PG8_LAS bf16x8*)(lds + PG8_SA(b, h) + aoff + m * 2048 + k * 1024); } while (0)
#define PG8_LDB(dst, b, h) do { _Pragma("unroll") for (int n = 0; n < 2; ++n) _Pragma("unroll") for (int k = 0; k < 2; ++k) dst[n][k] = *(const PG8_LAS bf16x8*)(lds + PG8_SB(b, h) + boff + n * 2048 + k * 1024); } while (0)
#define PG8_MMA(ai, bj, At, Bt) do { __builtin_amdgcn_s_setprio(1); _Pragma("unroll") for (int m = 0; m < 4; ++m) _Pragma("unroll") for (int n = 0; n < 2; ++n) _Pragma("unroll") for (int k = 0; k < 2; ++k) \
        acc[ai][bj][m][n] = __builtin_amdgcn_mfma_f32_16x16x32_bf16(Bt[n][k], At[m][k], acc[ai][bj][m][n], 0, 0, 0); __builtin_amdgcn_s_setprio(0); } while (0)
#define PG8_WAIT_V(n) asm volatile("s_waitcnt vmcnt(" #n ")" ::: "memory")
#define PG8_WAIT_L(n) asm volatile("s_waitcnt lgkmcnt(" #n ")" ::: "memory")
#define PG8_BAR __builtin_amdgcn_s_barrier()
#define PG8_SCHED __builtin_amdgcn_sched_barrier(0)
    Unit cur, nxt; int ui = 0;
    if (!S.next(0, cur)) return;
    f32x4 acc[2][2][4][2];
#pragma unroll
    for (int a = 0; a < 2; ++a)
#pragma unroll
        for (int b = 0; b < 2; ++b)
#pragma unroll
            for (int m = 0; m < 4; ++m)
#pragma unroll
                for (int n = 0; n < 2; ++n) acc[a][b][m][n] = (f32x4){0.f, 0.f, 0.f, 0.f};
    bf16x8 At[4][2], B0[2][2], B1[2][2];
    const char* cA = (const char*)g.A + (size_t)cur.pm * tstepA; const char* cB = (const char*)g.Bt + (size_t)cur.pn * tstep;
    S.a_ready(cur);
    if constexpr (SP2) {
        PG8_STAGE(PG8_SB(0, 0), cB, voffB); PG8_STAGE(PG8_SB(0, 1), cB + hstep, voffB); PG8_STAGE(PG8_SA(0, 0), cA, voffA); PG8_STAGE(PG8_SA(0, 1), cA + hstepA, voffA);
        if (wr == 1) PG8_BAR;
        PG8_WAIT_V(2); PG8_BAR;
        PG8_STAGE(PG8_SB(1, 0), cB + kstep, voffB); PG8_STAGE(PG8_SA(1, 0), cA + kstep, voffA); PG8_STAGE(PG8_SB(1, 1), cB + hstep + kstep, voffB);
        PG8_WAIT_V(6); PG8_BAR;
    } else {
        PG8_STAGE(PG8_SB(0, 0), cB, voffB); PG8_STAGE(PG8_SA(0, 0), cA, voffA); PG8_STAGE(PG8_SB(0, 1), cB + hstep, voffB); PG8_STAGE(PG8_SA(0, 1), cA + hstepA, voffA);
        if (wr == 1) PG8_BAR;
        PG8_WAIT_V(4); PG8_BAR;
        PG8_STAGE(PG8_SB(1, 0), cB + kstep, voffB); PG8_STAGE(PG8_SA(1, 0), cA + kstep, voffA); PG8_STAGE(PG8_SB(1, 1), cB + hstep + kstep, voffB);
        PG8_WAIT_V(6); PG8_BAR;
    }
    for (;;) {
        const bool has_next = S.next(ui + 1, nxt);
        const char* nA = has_next ? (const char*)g.A + (size_t)nxt.pm * tstepA : cA; const char* nB = has_next ? (const char*)g.Bt + (size_t)nxt.pn * tstep : cB;
        for (int t = 0; t < nt; t += 2) {
            const bool last = (t == nt - 2);
            const char* a1 = cA + (size_t)(t + 1) * kstep;
            const char* a2 = last ? nA : cA + (size_t)(t + 2) * kstep; const char* b2 = last ? nB : cB + (size_t)(t + 2) * kstep;
            const char* a3 = a2 + kstep; const char* b3 = b2 + kstep;
            if (last && has_next) S.a_ready(nxt);
            if constexpr (SP2) {
            PG8_LDB(B0, 0, 0); PG8_LDB(B1, 0, 1); PG8_SCHED; PG8_LDA(At, 0, 0); PG8_STAGE(PG8_SA(1, 1), a1 + hstepA, voffA);
            PG8_WAIT_V(8); PG8_WAIT_L(0); PG8_BAR; PG8_MMA(0, 0, At, B0); PG8_MMA(0, 1, At, B1); PG8_BAR; PG8_SCHED;
            PG8_LDA(At, 0, 1); PG8_STAGE(PG8_SB(0, 0), b2, voffB); PG8_STAGE(PG8_SB(0, 1), b2 + hstep, voffB); PG8_STAGE(PG8_SA(0, 0), a2, voffA);
            PG8_WAIT_V(8); PG8_WAIT_L(0); PG8_BAR; PG8_MMA(1, 0, At, B0); PG8_MMA(1, 1, At, B1); PG8_BAR; PG8_SCHED;
            PG8_LDB(B0, 1, 0); PG8_LDB(B1, 1, 1); PG8_SCHED; PG8_LDA(At, 1, 0); PG8_STAGE(PG8_SA(0, 1), a2 + hstepA, voffA);
            PG8_WAIT_V(8); PG8_WAIT_L(0); PG8_BAR; PG8_MMA(0, 0, At, B0); PG8_MMA(0, 1, At, B1); PG8_BAR; PG8_SCHED;
            PG8_LDA(At, 1, 1); PG8_STAGE(PG8_SB(1, 0), b3, voffB); PG8_STAGE(PG8_SB(1, 1), b3 + hstep, voffB); PG8_STAGE(PG8_SA(1, 0), a3, voffA);
            PG8_WAIT_V(8); PG8_WAIT_L(0); PG8_BAR; PG8_MMA(1, 0, At, B0); PG8_MMA(1, 1, At, B1); PG8_BAR; PG8_SCHED;
            } else {
            PG8_LDB(B0, 0, 0); PG8_SCHED; PG8_LDA(At, 0, 0); PG8_STAGE(PG8_SA(1, 1), a1 + hstepA, voffA);
            PG8_WAIT_L(8); PG8_BAR; PG8_WAIT_L(0); PG8_MMA(0, 0, At, B0); PG8_BAR; PG8_SCHED;
            PG8_LDB(B1, 0, 1); PG8_STAGE(PG8_SB(0, 0), b2, voffB);
            PG8_BAR; PG8_WAIT_L(0); PG8_MMA(0, 1, At, B1); PG8_BAR;
            PG8_LDA(At, 0, 1); PG8_STAGE(PG8_SA(0, 0), a2, voffA);
            PG8_BAR; PG8_WAIT_L(0); PG8_MMA(1, 0, At, B0); PG8_BAR; PG8_SCHED;
            PG8_STAGE(PG8_SB(0, 1), b2 + hstep, voffB);
            PG8_WAIT_V(6); PG8_BAR; PG8_MMA(1, 1, At, B1); PG8_BAR;
            PG8_LDB(B0, 1, 0); PG8_SCHED; PG8_LDA(At, 1, 0); PG8_STAGE(PG8_SA(0, 1), a2 + hstepA, voffA);
            PG8_WAIT_L(8); PG8_BAR; PG8_WAIT_L(0); PG8_MMA(0, 0, At, B0); PG8_BAR; PG8_SCHED;
            PG8_LDB(B1, 1, 1); PG8_STAGE(PG8_SB(1, 0), b3, voffB);
            PG8_BAR; PG8_WAIT_L(0); PG8_MMA(0, 1, At, B1); PG8_BAR;
            PG8_LDA(At, 1, 1); PG8_STAGE(PG8_SA(1, 0), a3, voffA);
            PG8_BAR; PG8_WAIT_L(0); PG8_MMA(1, 0, At, B0); PG8_BAR; PG8_SCHED;
            PG8_STAGE(PG8_SB(1, 1), b3 + hstep, voffB);
            PG8_WAIT_V(6); PG8_BAR; PG8_MMA(1, 1, At, B1); PG8_BAR;
            }
        }
        if constexpr (ALIGN_EPI) { if (wr == 0) PG8_BAR; }
        if constexpr (!Epi::AFTER_DRAIN) { E(acc, cur, wr, wc, fr, fq); S.done(cur); }
        if (!has_next) break;
#pragma unroll
        for (int a = 0; a < 2; ++a)
#pragma unroll
            for (int b = 0; b < 2; ++b)
#pragma unroll
                for (int m = 0; m < 4; ++m)
#pragma unroll
                    for (int n = 0; n < 2; ++n) acc[a][b][m][n] = (f32x4){0.f, 0.f, 0.f, 0.f};
        cur = nxt; cA = nA; cB = nB; ++ui;
        if constexpr (ALIGN_EPI) { if (wr == 1) PG8_BAR; }
    }
    PG8_WAIT_V(0);
    if constexpr (!ALIGN_EPI) { if (wr == 0) PG8_BAR; }
    PG8_BAR;
    if constexpr (Epi::AFTER_DRAIN) { E.fused(acc, cur, wr, wc, fr, fq, lds, wid, lane); S.done(cur); }
#undef PG8_SA
#undef PG8_SB
#undef PG8_STAGE
#undef PG8_LDA
#undef PG8_LDB
#undef PG8_MMA
#undef PG8_WAIT_V
#undef PG8_WAIT_L
#undef PG8_BAR
#undef PG8_SCHED
}
}

constexpr int DM = 2048, NTOK = 8192, NCTX = 4096, DEPTH = 4, NIN = 34;
constexpr int INW = 3136, INP = 3328;
constexpr int OFF_KV = 512, OFF_KR = 768, OFF_XF = 832, OFF_RKV = 1344, OFF_WLO = 2880, OFF_ALO = 2944, OFF_GLO = 3008;
constexpr int DFF = 5632, UPN = 11264, KVROWS = 9216, LORAN = 2560, QW = 1536;
constexpr float EPS = 1e-6f, GN_EPS = 64e-5f, DECAY_SCALE = 0.6065306597126334f;
enum { I_XP = 0, I_XS, I_CKV, I_CKR, I_ST, I_C, I_CCTX, I_WMOD, I_BMOD, I_GPREMIX, I_GPOSTMIX, I_GPREFFN, I_GPOSTFFN, I_WIN, I_GQ, I_WUQ, I_GKV, I_WUKV,
       I_RCONV, I_RW0, I_RW2, I_RA0, I_RA2, I_RG2, I_RKK, I_RKA, I_RRK, I_GNG, I_GNB, I_WOUT, I_WUP, I_FCONV, I_FCONVB, I_WDOWN };
constexpr size_t OUT_X = 0, OUT_CKV = (size_t)NTOK * DM, OUT_KR = OUT_CKV + (size_t)16 * 4 * 256 * 256, OUT_ST = OUT_KR + (size_t)16 * 4 * 256 * 64, OUT_END = OUT_ST + (size_t)16 * 4 * 2 * 8 * 64 * 64;

constexpr size_t A256(size_t x) { return (x + 255) & ~(size_t)255; }
constexpr size_t WS_CTL = 0, CTL_BYTES = 1u << 20;
constexpr size_t WS_MOD   = WS_CTL + CTL_BYTES;
constexpr size_t WS_ROPE  = WS_MOD + A256((size_t)4 * 5 * 12288 * 4);
constexpr size_t WS_P256  = WS_ROPE + A256((size_t)2 * 1024 * 32 * 4);
constexpr size_t WS_P1024 = WS_P256 + A256((size_t)256 * 512 * 2);
constexpr size_t WS_MBD   = WS_P1024 + A256((size_t)1024 * 2048 * 2);
constexpr size_t WS_WL    = WS_MBD + A256((size_t)1024 * 512 * 2);
constexpr size_t WS_WIN   = WS_WL + A256((size_t)4 * LORAN * 256 * 2);
constexpr size_t WS_WUQ   = WS_WIN + A256((size_t)4 * INP * DM * 2);
constexpr size_t WS_WUKV  = WS_WUQ + A256((size_t)4 * QW * 512 * 2);
constexpr size_t WS_WOUT  = WS_WUKV + A256((size_t)4 * 2048 * 256 * 2);
constexpr size_t WS_WUP   = WS_WOUT + A256((size_t)4 * DM * DM * 2);
constexpr size_t WS_WDN   = WS_WUP + A256((size_t)4 * UPN * DM * 2);
constexpr size_t WS_H     = WS_WDN + A256((size_t)4 * DM * DFF * 2);
constexpr size_t WS_PROJ  = WS_H + A256((size_t)NTOK * DM * 2);
constexpr size_t WS_QN    = WS_PROJ + A256((size_t)NTOK * INP * 2);
constexpr size_t WS_CKVA  = WS_QN + A256((size_t)NTOK * 512 * 2);
constexpr size_t WS_KR    = WS_CKVA + A256((size_t)KVROWS * 256 * 2);
constexpr size_t WS_AL    = WS_KR + A256((size_t)KVROWS * 64 * 2);
constexpr size_t WS_RC    = WS_AL + A256((size_t)NTOK * 256 * 2);
constexpr size_t WS_KC    = WS_RC + A256((size_t)NTOK * 512 * 4);
constexpr size_t WS_VC    = WS_KC + A256((size_t)NTOK * 512 * 4);
constexpr size_t WS_NK    = WS_VC + A256((size_t)NTOK * 512 * 4);
constexpr size_t WS_Q     = WS_NK + A256((size_t)NTOK * 8 * 4);
constexpr size_t WS_KV    = WS_Q + A256((size_t)NTOK * QW * 2);
constexpr size_t WS_LORA  = WS_KV + A256((size_t)KVROWS * 2048 * 2);
constexpr size_t WS_Y     = WS_LORA + A256((size_t)NTOK * LORAN * 4);
constexpr size_t WS_YF    = WS_Y + A256((size_t)NTOK * 1024 * 2);
constexpr size_t WS_YB    = WS_YF + A256((size_t)NTOK * 512 * 4);
constexpr size_t WS_BON   = WS_YB + A256((size_t)NTOK * 512 * 4);
constexpr size_t WS_MIX   = WS_BON + A256((size_t)2 * NTOK * 8 * 4);
constexpr size_t WS_O     = WS_MIX + A256((size_t)NTOK * DM * 2);
constexpr size_t WS_U     = WS_O + A256((size_t)NTOK * DM * 4);
constexpr size_t WS_ACT   = WS_U + A256((size_t)NTOK * UPN * 2);
constexpr size_t WS_END   = WS_ACT + A256((size_t)NTOK * DFF * 2);
constexpr int CW_TMO = 0, CW_CODE = 1, CW_QUEUE = 64  , CW_BAR = 4096;
constexpr int NPHASES = 2 + 11 * DEPTH;
constexpr int RING_OFF = 0, RING_BYTES = 131072, LDSCTL_OFF = RING_BYTES, MISC_OFF = LDSCTL_OFF + 320, LDS_BYTES = 147456, NWAVES = 8;

#define GAS __attribute__((address_space(1)))
#define LAS __attribute__((address_space(3)))
typedef unsigned short bf16;
typedef unsigned v4u __attribute__((ext_vector_type(4)));
typedef unsigned v2u __attribute__((ext_vector_type(2)));
typedef float f32x4 __attribute__((ext_vector_type(4)));
typedef float f32x2 __attribute__((ext_vector_type(2)));
typedef float f32x16 __attribute__((ext_vector_type(16)));
typedef short bf16x8 __attribute__((ext_vector_type(8)));
typedef short s16x4 __attribute__((ext_vector_type(4)));
typedef GAS unsigned gu32;
#define RLX_AGENT __ATOMIC_RELAXED, __HIP_MEMORY_SCOPE_AGENT
#define LDS_WAIT() asm volatile("s_waitcnt lgkmcnt(0)" ::: "memory")
#define VM_WAIT() asm volatile("s_waitcnt vmcnt(0)" ::: "memory")
#define SBAR() __builtin_amdgcn_sched_barrier(0)
__device__ __forceinline__ unsigned cvtpk(float lo, float hi) { unsigned r; asm volatile("v_cvt_pk_bf16_f32 %0, %1, %2" : "=v"(r) : "v"(lo), "v"(hi)); return r; }
__device__ __forceinline__ bf16 f2bf(float f) { return (bf16)(cvtpk(f, 0.f) & 0xffffu); }
__device__ __forceinline__ float bf2f(short s) { return __uint_as_float(((unsigned)(unsigned short)s) << 16); }
__device__ __forceinline__ float wave_sum(float v) {
#pragma unroll
    for (int o = 1; o < 64; o <<= 1) v += __shfl_xor(v, o);
    return v;
}
template <int CTRL> __device__ __forceinline__ float dpp_mov(float x) { return __int_as_float(__builtin_amdgcn_update_dpp(0, __float_as_int(x), CTRL, 0xf, 0xf, true)); }
__device__ __forceinline__ float allred16(float x) {
    x += dpp_mov<0xB1>(x);
    x += dpp_mov<0x4E>(x);
    x += dpp_mov<0x141>(x);
    x += dpp_mov<0x140>(x);
    return x;
}
__device__ __forceinline__ float sigmoidf_(float x) { return 1.0f / (1.0f + __expf(-x)); }
#define XB_TMO      128
#define XB_XCNT(j)  (256  + 64 * (j))
#define XB_XSUB(j)  (1280 + 64 * (j))
#define XB_XGEN(j)  (2304 + 64 * (j))
#define XB_TOP      3328
#define XB_TOPGEN   3392
#define XCD_BAR_WORDS 3456
#define XB_SPIN_CAP (1u << 18)

__device__ __forceinline__ unsigned xb_ld(unsigned* p)              { return __hip_atomic_load(p, __ATOMIC_RELAXED, __HIP_MEMORY_SCOPE_AGENT); }
__device__ __forceinline__ unsigned xb_add(unsigned* p, unsigned v) { return __hip_atomic_fetch_add(p, v, __ATOMIC_RELAXED, __HIP_MEMORY_SCOPE_AGENT); }
__device__ __forceinline__ unsigned xb_xcc_id() { return (unsigned)__builtin_amdgcn_s_getreg((3 << 11) | 20) & 0xFu; }
#define XB_SPIN(cond, bar) do { unsigned _sp = 0; while (cond) { __builtin_amdgcn_s_sleep(1); \
    if ((++_sp & 255u) == 0u) { if (xb_ld(&(bar)[XB_TMO])) break; if (_sp > XB_SPIN_CAP) { atomicAdd(&(bar)[XB_TMO], 1u); break; } } } } while (0)

struct XcdBarrier {
    unsigned* bar; unsigned x;
    volatile LAS unsigned* st;
};

__device__ __forceinline__ XcdBarrier xcd_barrier_post(unsigned* bar, volatile LAS unsigned* st) {
    XcdBarrier b; b.bar = bar; b.x = xb_xcc_id(); b.st = st;
    if (threadIdx.x == 0) (void)xb_add(&bar[XB_XCNT(b.x)], 1u);
    return b;
}
__device__ __forceinline__ void xcd_barrier_complete(unsigned* bar, unsigned x, unsigned& nloc, unsigned& nx) {
    const unsigned G = gridDim.x * gridDim.y * gridDim.z;
    unsigned sum, cnt, mine, sp = 0u;
    for (;;) {
        sum = 0u; cnt = 0u; mine = 0u;
#pragma unroll
        for (unsigned j = 0; j < 16; ++j) { const unsigned c = xb_ld(&bar[XB_XCNT(j)]); sum += c; cnt += (c > 0u) ? 1u : 0u; mine = (j == x) ? c : mine; }
        if (sum == G) break;
        __builtin_amdgcn_s_sleep(1);
        if ((++sp & 255u) == 0u) { if (xb_ld(&bar[XB_TMO])) break; if (sp > XB_SPIN_CAP) { atomicAdd(&bar[XB_TMO], 1u); break; } }
    }
    nloc = mine > 0u ? mine : 1u; nx = cnt > 0u ? cnt : 1u;
}

__device__ __forceinline__ void xcd_barrier(const XcdBarrier& b) {
    asm volatile("s_waitcnt vmcnt(0)" ::: "memory");
    __syncthreads();
    if (threadIdx.x == 0) {
        unsigned* bar = b.bar;
        __builtin_amdgcn_s_waitcnt(0);
        unsigned nloc = b.st[0], nx = b.st[1];
        if (nloc == 0u) { xcd_barrier_complete(bar, b.x, nloc, nx); b.st[0] = nloc; b.st[1] = nx; }
        const unsigned old = xb_add(&bar[XB_XSUB(b.x)], 1u);
        const unsigned gen = old / nloc;
        if (old + 1u == (gen + 1u) * nloc) {
            __builtin_amdgcn_fence(__ATOMIC_RELEASE, "agent");
            asm volatile("s_waitcnt vmcnt(0)" ::: "memory");
            const unsigned og = xb_add(&bar[XB_TOP], 1u);
            const unsigned tg = og / nx;
            if (og + 1u == (tg + 1u) * nx) xb_add(&bar[XB_TOPGEN], 1u);
            else XB_SPIN(xb_ld(&bar[XB_TOPGEN]) == tg, bar);
            __builtin_amdgcn_fence(__ATOMIC_ACQUIRE, "agent");
            xb_add(&bar[XB_XGEN(b.x)], 1u);
            asm volatile("s_waitcnt vmcnt(0)" ::: "memory");
        } else {
            XB_SPIN(xb_ld(&bar[XB_XGEN(b.x)]) == gen, bar);
            __builtin_amdgcn_fence(__ATOMIC_ACQUIRE, "agent");
            asm volatile("s_waitcnt vmcnt(0)" ::: "memory");
        }
    }
    __syncthreads();
}

struct Frame {
    LAS unsigned char* lds;
    volatile LAS unsigned* MISC;
    gu32* ctl;
    int tid, lane, wave, vcu, G;
    const float* const* in;
    float* out; unsigned char* ws;
};
#define WSP(T, off) ((T*)(F.ws + (off)))

__device__ __forceinline__ void p0_transpose_item(const float* W, int K, int N, bf16* WT, LAS float* scr, int item, int lane) {
    const int nblk = N / 32, kb = item / nblk, nb = item % nblk, k0 = 64 * kb, n0 = 32 * nb;
#pragma unroll 8
    for (int i = 0; i < 32; ++i) { const int kk = 2 * i + (lane >> 5); scr[kk * 33 + (lane & 31)] = W[(size_t)(k0 + kk) * N + n0 + (lane & 31)]; }
    LDS_WAIT(); asm volatile("" ::: "memory");
    const int c = lane & 7;
#pragma unroll
    for (int j = 0; j < 4; ++j) { const int n = (lane >> 3) + 8 * j; const LAS float* s = scr + (8 * c) * 33 + n;
        v4u o; o.x = cvtpk(s[0 * 33], s[1 * 33]); o.y = cvtpk(s[2 * 33], s[3 * 33]); o.z = cvtpk(s[4 * 33], s[5 * 33]); o.w = cvtpk(s[6 * 33], s[7 * 33]);
        *(GAS v4u*)(WT + (size_t)(n0 + n) * K + k0 + 8 * c) = o; }
    LDS_WAIT(); asm volatile("" ::: "memory");
}
constexpr int I_IN = (DM / 64) * (INW / 32), I_UQ = (512 / 64) * (QW / 32), I_UKV = (256 / 64) * (2048 / 32), I_OUT = (DM / 64) * (DM / 32), I_UP = (DM / 64) * (UPN / 32), I_DN = (DFF / 64) * (DM / 32);
constexpr int I_LAYER = I_IN + I_UQ + I_UKV + I_OUT + I_UP + I_DN;
__device__ __forceinline__ void convert_wave_item(Frame& F, int l, int r, LAS float* scr) {
    if (r < I_IN) { p0_transpose_item(F.in[I_WIN] + (size_t)l * DM * INW, DM, INW, WSP(bf16, WS_WIN) + (size_t)l * INP * DM, scr, r, F.lane); return; } r -= I_IN;
    if (r < I_UQ) { p0_transpose_item(F.in[I_WUQ] + (size_t)l * 512 * QW, 512, QW, WSP(bf16, WS_WUQ) + (size_t)l * QW * 512, scr, r, F.lane); return; } r -= I_UQ;
    if (r < I_UKV) { p0_transpose_item(F.in[I_WUKV] + (size_t)l * 256 * 2048, 256, 2048, WSP(bf16, WS_WUKV) + (size_t)l * 2048 * 256, scr, r, F.lane); return; } r -= I_UKV;
    if (r < I_OUT) { p0_transpose_item(F.in[I_WOUT] + (size_t)l * DM * DM, DM, DM, WSP(bf16, WS_WOUT) + (size_t)l * DM * DM, scr, r, F.lane); return; } r -= I_OUT;
    if (r < I_UP) { p0_transpose_item(F.in[I_WUP] + (size_t)l * DM * UPN, DM, UPN, WSP(bf16, WS_WUP) + (size_t)l * UPN * DM, scr, r, F.lane); return; } r -= I_UP;
    p0_transpose_item(F.in[I_WDOWN] + (size_t)l * DFF * DM, DFF, DM, WSP(bf16, WS_WDN) + (size_t)l * DM * DFF, scr, r, F.lane);
}
__device__ __forceinline__ void mod_block_item(Frame& F, int l, int ch) {
    LAS float* sc = (LAS float*)(F.lds);
    LAS float* red = (LAS float*)(F.lds + 40960);
    for (int i = F.tid; i < 5 * 2048; i += 512) { const int cd = i >> 11, k = i & 2047; const float x = (cd == 0) ? F.in[I_CCTX][k] : F.in[I_C][(cd - 1) * 2048 + k]; sc[i] = x * sigmoidf_(x); }
    __syncthreads();
    const int kh = F.lane >> 5, c4 = F.lane & 31;
    const float* wp = F.in[I_WMOD] + (size_t)l * DM * 12288 + (size_t)ch * 128 + 4 * c4;
    f32x4 a0 = {0.f, 0.f, 0.f, 0.f}, a1 = a0, a2 = a0, a3 = a0, a4 = a0;
#pragma unroll 8
    for (int i = 0; i < 128; ++i) { const int k = 256 * F.wave + 2 * i + kh; const f32x4 wv = *(const f32x4*)(wp + (size_t)k * 12288);
        a0 += wv * sc[k]; a1 += wv * sc[2048 + k]; a2 += wv * sc[4096 + k]; a3 += wv * sc[6144 + k]; a4 += wv * sc[8192 + k]; }
    const int part = F.wave * 2 + kh;
    *(LAS f32x4*)(red + (part * 5 + 0) * 128 + 4 * c4) = a0; *(LAS f32x4*)(red + (part * 5 + 1) * 128 + 4 * c4) = a1; *(LAS f32x4*)(red + (part * 5 + 2) * 128 + 4 * c4) = a2;
    *(LAS f32x4*)(red + (part * 5 + 3) * 128 + 4 * c4) = a3; *(LAS f32x4*)(red + (part * 5 + 4) * 128 + 4 * c4) = a4;
    __syncthreads();
    for (int i = F.tid; i < 640; i += 512) { const int cd = i >> 7, col = i & 127; float s = F.in[I_BMOD][(size_t)l * 12288 + ch * 128 + col];
#pragma unroll
        for (int p = 0; p < 16; ++p) s += red[(p * 5 + cd) * 128 + col];
        WSP(float, WS_MOD)[((size_t)l * 5 + cd) * 12288 + ch * 128 + col] = s; }
    __syncthreads();
}
__device__ __forceinline__ void p0_prologue(Frame& F) {
    LAS float* scr = (LAS float*)(F.lds + RING_OFF + F.wave * 16384);
    const int gw = F.vcu * NWAVES + F.wave, NGW = F.G * NWAVES;
    for (int it = gw; it < I_LAYER; it += NGW) convert_wave_item(F, 0, it, scr);
    const long gt = (long)F.vcu * 512 + F.tid, NGT = (long)F.G * 512;
    for (long i = gt; i < (long)DEPTH * (INP - INW) * DM / 8; i += NGT) { const int l = (int)(i / ((INP - INW) * DM / 8)); const long r = i % ((INP - INW) * DM / 8);
        *(v4u*)(WSP(bf16, WS_WIN) + (size_t)l * INP * DM + (size_t)INW * DM + r * 8) = (v4u){0u, 0u, 0u, 0u}; }
    for (long i = gt; i < (long)DEPTH * LORAN * 256; i += NGT) { const int l = (int)(i / (LORAN * 256)), n = (int)((i / 256) % LORAN), k = (int)(i & 255);
        float v = 0.f;
        if (n < 1024) { if (k < 64) v = F.in[I_RW2][(((size_t)l * 2 + (n >> 9)) * 64 + k) * 512 + (n & 511)]; }
        else if (n < 2048) { if (k >= 64 && k < 128) v = F.in[I_RA2][(((size_t)l * 2 + ((n - 1024) >> 9)) * 64 + (k - 64)) * 512 + (n & 511)]; }
        else { if (k >= 128) v = F.in[I_RG2][((size_t)l * 128 + (k - 128)) * 512 + (n - 2048)]; }
        WSP(bf16, WS_WL)[i] = f2bf(v); }
    for (long i = gt; i < 1024 * 512; i += NGT) { const int n = (int)(i >> 9), k = (int)(i & 511), g = n >> 8, j = n & 255, g2 = k >> 7, c = k & 127;
        float v = 0.f; if (g == g2) { const int m = (c * (j & 127)) & 127; v = (j < 128) ? cospif((float)m * (1.0f / 64.0f)) : sinpif((float)m * (1.0f / 64.0f)); }
        WSP(bf16, WS_MBD)[i] = f2bf(v); }
    for (long i = gt; i < 256 * 512; i += NGT) { const int tp = (int)(i >> 9), t = (int)(i & 511), m = (tp * (t & 255)) & 255; const float sc = 0.005524271728019903f;
        const float v = (t < 256) ? cospif((float)m * (1.0f / 128.0f)) : -sinpif((float)m * (1.0f / 128.0f)); WSP(bf16, WS_P256)[i] = f2bf(v * sc); }
    for (long i = gt; i < 1024 * 2048; i += NGT) { const int tp = (int)(i >> 11), t = (int)(i & 2047), m = (tp * (t & 1023)) & 1023; const float sc = 0.0027621358640099515f;
        const float v = (t < 1024) ? cospif((float)m * (1.0f / 512.0f)) : -sinpif((float)m * (1.0f / 512.0f)); WSP(bf16, WS_P1024)[i] = f2bf(v * sc); }
    for (long i = gt; i < 1024 * 32; i += NGT) { const int t = (int)(i >> 5), ii = (int)(i & 31); const float pos = (ii < 16) ? (float)(t >> 6) : (float)(t & 63);
        const float inv = exp2f(-(float)(ii & 15) * (13.287712379549449f / 16.0f)); const float ang = pos * inv;
        WSP(float, WS_ROPE)[i] = cosf(ang); WSP(float, WS_ROPE)[1024 * 32 + i] = sinf(ang); }
    __syncthreads();
    for (int it = F.vcu; it < 96; it += F.G) mod_block_item(F, 0, it);
}

template <int MODE> __device__ __forceinline__ void norm_phase(Frame& F, int l) {
    LAS float* vA = (LAS float*)(F.lds); LAS float* vB = vA + 2048; LAS float* vC = vB + 2048;
    const float* MOD = WSP(float, WS_MOD);
    const bool doh = (MODE != 2) || (l < DEPTH - 1);
    for (int ch = F.vcu; ch < NTOK / 32; ch += F.G) {
        const int row0 = 32 * ch, cond = row0 < NCTX ? 0 : 1 + ((row0 - NCTX) >> 10);
        __syncthreads();
        { const int col = 4 * F.tid;
          if (MODE != 0) { const float* gate = MOD + ((size_t)l * 5 + cond) * 12288 + (MODE == 1 ? 4096 : 10240) + col; const float* gp = F.in[MODE == 1 ? I_GPOSTMIX : I_GPOSTFFN] + (size_t)l * DM + col;
              *(LAS f32x4*)(vA + col) = *(const f32x4*)gate * *(const f32x4*)gp; }
          if (doh) { const int ln = (MODE == 2) ? l + 1 : l; const float* mb = MOD + ((size_t)ln * 5 + cond) * 12288;
              const float* gpre = F.in[MODE == 1 ? I_GPREFFN : I_GPREMIX] + (size_t)ln * DM + col;
              const float* scp = mb + (MODE == 1 ? 8192 : 2048) + col; const float* shp = mb + (MODE == 1 ? 6144 : 0) + col;
              *(LAS f32x4*)(vB + col) = *(const f32x4*)gpre * (*(const f32x4*)scp + 1.0f); *(LAS f32x4*)(vC + col) = *(const f32x4*)shp; } }
        __syncthreads();
        for (int rr = 0; rr < 4; ++rr) {
            const int row = row0 + 4 * F.wave + rr;
            float* xrow = F.out + OUT_X + (size_t)row * DM;
            f32x4 x[8];
            if (MODE == 0) { const float* src = row < NCTX ? F.in[I_XP] + (size_t)row * DM : F.in[I_XS] + (size_t)(row - NCTX) * DM;
#pragma unroll
                for (int j = 0; j < 8; ++j) x[j] = *(const f32x4*)(src + 4 * F.lane + 256 * j); }
            else { const float* orow = WSP(float, WS_O) + (size_t)row * DM; f32x4 o[8]; float ss = 0.f;
#pragma unroll
                for (int j = 0; j < 8; ++j) { o[j] = *(const f32x4*)(orow + 4 * F.lane + 256 * j); x[j] = *(const f32x4*)(xrow + 4 * F.lane + 256 * j); ss += o[j].x * o[j].x + o[j].y * o[j].y + o[j].z * o[j].z + o[j].w * o[j].w; }
                const float rs = rsqrtf(wave_sum(ss) * (1.0f / DM) + EPS);
#pragma unroll
                for (int j = 0; j < 8; ++j) x[j] += *(const LAS f32x4*)(vA + 4 * F.lane + 256 * j) * (o[j] * rs); }
#pragma unroll
            for (int j = 0; j < 8; ++j) *(f32x4*)(xrow + 4 * F.lane + 256 * j) = x[j];
            if (doh) { float ss = 0.f;
#pragma unroll
                for (int j = 0; j < 8; ++j) ss += x[j].x * x[j].x + x[j].y * x[j].y + x[j].z * x[j].z + x[j].w * x[j].w;
                const float rs = rsqrtf(wave_sum(ss) * (1.0f / DM) + EPS);
                bf16* hrow = WSP(bf16, WS_H) + (size_t)row * DM;
#pragma unroll
                for (int j = 0; j < 8; ++j) { const f32x4 hv = (x[j] * rs) * *(const LAS f32x4*)(vB + 4 * F.lane + 256 * j) + *(const LAS f32x4*)(vC + 4 * F.lane + 256 * j);
                    v2u w; w.x = cvtpk(hv.x, hv.y); w.y = cvtpk(hv.z, hv.w); *(v2u*)(hrow + 4 * F.lane + 256 * j) = w; } }
        }
    }
}

__device__ __forceinline__ int kv_row(int row) { return row < NCTX ? row : NCTX + ((row - NCTX) >> 10) * 1280 + 256 + ((row - NCTX) & 1023); }
__device__ __forceinline__ void prep_phase(Frame& F, int l) {
    const int gw = F.vcu * NWAVES + F.wave, NGW = F.G * NWAVES, lane = F.lane;
    const bf16* PROJ = WSP(bf16, WS_PROJ);
    for (int row = gw; row < NTOK; row += NGW) {
        const bf16* pr = PROJ + (size_t)row * INP;
        const int kvr = kv_row(row);
        { const bf16x8 qv = *(const bf16x8*)(pr + 8 * lane); float q[8]; float ss = 0.f;
#pragma unroll
          for (int e = 0; e < 8; ++e) { q[e] = bf2f(qv[e]); ss += q[e] * q[e]; }
          const float rs = rsqrtf(wave_sum(ss) * (1.0f / 512.0f) + EPS);
          const float* g = F.in[I_GQ] + (size_t)l * 512 + 8 * lane; const f32x4 g0 = *(const f32x4*)g, g1 = *(const f32x4*)(g + 4);
          v4u w; w.x = cvtpk(q[0] * rs * g0.x, q[1] * rs * g0.y); w.y = cvtpk(q[2] * rs * g0.z, q[3] * rs * g0.w); w.z = cvtpk(q[4] * rs * g1.x, q[5] * rs * g1.y); w.w = cvtpk(q[6] * rs * g1.z, q[7] * rs * g1.w);
          *(v4u*)(WSP(bf16, WS_QN) + (size_t)row * 512 + 8 * lane) = w; }
        { const s16x4 kvv = *(const s16x4*)(pr + OFF_KV + 4 * lane); f32x4 kv = {bf2f(kvv[0]), bf2f(kvv[1]), bf2f(kvv[2]), bf2f(kvv[3])};
          const float rs = rsqrtf(wave_sum(kv.x * kv.x + kv.y * kv.y + kv.z * kv.z + kv.w * kv.w) * (1.0f / 256.0f) + EPS);
          kv = kv * rs * *(const f32x4*)(F.in[I_GKV] + (size_t)l * 256 + 4 * lane);
          v2u w; w.x = cvtpk(kv.x, kv.y); w.y = cvtpk(kv.z, kv.w); *(v2u*)(WSP(bf16, WS_CKVA) + (size_t)kvr * 256 + 4 * lane) = w;
          if (row < NCTX) *(f32x4*)(F.out + OUT_CKV + ((size_t)((row >> 8) * DEPTH + l) * 256 + (row & 255)) * 256 + 4 * lane) = kv; }
        { const float kr = bf2f((short)pr[OFF_KR + lane]); float val = kr;
          if (row < NCTX) F.out[OUT_KR + ((size_t)((row >> 8) * DEPTH + l) * 256 + (row & 255)) * 64 + lane] = kr;
          else { const int t = (row - NCTX) & 1023, i = lane & 31; const float c = WSP(float, WS_ROPE)[t * 32 + i], s = WSP(float, WS_ROPE)[1024 * 32 + t * 32 + i];
              const float other = __shfl_xor(kr, 32); val = (lane < 32) ? kr * c - other * s : other * s + kr * c; }
          WSP(bf16, WS_KR)[(size_t)kvr * 64 + lane] = f2bf(val); }
        { bf16* al = WSP(bf16, WS_AL) + (size_t)row * 256;
          al[lane] = f2bf(tanhf(bf2f((short)pr[OFF_WLO + lane]))); al[64 + lane] = pr[OFF_ALO + lane];
          const unsigned gg = *(const unsigned*)(pr + OFF_GLO + 2 * lane); *(unsigned*)(al + 128 + 2 * lane) = cvtpk(sigmoidf_(__uint_as_float(gg << 16)), sigmoidf_(__uint_as_float(gg & 0xffff0000u))); }
    }
    for (int it = gw; it < (NTOK / 32) * 24; it += NGW) {
        const int chunk = it / 24, grp = it % 24, row0 = 32 * chunk, which = grp >> 3, hh = grp & 7;
        const int s0 = row0 < NCTX ? (row0 & ~255) : NCTX + ((row0 - NCTX) & ~1023), send = s0 + (row0 < NCTX ? 256 : 1024);
        const int ch = 64 * grp + lane, cc = 64 * hh + lane;
        const float* cw = F.in[I_RCONV] + (size_t)l * 3 * 1536;
        const float w0 = cw[ch], w1 = cw[1536 + ch], w2 = cw[3072 + ch];
        const float kk = F.in[I_RKK][(size_t)l * 512 + cc];
        float* dst = WSP(float, which == 0 ? WS_RC : (which == 1 ? WS_KC : WS_VC));
        const bf16* src = PROJ + OFF_RKV + ch;
        float prev = row0 > s0 ? bf2f((short)src[(size_t)(row0 - 1) * INP]) : 0.f, cur = bf2f((short)src[(size_t)row0 * INP]);
#pragma unroll 4
        for (int i = 0; i < 32; ++i) { const int row = row0 + i; const float nxt = (row + 1 < send) ? bf2f((short)src[(size_t)(row + 1) * INP]) : 0.f;
            const float o = prev * w0 + cur * w1 + nxt * w2; dst[(size_t)row * 512 + cc] = o;
            if (which == 1) { const float kap = o * kk; const float ss = wave_sum(kap * kap); if (lane == 0) WSP(float, WS_NK)[row * 8 + hh] = rsqrtf(ss + EPS); }
            prev = cur; cur = nxt; }
    }
    { const long gt = (long)F.vcu * 512 + F.tid, NGT = (long)F.G * 512;
      for (long i = gt; i < 1024 * 64; i += NGT) { const int r = (int)(i >> 6), c4 = (int)(i & 63) * 4, b = r >> 8, j = r & 255;
          const f32x4 v = *(const f32x4*)(F.in[I_CKV] + (((size_t)b * DEPTH + l) * 256 + j) * 256 + c4); v2u w; w.x = cvtpk(v.x, v.y); w.y = cvtpk(v.z, v.w);
          *(v2u*)(WSP(bf16, WS_CKVA) + (size_t)(NCTX + b * 1280 + j) * 256 + c4) = w; }
      for (long i = gt; i < 1024 * 16; i += NGT) { const int r = (int)(i >> 4), c4 = (int)(i & 15) * 4, b = r >> 8, j = r & 255;
          const f32x4 v = *(const f32x4*)(F.in[I_CKR] + (((size_t)b * DEPTH + l) * 256 + j) * 64 + c4); v2u w; w.x = cvtpk(v.x, v.y); w.y = cvtpk(v.z, v.w);
          *(v2u*)(WSP(bf16, WS_KR) + (size_t)(NCTX + b * 1280 + j) * 64 + c4) = w; } }
}

__device__ __forceinline__ void post_phase(Frame& F, int l) {
    const int gw = F.vcu * NWAVES + F.wave, NGW = F.G * NWAVES, lane = F.lane;
    for (int row = gw; row < NTOK; row += NGW) {
#pragma unroll
        for (int h = 0; h < 8; ++h) { const int c = 64 * h + lane;
            const float y = WSP(float, WS_YF)[(size_t)row * 512 + c] + WSP(float, WS_YB)[(size_t)row * 512 + c];
            const float mu = wave_sum(y) * (1.0f / 64.0f); const float d = y - mu; const float var = wave_sum(d * d) * (1.0f / 64.0f);
            const float yn = d * rsqrtf(var + GN_EPS) * F.in[I_GNG][(size_t)l * 512 + c] + F.in[I_GNB][(size_t)l * 512 + c];
            const float bonus = WSP(float, WS_BON)[(size_t)row * 8 + h] + WSP(float, WS_BON)[(size_t)NTOK * 8 + (size_t)row * 8 + h];
            const float o = (yn + bonus * WSP(float, WS_VC)[(size_t)row * 512 + c]) * WSP(float, WS_LORA)[(size_t)row * LORAN + 2048 + c];
            WSP(bf16, WS_MIX)[(size_t)row * DM + 1536 + c] = f2bf(o); }
    }
}

__device__ __forceinline__ void ffn_act_phase(Frame& F, int l) {
    const int gw = F.vcu * NWAVES + F.wave, NGW = F.G * NWAVES, lane = F.lane;
    const bf16* U = WSP(bf16, WS_U);
    for (int it = gw; it < (NTOK / 32) * 11; it += NGW) {
        const int chunk = it / 11, slab = it % 11, row0 = 32 * chunk, col = 512 * slab + 8 * lane;
        const int s0 = row0 < NCTX ? (row0 & ~255) : NCTX + ((row0 - NCTX) & ~1023), send = s0 + (row0 < NCTX ? 256 : 1024);
        const float* cw = F.in[I_FCONV] + (size_t)l * 3 * UPN; const float* cb = F.in[I_FCONVB] + (size_t)l * UPN;
        float wg[3][8], wv[3][8], bg[8], bv[8];
#pragma unroll
        for (int j = 0; j < 3; ++j)
#pragma unroll
            for (int e = 0; e < 8; ++e) { wg[j][e] = cw[(size_t)j * UPN + col + e]; wv[j][e] = cw[(size_t)j * UPN + DFF + col + e]; }
#pragma unroll
        for (int e = 0; e < 8; ++e) { bg[e] = cb[col + e]; bv[e] = cb[DFF + col + e]; }
        const bf16x8 z8 = {0, 0, 0, 0, 0, 0, 0, 0};
        bf16x8 pg = row0 > s0 ? *(const bf16x8*)(U + (size_t)(row0 - 1) * UPN + col) : z8, pv = row0 > s0 ? *(const bf16x8*)(U + (size_t)(row0 - 1) * UPN + DFF + col) : z8;
        bf16x8 cg = *(const bf16x8*)(U + (size_t)row0 * UPN + col), cv = *(const bf16x8*)(U + (size_t)row0 * UPN + DFF + col);
#pragma unroll 2
        for (int i = 0; i < 32; ++i) { const int row = row0 + i; const bool hn = row + 1 < send;
            const bf16x8 ng = hn ? *(const bf16x8*)(U + (size_t)(row + 1) * UPN + col) : z8, nv = hn ? *(const bf16x8*)(U + (size_t)(row + 1) * UPN + DFF + col) : z8;
            float r[8];
#pragma unroll
            for (int e = 0; e < 8; ++e) { const float g = bf2f(pg[e]) * wg[0][e] + bf2f(cg[e]) * wg[1][e] + bf2f(ng[e]) * wg[2][e] + bg[e];
                const float v = bf2f(pv[e]) * wv[0][e] + bf2f(cv[e]) * wv[1][e] + bf2f(nv[e]) * wv[2][e] + bv[e]; r[e] = g * sigmoidf_(g) * v; }
            v4u w; w.x = cvtpk(r[0], r[1]); w.y = cvtpk(r[2], r[3]); w.z = cvtpk(r[4], r[5]); w.w = cvtpk(r[6], r[7]);
            *(v4u*)(WSP(bf16, WS_ACT) + (size_t)row * DFF + col) = w;
            pg = cg; pv = cv; cg = ng; cv = nv; }
    }
}

constexpr int SC_STEP = 448, SC_BUF = 32 * SC_STEP;
__device__ __forceinline__ void scan_unit(Frame& F, int l, int s, int h, int d) {
    const int tid = F.tid, lane = F.lane, wv = F.wave;
    const int T = s < 16 ? 256 : 1024, row0 = s < 16 ? 256 * s : NCTX + 1024 * (s - 16), NCH = T / 32;
    LAS float* SV = (LAS float*)F.lds;
    LAS float* YS = (LAS float*)(F.lds + 2 * SC_BUF * 4);
    const int rp = lane >> 4, kq = lane & 15, rowA = 8 * wv + 2 * rp;
    f32x2 ST[4];
    if (s >= 16) { const float* sp = F.in[I_ST] + ((((size_t)(s - 16) * DEPTH + l) * 2 + d) * 8 + h) * 4096 + rowA * 64 + 4 * kq; const f32x4 a = *(const f32x4*)sp, b = *(const f32x4*)(sp + 64);
#pragma unroll
        for (int k = 0; k < 4; ++k) ST[k] = (f32x2){a[k], b[k]}; }
    else {
#pragma unroll
        for (int k = 0; k < 4; ++k) ST[k] = (f32x2){0.f, 0.f}; }
    const int si = tid >> 4, sj = tid & 15, sn = sj * 4, cbase = 64 * h + sn;
    const f32x4 w0v = *(const f32x4*)(F.in[I_RW0] + ((size_t)l * 2 + d) * 512 + cbase), a0v = *(const f32x4*)(F.in[I_RA0] + ((size_t)l * 2 + d) * 512 + cbase);
    const f32x4 kkv = *(const f32x4*)(F.in[I_RKK] + (size_t)l * 512 + cbase), kav = *(const f32x4*)(F.in[I_RKA] + (size_t)l * 512 + cbase), rkv = *(const f32x4*)(F.in[I_RRK] + (size_t)l * 512 + cbase);
    float* Yout = WSP(float, d == 0 ? WS_YF : WS_YB); float* BON = WSP(float, WS_BON) + (size_t)d * NTOK * 8;
    const float* RC = WSP(float, WS_RC); const float* KC = WSP(float, WS_KC); const float* VC = WSP(float, WS_VC); const float* NK = WSP(float, WS_NK); const float* LORA = WSP(float, WS_LORA);
    f32x4 gr, gk, gv, gwp, gap; float gnk;
#define SCAN_ROW(c) (row0 + (d == 0 ? 32 * (c) + si : T - 1 - (32 * (c) + si)))
#define SCAN_LOADG(c) do { const size_t row_ = (size_t)SCAN_ROW(c); gr = *(const f32x4*)(RC + row_ * 512 + cbase); gk = *(const f32x4*)(KC + row_ * 512 + cbase); gv = *(const f32x4*)(VC + row_ * 512 + cbase); \
        gwp = *(const f32x4*)(LORA + row_ * LORAN + d * 512 + cbase); gap = *(const f32x4*)(LORA + row_ * LORAN + 1024 + d * 512 + cbase); gnk = NK[row_ * 8 + h]; } while (0)
#define SCAN_WRITES(buf, c) do { const f32x4 kh_ = gk * kkv * gnk; f32x4 w_, a_; \
        _Pragma("unroll") for (int e = 0; e < 4; ++e) { w_[e] = __expf(-DECAY_SCALE * sigmoidf_(w0v[e] + gwp[e])); a_[e] = sigmoidf_(a0v[e] + gap[e]); } \
        const f32x4 b_ = a_ * kh_, kt_ = gk * ((a_ - 1.0f) * kav + 1.0f); const f32x4 bb_ = gr * rkv * kt_, br4_ = b_ * gr, kr4_ = kt_ * gr; \
        const float bon_ = allred16((bb_.x + bb_.y) + (bb_.z + bb_.w)), br_ = allred16((br4_.x + br4_.y) + (br4_.z + br4_.w)), ktr_ = allred16((kr4_.x + kr4_.y) + (kr4_.z + kr4_.w)); \
        if (sj == 0) BON[(size_t)SCAN_ROW(c) * 8 + h] = bon_; \
        LAS float* p_ = SV + (buf) * SC_BUF + si * SC_STEP; *(LAS f32x4*)(p_ + sn) = w_; *(LAS f32x4*)(p_ + 64 + sn) = kh_; *(LAS f32x4*)(p_ + 128 + sn) = b_; *(LAS f32x4*)(p_ + 192 + sn) = kt_; \
        *(LAS f32x4*)(p_ + 256 + sn) = gr; *(LAS f32x4*)(p_ + 320 + 8 * sj) = (f32x4){gv.x, gv.y, br_, ktr_}; *(LAS f32x4*)(p_ + 324 + 8 * sj) = (f32x4){gv.z, gv.w, br_, ktr_}; } while (0)
    SCAN_LOADG(0); SCAN_WRITES(0, 0); __syncthreads();
    const int vo = 4 * kq, ao = 320 + 4 * (4 * wv + rp);
    for (int c = 0; c < NCH; ++c) {
        if (c + 1 < NCH) SCAN_LOADG(c + 1);
        const LAS float* sv = SV + (c & 1) * SC_BUF; LAS float* ys = YS + (c & 1) * 2048;
        f32x4 w4 = *(const LAS f32x4*)(sv + vo), kh4 = *(const LAS f32x4*)(sv + 64 + vo), b4 = *(const LAS f32x4*)(sv + 128 + vo), kt4 = *(const LAS f32x4*)(sv + 192 + vo), r4 = *(const LAS f32x4*)(sv + 256 + vo), ax = *(const LAS f32x4*)(sv + ao);
#pragma unroll 4
        for (int i = 0; i < 32; ++i) {
            const LAS float* pn = sv + ((i + 1) & 31) * SC_STEP;
            const f32x4 nw = *(const LAS f32x4*)(pn + vo), nkh = *(const LAS f32x4*)(pn + 64 + vo), nb = *(const LAS f32x4*)(pn + 128 + vo), nkt = *(const LAS f32x4*)(pn + 192 + vo), nr = *(const LAS f32x4*)(pn + 256 + vo), nax = *(const LAS f32x4*)(pn + ao);
            f32x2 SW[4];
#pragma unroll
            for (int k = 0; k < 4; ++k) SW[k] = ST[k] * w4[k];
            f32x2 P = ST[0] * kh4[0], A = SW[0] * r4[0];
#pragma unroll
            for (int k = 1; k < 4; ++k) { P += ST[k] * kh4[k]; A += SW[k] * r4[k]; }
            float p0 = P.x, p1 = P.y, q0 = A.x, q1 = A.y;
            p0 += dpp_mov<0xB1>(p0); p1 += dpp_mov<0xB1>(p1); q0 += dpp_mov<0xB1>(q0); q1 += dpp_mov<0xB1>(q1);
            p0 += dpp_mov<0x4E>(p0); p1 += dpp_mov<0x4E>(p1); q0 += dpp_mov<0x4E>(q0); q1 += dpp_mov<0x4E>(q1);
            p0 += dpp_mov<0x141>(p0); p1 += dpp_mov<0x141>(p1); q0 += dpp_mov<0x141>(q0); q1 += dpp_mov<0x141>(q1);
            p0 += dpp_mov<0x140>(p0); p1 += dpp_mov<0x140>(p1); q0 += dpp_mov<0x140>(q0); q1 += dpp_mov<0x140>(q1);
            const f32x2 SK = {p0, p1}, V2 = {ax.x, ax.y};
            const f32x2 Y = (f32x2){q0, q1} - SK * ax.z + V2 * ax.w;
#pragma unroll
            for (int k = 0; k < 4; ++k) ST[k] = SW[k] - SK * b4[k] + V2 * kt4[k];
            if (kq == 0) *(LAS f32x2*)(ys + i * 64 + rowA) = Y;
            w4 = nw; kh4 = nkh; b4 = nb; kt4 = nkt; r4 = nr; ax = nax;
        }
        if (c + 1 < NCH) SCAN_WRITES((c + 1) & 1, c + 1);
        __syncthreads();
        *(f32x4*)(Yout + (size_t)SCAN_ROW(c) * 512 + cbase) = *(const LAS f32x4*)(ys + si * 64 + sn);
    }
    if (s < 16) { float* op = F.out + OUT_ST + ((((size_t)s * DEPTH + l) * 2 + d) * 8 + h) * 4096 + rowA * 64 + 4 * kq;
        *(f32x4*)op = (f32x4){ST[0].x, ST[1].x, ST[2].x, ST[3].x}; *(f32x4*)(op + 64) = (f32x4){ST[0].y, ST[1].y, ST[2].y, ST[3].y}; }
#undef SCAN_ROW
#undef SCAN_LOADG
#undef SCAN_WRITES
}

constexpr float ATT_SCALE = 0.07216878364870322f;
constexpr float ATT_THR = 8.f;
#define KSWZ(row, colB) ((row) * 256 + ((colB) ^ (((row) & 7) << 4)))
__device__ __forceinline__ int crow(int r, int hi) { return (r & 3) + 8 * (r >> 2) + 4 * hi; }
__device__ __forceinline__ void partialSM(f32x16& p0, f32x16& p1, float& m_reg, float& mn, float& alpha) {
    constexpr float C = ATT_SCALE * 1.4426950408889634f;
    float pmax = p0[0];
#pragma unroll
    for (int r = 1; r < 16; ++r) pmax = fmaxf(pmax, p0[r]);
#pragma unroll
    for (int r = 0; r < 16; ++r) pmax = fmaxf(pmax, p1[r]);
    { auto rr = __builtin_amdgcn_permlane32_swap(__float_as_uint(pmax), __float_as_uint(pmax), false, false); pmax = fmaxf(__uint_as_float(rr[0]), __uint_as_float(rr[1])); }
    if (__builtin_expect(__all(pmax - m_reg <= ATT_THR / ATT_SCALE), 1)) { mn = m_reg; alpha = 1.f; }
    else { mn = fmaxf(m_reg, pmax); alpha = __builtin_amdgcn_exp2f((m_reg - mn) * C); m_reg = mn; }
    const float mnC = -mn * C;
#pragma unroll
    for (int r = 0; r < 16; ++r) p0[r] = __builtin_amdgcn_exp2f(fmaf(p0[r], C, mnC));
#pragma unroll
    for (int r = 0; r < 16; ++r) p1[r] = __builtin_amdgcn_exp2f(fmaf(p1[r], C, mnC));
}
__device__ __forceinline__ void finishSM(f32x16& p0, f32x16& p1, float alpha, float& l_reg, bf16x8& pa0, bf16x8& pa1, bf16x8& pa2, bf16x8& pa3) {
    float ps = 0;
#pragma unroll
    for (int r = 0; r < 16; ++r) ps += p0[r];
#pragma unroll
    for (int r = 0; r < 16; ++r) ps += p1[r];
    { auto rr = __builtin_amdgcn_permlane32_swap(__float_as_uint(ps), __float_as_uint(ps), false, false); ps = __uint_as_float(rr[0]) + __uint_as_float(rr[1]); }
    l_reg = l_reg * alpha + ps;
#define PK4(P, BASE, OUT) do { unsigned a0 = cvtpk(P[BASE + 0], P[BASE + 1]), a1 = cvtpk(P[BASE + 2], P[BASE + 3]);   \
    unsigned b0 = cvtpk(P[BASE + 4], P[BASE + 5]), b1 = cvtpk(P[BASE + 6], P[BASE + 7]);                              \
    auto r0 = __builtin_amdgcn_permlane32_swap(a0, b0, false, false); auto r1 = __builtin_amdgcn_permlane32_swap(a1, b1, false, false); \
    v4u w = {r0[0], r1[0], r0[1], r1[1]}; OUT = *reinterpret_cast<bf16x8*>(&w); } while (0)
    PK4(p0, 0, pa0); PK4(p0, 8, pa1); PK4(p1, 0, pa2); PK4(p1, 8, pa3);
#undef PK4
}
__device__ __forceinline__ int v_st(int k, int c) { const int kk = (k & ~0xC) | ((k & 4) << 1) | ((k & 8) >> 1); return ((kk >> 3) * 4 + (c >> 5)) * 512 + ((kk & 7) * 32 + (c & 31)) * 2; }
__device__ __forceinline__ int v_rd_base(int lane) { return ((lane & 3) << 3) | (((lane >> 2) & 3) << 6) | (((lane >> 4) & 1) << 5) | (((lane >> 5) & 1) << 8); }
constexpr int v_rd_off(int d0, int ks, int half) { return d0 * 512 + ks * 4096 + half * 2048; }
template <int OFF> __device__ __forceinline__ s16x4 tr_read(int vb) { s16x4 r; asm volatile("ds_read_b64_tr_b16 %0, %1 offset:%2" : "=&v"(r) : "v"(vb), "i"(OFF) : "memory"); return r; }
template <int D0> __device__ __forceinline__ void pv_one(f32x16& od, int vb, bf16x8 pa0, bf16x8 pa1, bf16x8 pa2, bf16x8 pa3) {
    const s16x4 l0 = tr_read<v_rd_off(D0, 0, 0)>(vb), h0 = tr_read<v_rd_off(D0, 0, 1)>(vb), l1 = tr_read<v_rd_off(D0, 1, 0)>(vb), h1 = tr_read<v_rd_off(D0, 1, 1)>(vb);
    const s16x4 l2 = tr_read<v_rd_off(D0, 2, 0)>(vb), h2 = tr_read<v_rd_off(D0, 2, 1)>(vb), l3 = tr_read<v_rd_off(D0, 3, 0)>(vb), h3 = tr_read<v_rd_off(D0, 3, 1)>(vb);
    asm volatile("s_waitcnt lgkmcnt(0)" ::: "memory"); SBAR();
#define PK(L, H) (bf16x8){L[0], L[1], L[2], L[3], H[0], H[1], H[2], H[3]}
    od = __builtin_amdgcn_mfma_f32_32x32x16_bf16(pa0, PK(l0, h0), od, 0, 0, 0);
    od = __builtin_amdgcn_mfma_f32_32x32x16_bf16(pa1, PK(l1, h1), od, 0, 0, 0);
    od = __builtin_amdgcn_mfma_f32_32x32x16_bf16(pa2, PK(l2, h2), od, 0, 0, 0);
    od = __builtin_amdgcn_mfma_f32_32x32x16_bf16(pa3, PK(l3, h3), od, 0, 0, 0);
#undef PK
}
__device__ __forceinline__ void pv_d0(f32x16* o, int vb, bf16x8 pa0, bf16x8 pa1, bf16x8 pa2, bf16x8 pa3) {
    pv_one<0>(o[0], vb, pa0, pa1, pa2, pa3); pv_one<1>(o[1], vb, pa0, pa1, pa2, pa3); pv_one<2>(o[2], vb, pa0, pa1, pa2, pa3); pv_one<3>(o[3], vb, pa0, pa1, pa2, pa3);
}
__device__ __forceinline__ bf16x8 pack8(const float* x) { v4u w = {cvtpk(x[0], x[1]), cvtpk(x[2], x[3]), cvtpk(x[4], x[5]), cvtpk(x[6], x[7])}; return *reinterpret_cast<bf16x8*>(&w); }

#define GLDS16(gp, lp) __builtin_amdgcn_global_load_lds((const unsigned*)(gp), (LAS unsigned*)(lp), 16, 0, 0)
constexpr int AT_BUF = 40960;
__device__ __forceinline__ void attn_unit(Frame& F, int s, int h, int qb) {
    const int wid = F.wave, lane = F.lane, r32 = lane & 31, hi = lane >> 5;
    const int grow0 = (s < 16 ? 256 * s : NCTX + 1024 * (s - 16)) + 256 * qb;
    const int kvr0 = s < 16 ? 256 * s : NCTX + 1280 * (s - 16), NT = s < 16 ? 4 : 20;
    LAS char* L0 = (LAS char*)F.lds;
    LAS float* wsx = (LAS float*)(L0 + 2 * AT_BUF) + wid * 64; LAS float* li_l = wsx; LAS float* al_l = wsx + 32;
    bf16x8 qr[12];
    { const bf16* Qw = WSP(bf16, WS_Q) + (size_t)(grow0 + wid * 32 + r32) * QW + h * 192 + hi * 8;
#pragma unroll
      for (int d0 = 0; d0 < 12; ++d0) qr[d0] = *(const bf16x8*)(Qw + d0 * 16); }
    if (s >= 16) {
        const int t = 256 * qb + wid * 32 + r32; const float* ct = WSP(float, WS_ROPE) + t * 32; const float* stb = ct + 1024 * 32;
#pragma unroll
        for (int pr = 0; pr < 2; ++pr) { const int ib = 16 * pr + 8 * hi; float n1[8], n2[8];
#pragma unroll
            for (int j = 0; j < 8; ++j) { const float c = ct[ib + j], sn = stb[ib + j], x1 = bf2f(qr[8 + pr][j]), x2 = bf2f(qr[10 + pr][j]); n1[j] = x1 * c - x2 * sn; n2[j] = x1 * sn + x2 * c; }
            qr[8 + pr] = pack8(n1); qr[10 + pr] = pack8(n2); }
    }
    const bf16* KVb = WSP(bf16, WS_KV) + (size_t)kvr0 * 2048 + h * 256; const bf16* KRb = WSP(bf16, WS_KR) + (size_t)kvr0 * 64;
    int okn[2], ov[2], okr;
#pragma unroll
    for (int j = 0; j < 2; ++j) { const int p = 2 * wid + j;
        { const int row = 4 * p + (lane >> 4), ch = (lane & 15) ^ (row & 7); okn[j] = row * 2048 + 8 * ch; }
        { const int st = 2 * p + (lane >> 5), kk = 8 * (st >> 2) + ((lane & 31) >> 2), k = (kk & ~0xC) | ((kk & 4) << 1) | ((kk & 8) >> 1), col = 32 * (st & 3) + 8 * (lane & 3); ov[j] = k * 2048 + 128 + col; } }
    { const int row = 8 * wid + (lane >> 3), ch = (lane & 7) ^ ((row >> 1) & 7); okr = row * 64 + 8 * ch; }
#define AT_ISSUE(kt, b) do { LAS char* B_ = L0 + (b) * AT_BUF; const bf16* kv_ = KVb + (size_t)(kt) * (64 * 2048); \
        GLDS16(kv_ + ov[0], B_ + (2 * wid) * 1024); GLDS16(kv_ + ov[1], B_ + (2 * wid + 1) * 1024); \
        GLDS16(kv_ + okn[0], B_ + 16384 + (2 * wid) * 1024); GLDS16(kv_ + okn[1], B_ + 16384 + (2 * wid + 1) * 1024); \
        GLDS16(KRb + (size_t)(kt) * (64 * 64) + okr, B_ + 32768 + wid * 1024); } while (0)
    const int vb0 = (int)(unsigned)(size_t)L0 + v_rd_base(lane);
    float m_reg = -1e30f, l_reg = 0.f; f32x16 o[4];
#pragma unroll
    for (int d = 0; d < 4; ++d)
#pragma unroll
        for (int r = 0; r < 16; ++r) o[d][r] = 0.f;
    AT_ISSUE(0, 0);
    for (int kt = 0; kt < NT; ++kt) {
        VM_WAIT(); __syncthreads();
        if (kt + 1 < NT) AT_ISSUE(kt + 1, (kt + 1) & 1);
        const LAS char* Kn_lds = L0 + (kt & 1) * AT_BUF + 16384; const LAS char* Kr_lds = L0 + (kt & 1) * AT_BUF + 32768;
        f32x16 p0, p1;
#pragma unroll
        for (int r = 0; r < 16; ++r) { p0[r] = 0.f; p1[r] = 0.f; }
#pragma unroll
        for (int d0 = 0; d0 < 8; ++d0) { const int cb = (d0 * 16 + hi * 8) * 2;
            const bf16x8 b0 = *(const LAS bf16x8*)(Kn_lds + KSWZ(r32, cb)), b1 = *(const LAS bf16x8*)(Kn_lds + KSWZ(32 + r32, cb));
            p0 = __builtin_amdgcn_mfma_f32_32x32x16_bf16(b0, qr[d0], p0, 0, 0, 0); p1 = __builtin_amdgcn_mfma_f32_32x32x16_bf16(b1, qr[d0], p1, 0, 0, 0);
            if ((d0 & 3) == 3) SBAR(); }
#pragma unroll
        for (int d0 = 0; d0 < 4; ++d0) { const int ko = r32 * 128 + (((2 * d0 + hi) ^ ((r32 >> 1) & 7)) << 4);
            const bf16x8 b0 = *(const LAS bf16x8*)(Kr_lds + ko), b1 = *(const LAS bf16x8*)(Kr_lds + 32 * 128 + ko);
            p0 = __builtin_amdgcn_mfma_f32_32x32x16_bf16(b0, qr[8 + d0], p0, 0, 0, 0); p1 = __builtin_amdgcn_mfma_f32_32x32x16_bf16(b1, qr[8 + d0], p1, 0, 0, 0); }
        SBAR();
        float mn, alpha; bf16x8 pa0, pa1, pa2, pa3;
        partialSM(p0, p1, m_reg, mn, alpha);
        if (__any(alpha < 1.f)) { if (hi == 0) al_l[r32] = alpha; LDS_WAIT();
#pragma unroll
            for (int d = 0; d < 4; ++d)
#pragma unroll
                for (int r = 0; r < 16; ++r) o[d][r] *= al_l[crow(r, hi)]; }
        finishSM(p0, p1, alpha, l_reg, pa0, pa1, pa2, pa3); SBAR();
        pv_d0(o, vb0 + (kt & 1) * AT_BUF, pa0, pa1, pa2, pa3);
    }
    if (hi == 0) li_l[r32] = l_reg; LDS_WAIT();
    bf16* Ow = WSP(bf16, WS_MIX) + (size_t)(grow0 + wid * 32) * DM + h * 128 + r32;
#pragma unroll
    for (int r = 0; r < 16; ++r) { const int orow = crow(r, hi); const float rl = __builtin_amdgcn_rcpf(li_l[orow]);
#pragma unroll
        for (int d0 = 0; d0 < 4; ++d0) Ow[(size_t)orow * DM + d0 * 32] = f2bf(o[d0][r] * rl); }
#undef AT_ISSUE
}

__device__ __forceinline__ void four_unit(Frame& F, int s, int g, int ob) {
    const int wid = F.wave, lane = F.lane, r32 = lane & 31, hi = lane >> 5;
    const int T = s < 16 ? 256 : 1024, row0 = s < 16 ? 256 * s : NCTX + 1024 * (s - 16), NTH = T / 64, NT = 2 * NTH, ldp = 2 * T;
    LAS char* L0 = (LAS char*)F.lds;
    const bf16* Pw = (s < 16 ? WSP(bf16, WS_P256) : WSP(bf16, WS_P1024)) + (size_t)(256 * ob + wid * 32 + r32) * ldp + hi * 8;
    const bf16* Y = WSP(bf16, WS_Y) + (size_t)row0 * 1024 + g * 256;
    int ov[2];
#pragma unroll
    for (int j = 0; j < 2; ++j) { const int p = 2 * wid + j, st = 2 * p + (lane >> 5), kk = 8 * (st >> 2) + ((lane & 31) >> 2), k = (kk & ~0xC) | ((kk & 4) << 1) | ((kk & 8) >> 1), col = 32 * (st & 3) + 8 * (lane & 3); ov[j] = k * 1024 + col; }
    const int vb0 = (int)(unsigned)(size_t)L0 + v_rd_base(lane);
    bf16x8 na0, na1, na2, na3;
#define FO_ISSUE(kt, b) do { const int part_ = (kt) >= NTH ? 1 : 0; const bf16* yp_ = Y + (size_t)(64 * ((kt) - part_ * NTH)) * 1024 + part_ * 128; \
        GLDS16(yp_ + ov[0], L0 + (b) * 16384 + (2 * wid) * 1024); GLDS16(yp_ + ov[1], L0 + (b) * 16384 + (2 * wid + 1) * 1024); } while (0)
#define FO_LOADP(kt) do { na0 = *(const bf16x8*)(Pw + 64 * (kt)); na1 = *(const bf16x8*)(Pw + 64 * (kt) + 16); na2 = *(const bf16x8*)(Pw + 64 * (kt) + 32); na3 = *(const bf16x8*)(Pw + 64 * (kt) + 48); } while (0)
    f32x16 o[4];
#pragma unroll
    for (int d = 0; d < 4; ++d)
#pragma unroll
        for (int r = 0; r < 16; ++r) o[d][r] = 0.f;
    FO_ISSUE(0, 0); FO_LOADP(0);
    for (int kt = 0; kt < NT; ++kt) {
        VM_WAIT(); __syncthreads();
        const bf16x8 pa0 = na0, pa1 = na1, pa2 = na2, pa3 = na3;
        if (kt + 1 < NT) { FO_ISSUE(kt + 1, (kt + 1) & 1); FO_LOADP(kt + 1); }
        pv_d0(o, vb0 + (kt & 1) * 16384, pa0, pa1, pa2, pa3);
    }
    bf16* Ow = WSP(bf16, WS_MIX) + (size_t)(row0 + 256 * ob + wid * 32) * DM + 1024 + g * 128 + r32;
#pragma unroll
    for (int r = 0; r < 16; ++r) { const int orow = crow(r, hi);
#pragma unroll
        for (int d0 = 0; d0 < 4; ++d0) Ow[(size_t)orow * DM + d0 * 32] = f2bf(o[d0][r]); }
#undef FO_ISSUE
#undef FO_LOADP
}

constexpr int NUNITS = 704, CV_PER_UNIT = 64, NCVU = (I_LAYER + CV_PER_UNIT - 1) / CV_PER_UNIT, NMODU = 96;
__device__ __forceinline__ void mixer_phase(Frame& F, int lq) {
    const int l = lq & 3; gu32* ctr = F.ctl + CW_QUEUE + 64 * lq;
    const int ntot = (l < DEPTH - 1 && lq < 4) ? NUNITS + NCVU + NMODU : NUNITS;
    for (;;) {
        __syncthreads();
        if (F.tid == 0) F.MISC[0] = __hip_atomic_fetch_add(ctr, 1u, RLX_AGENT);
        __syncthreads();
        const int u = (int)F.MISC[0];
        if (u >= ntot) break;
        { int t_ = threadIdx.x; asm volatile("" : "+v"(t_)); F.tid = t_; F.lane = t_ & 63; F.wave = __builtin_amdgcn_readfirstlane(t_ >> 6); }
        if (u >= NUNITS) {
            if (u < NUNITS + NCVU) { LAS float* scr = (LAS float*)(F.lds + RING_OFF + F.wave * 16384); const int base = (u - NUNITS) * CV_PER_UNIT + F.wave * (CV_PER_UNIT / NWAVES);
                for (int i = 0; i < CV_PER_UNIT / NWAVES; ++i) if (base + i < I_LAYER) convert_wave_item(F, l + 1, base + i, scr); }
            else mod_block_item(F, l + 1, u - NUNITS - NCVU);
            continue;
        }
        int ty, a, b, c;
        if (u < 64) { ty = 0; a = 16 + (u >> 4); b = (u & 15) >> 1; c = u & 1; }
        else if (u < 192) { const int i = u - 64; ty = 1; a = 16 + (i >> 5); b = (i >> 2) & 7; c = i & 3; }
        else if (u < 256) { const int i = u - 192; ty = 2; a = 16 + (i >> 4); b = (i >> 2) & 3; c = i & 3; }
        else if (u < 512) { const int i = u - 256; ty = 0; a = i >> 4; b = (i & 15) >> 1; c = i & 1; }
        else if (u < 640) { const int i = u - 512; ty = 1; a = i >> 3; b = i & 7; c = 0; }
        else { const int i = u - 640; ty = 2; a = i >> 2; b = i & 3; c = 0; }
        if (ty == 0) scan_unit(F, l, a, b, c); else if (ty == 1) attn_unit(F, a, b, c); else four_unit(F, a, b, c);
    }
}

#ifndef MK_MODE
#define MK_MODE 1
#endif
struct Args { const float* in[NIN]; float* out; unsigned char* ws; int ph_lo, ph_hi, li, pad; };
__global__ void __launch_bounds__(NWAVES * 64, 2) mk_fwd(Args args) {
    extern __shared__ __attribute__((aligned(16))) unsigned char lds_raw[];
    Frame F;
    F.lds = (LAS unsigned char*)lds_raw;
    F.MISC = (volatile LAS unsigned*)(F.lds + MISC_OFF);
    F.tid = threadIdx.x; F.lane = F.tid & 63; F.wave = __builtin_amdgcn_readfirstlane(F.tid >> 6);
    F.G = gridDim.x; { const int bx = blockIdx.x; F.vcu = (F.G % 8 == 0) ? (bx % 8) * (F.G / 8) + bx / 8 : bx; }
    F.in = args.in; F.out = args.out; F.ws = args.ws; F.ctl = (gu32*)(args.ws + WS_CTL);
    for (int u = F.tid; u < (LDS_BYTES - LDSCTL_OFF) / 4; u += NWAVES * 64) ((LAS unsigned*)(F.lds + LDSCTL_OFF))[u] = 0u;
    __syncthreads();
    const int lo = args.ph_lo, hi = args.ph_hi;
    XcdBarrier bar; bar.bar = (unsigned*)(F.ctl + CW_BAR) + args.li * XCD_BAR_WORDS; bar.x = 0; bar.st = nullptr;
    if (hi - lo > 1) bar = xcd_barrier_post((unsigned*)(F.ctl + CW_BAR) + args.li * XCD_BAR_WORDS, F.MISC + 8);
#ifdef ONLY
#define KIND_ON(x) ((x) == ONLY)
#else
#define KIND_ON(x) true
#endif
#define IN(k) (lo <= (k) && (k) < hi)
#ifndef REPMASK
#define REPMASK 0
#endif
#define NREP(kind) (1 + ((REPMASK >> (kind)) & 1))
#define RELANE() do { int t_ = threadIdx.x; asm volatile("" : "+v"(t_)); F.tid = t_; F.lane = t_ & 63; F.wave = __builtin_amdgcn_readfirstlane(t_ >> 6); } while (0)
#define SEAM(k) do { if (IN(k) && IN((k) + 1)) xcd_barrier(bar); } while (0)
    const int cb = (int)blockIdx.x;

    if (KIND_ON(0) && IN(0)) { for (int rep = 0; rep < NREP(0); ++rep) { RELANE(); p0_prologue(F); } SEAM(0); }
    if (KIND_ON(1) && IN(1)) { for (int rep = 0; rep < NREP(1); ++rep) { RELANE(); norm_phase<0>(F, 0); } SEAM(1); }
    for (int l = 0; l < DEPTH; ++l) {
        const int pb = 2 + 11 * l;
        if (KIND_ON(2) && IN(pb + 0)) {
            for (int rep = 0; rep < NREP(2); ++rep) {
            pg8::Gemm g{WSP(bf16, WS_H), WSP(bf16, WS_WIN) + (size_t)l * INP * DM, NTOK, INP, DM, DM}; pg8::StaticOrder S; S.init(NTOK, INP, F.G, cb);
            pg8::EpiAny E{(void*)WSP(bf16, WS_PROJ), INP, 0};
            pg8::gemm_phase<pg8::EpiAny, pg8::StaticOrder, true, true>(F.lds + RING_OFF, g, S, E); }
            SEAM(pb + 0);
        }
        if (KIND_ON(3) && IN(pb + 1)) { for (int rep = 0; rep < NREP(3); ++rep) { RELANE(); prep_phase(F, l); } SEAM(pb + 1); }
        if (KIND_ON(4) && IN(pb + 2)) {
            for (int gi = 0; gi < 4 * NREP(4); ++gi) {
                const bf16* A_; const bf16* B_; void* O_; int M_, N_, K_, f_, rot_, lda_;
                if ((gi & 3) == 0) { A_ = WSP(bf16, WS_QN); B_ = WSP(bf16, WS_WUQ) + (size_t)l * QW * 512; O_ = WSP(bf16, WS_Q); M_ = NTOK; N_ = QW; K_ = 512; f_ = 0; rot_ = 0; lda_ = 512; }
                else if ((gi & 3) == 1) { A_ = WSP(bf16, WS_PROJ) + OFF_XF; B_ = WSP(bf16, WS_MBD); O_ = WSP(bf16, WS_Y); M_ = NTOK; N_ = 1024; K_ = 512; f_ = 0; rot_ = 192; lda_ = INP; }
                else if ((gi & 3) == 2) { A_ = WSP(bf16, WS_CKVA); B_ = WSP(bf16, WS_WUKV) + (size_t)l * 2048 * 256; O_ = WSP(bf16, WS_KV); M_ = KVROWS; N_ = 2048; K_ = 256; f_ = 0; rot_ = 64; lda_ = 256; }
                else { A_ = WSP(bf16, WS_AL); B_ = WSP(bf16, WS_WL) + (size_t)l * LORAN * 256; O_ = WSP(float, WS_LORA); M_ = NTOK; N_ = LORAN; K_ = 256; f_ = 1; rot_ = 96; lda_ = 256; }
                pg8::Gemm g{A_, B_, M_, N_, K_, lda_}; pg8::StaticOrder S; S.init(M_, N_, F.G, (cb + F.G - rot_ % F.G) % F.G);
                pg8::EpiAny E{O_, N_, f_};
                pg8::gemm_phase<pg8::EpiAny, pg8::StaticOrder, true, true>(F.lds + RING_OFF, g, S, E);
            }
            SEAM(pb + 2);
        }
        if (KIND_ON(5) && IN(pb + 3)) { for (int rep = 0; rep < NREP(5); ++rep) { RELANE(); mixer_phase(F, l + 4 * rep); } SEAM(pb + 3); }
        if (KIND_ON(6) && IN(pb + 4)) { for (int rep = 0; rep < NREP(6); ++rep) { RELANE(); post_phase(F, l); } SEAM(pb + 4); }
        if (KIND_ON(7) && IN(pb + 5)) {
            for (int rep = 0; rep < NREP(7); ++rep) {
            pg8::Gemm g{WSP(bf16, WS_MIX), WSP(bf16, WS_WOUT) + (size_t)l * DM * DM, NTOK, DM, DM, DM}; pg8::StaticOrder S; S.init(NTOK, DM, F.G, cb);
            pg8::EpiAny E{(void*)WSP(float, WS_O), DM, 1};
            pg8::gemm_phase<pg8::EpiAny, pg8::StaticOrder, true, true>(F.lds + RING_OFF, g, S, E); }
            SEAM(pb + 5);
        }
        if (KIND_ON(8) && IN(pb + 6)) { RELANE(); norm_phase<1>(F, l); SEAM(pb + 6); }
        if (KIND_ON(9) && IN(pb + 7)) {
            for (int rep = 0; rep < NREP(9); ++rep) {
            pg8::Gemm g{WSP(bf16, WS_H), WSP(bf16, WS_WUP) + (size_t)l * UPN * DM, NTOK, UPN, DM, DM}; pg8::StaticOrder S; S.init(NTOK, UPN, F.G, cb);
            pg8::EpiAny E{(void*)WSP(bf16, WS_U), UPN, 0};
            pg8::gemm_phase<pg8::EpiAny, pg8::StaticOrder, true, true>(F.lds + RING_OFF, g, S, E); }
            SEAM(pb + 7);
        }
        if (KIND_ON(10) && IN(pb + 8)) { for (int rep = 0; rep < NREP(10); ++rep) { RELANE(); ffn_act_phase(F, l); } SEAM(pb + 8); }
        if (KIND_ON(11) && IN(pb + 9)) {
            for (int rep = 0; rep < NREP(11); ++rep) {
            pg8::Gemm g{WSP(bf16, WS_ACT), WSP(bf16, WS_WDN) + (size_t)l * DM * DFF, NTOK, DM, DFF, DFF}; pg8::StaticOrder S; S.init(NTOK, DM, F.G, cb);
            pg8::EpiAny E{(void*)WSP(float, WS_O), DM, 1};
            pg8::gemm_phase<pg8::EpiAny, pg8::StaticOrder, true, true>(F.lds + RING_OFF, g, S, E); }
            SEAM(pb + 9);
        }
        if (KIND_ON(12) && IN(pb + 10)) { RELANE(); norm_phase<2>(F, l); SEAM(pb + 10); }
    }
#undef IN
#undef SEAM
}

extern "C" void kernel_launch(void* const* d_in, const int* in_sizes, int n_in, void* d_out, int out_size, void* d_ws, size_t ws_size, hipStream_t stream) {
    static int grid = 0;
    if (grid == 0) {
        if (n_in != NIN || (size_t)out_size != OUT_END || ws_size < WS_END) { fprintf(stderr, "kernel_launch: built for %d inputs, %zu outputs, >= %zu bytes of workspace; got n_in %d, out %d, ws %zu; nothing launched\n", NIN, (size_t)OUT_END, (size_t)WS_END, n_in, out_size, ws_size); grid = -1; return; }
        int dev = 0, cus = 0, per_cu = 0;
        if (hipGetDevice(&dev) != hipSuccess || hipDeviceGetAttribute(&cus, hipDeviceAttributeMultiprocessorCount, dev) != hipSuccess) { fprintf(stderr, "kernel_launch: device query failed\n"); grid = -1; return; }
        if (hipFuncSetAttribute((const void*)mk_fwd, hipFuncAttributeMaxDynamicSharedMemorySize, LDS_BYTES) != hipSuccess) { fprintf(stderr, "kernel_launch: hipFuncSetAttribute failed\n"); grid = -1; return; }
        if (hipOccupancyMaxActiveBlocksPerMultiprocessor(&per_cu, (const void*)mk_fwd, NWAVES * 64, LDS_BYTES) != hipSuccess || per_cu < 1)
            fprintf(stderr, "kernel_launch: note: occupancy query reports %d workgroups per CU\n", per_cu);
        (void)hipGetLastError();
        grid = cus;
    }
    if (grid < 0) return;
    if (hipMemsetAsync((char*)d_ws + WS_CTL, 0, CTL_BYTES, stream) != hipSuccess) { fprintf(stderr, "kernel_launch: memset failed\n"); return; }
    Args a{};
    for (int i = 0; i < NIN; ++i) a.in[i] = (const float*)d_in[i];
    a.out = (float*)d_out; a.ws = (unsigned char*)d_ws; a.pad = 0;
#if MK_MODE == 1
    const int nl = 1; const int cuts[2] = {0, NPHASES};
#else
    const int nl = NPHASES; int cuts[NPHASES + 1]; for (int i = 0; i <= NPHASES; ++i) cuts[i] = i;
#endif
    for (int li = 0; li < nl; ++li) {
        a.ph_lo = cuts[li]; a.ph_hi = cuts[li + 1]; a.li = li;
        hipLaunchKernelGGL(mk_fwd, dim3(grid), dim3(NWAVES * 64), LDS_BYTES, stream, a);
        const hipError_t le = hipPeekAtLastError();
        if (le != hipSuccess) { fprintf(stderr, "kernel_launch: launch %d failed: %s\n", li, hipGetErrorName(le)); break; }
    }
}
```

```cpp
#include <hip/hip_runtime.h>
#include <cstdio>
#include <cstdint>
namespace pg8 {
#define PG8_LAS __attribute__((address_space(3)))
typedef unsigned short bf16_t;
typedef short bf16x8 __attribute__((ext_vector_type(8)));
typedef float f32x4 __attribute__((ext_vector_type(4)));
typedef unsigned u32x4 __attribute__((ext_vector_type(4)));
constexpr int BM = 256, BK = 64, HALF = 128, HTB = HALF * BK * 2  , STAGE_BYTES = 8 * HTB, NXCD = 8, WGM = 8;

__host__ __device__ __forceinline__ int lds_byte(int r, int c) { const int st = (r >> 4) * 2 + (c >> 5), rr = r & 15, cc = c & 31, ob = rr * 64 + cc * 2; return st * 1024 + (ob ^ (((ob >> 9) & 1) << 5)); }
__host__ __device__ __forceinline__ void stage_rc(int b, int& R, int& C) { const int st = b / 1024, sb = b % 1024, swz = sb ^ (((sb >> 9) & 1) << 5); R = (st >> 1) * 16 + swz / 64; C = (st & 1) * 32 + (swz % 64) / 2; }
__host__ __device__ __forceinline__ int perm32(int rho) { const int n = rho >> 4, i = rho & 15; return 8 * (i >> 2) + 4 * n + (i & 3); }

struct Unit { int pm, pn; };
struct Gemm { const bf16_t* A; const bf16_t* Bt; int M, N, K, lda; };

struct StaticOrder {
    int nM, nN, nwg, G, c;
    __host__ __device__ void init(int M, int N, int G_, int c_) { nM = M / BM; nN = N / BM; nwg = nM * nN; G = G_; c = c_; }
    __host__ __device__ bool next(int i, Unit& u) const {
        const long L = (long)i * G + c; if (L >= nwg) return false;
        int wgid = (int)L; { const int q = nwg / NXCD, r = nwg % NXCD, xcd = wgid % NXCD, off = wgid / NXCD; wgid = (xcd < r ? xcd * (q + 1) : r * (q + 1) + (xcd - r) * q) + off; }
        const int nig = WGM * nN, gid = wgid / nig, fm = gid * WGM, gsz = (nM - fm) < WGM ? (nM - fm) : WGM;
        u.pm = fm + ((wgid % nig) % gsz); u.pn = (wgid % nig) / gsz; return true;
    }
    __device__ __forceinline__ void a_ready(const Unit&) const {}
    __device__ __forceinline__ void done(const Unit&) const {}
};

__device__ __forceinline__ unsigned cvt_pk_bf16(float lo, float hi) { unsigned r; asm volatile("v_cvt_pk_bf16_f32 %0, %1, %2" : "=v"(r) : "v"(lo), "v"(hi)); return r; }
typedef float f32x2 __attribute__((ext_vector_type(2)));
struct EpiF32 {
    static constexpr bool PERM = false, AFTER_DRAIN = false;
    float* C; int ldc; const float* bias;
    __device__ __forceinline__ void operator()(const f32x4 (&acc)[2][2][4][2], const Unit& u, int wr, int wc, int fr, int fq) const {
        const int row0 = u.pm * BM + wr * 64 + fr, col0 = u.pn * BM + wc * 32 + 4 * fq;
        f32x4 bv[2][2];
#pragma unroll
        for (int bj = 0; bj < 2; ++bj)
#pragma unroll
            for (int n = 0; n < 2; ++n) bv[bj][n] = bias ? *(const f32x4*)(bias + col0 + bj * HALF + n * 16) : (f32x4){0.f, 0.f, 0.f, 0.f};
#pragma unroll
        for (int ai = 0; ai < 2; ++ai)
#pragma unroll
            for (int m = 0; m < 4; ++m) { float* rowp = C + (size_t)(row0 + ai * HALF + m * 16) * ldc + col0;
#pragma unroll
                for (int bj = 0; bj < 2; ++bj)
#pragma unroll
                    for (int n = 0; n < 2; ++n) *(f32x4*)(rowp + bj * HALF + n * 16) = acc[ai][bj][m][n] + bv[bj][n]; }
    }
};
struct EpiAny {
    static constexpr bool PERM = true, AFTER_DRAIN = false;
    void* O; int ldc; int f32;
    __device__ __forceinline__ void operator()(const f32x4 (&acc)[2][2][4][2], const Unit& u, int wr, int wc, int fr, int fq) const {
        const int row0 = u.pm * BM + wr * 64 + fr, col0 = u.pn * BM + wc * 32 + 8 * fq;
        if (f32) {
#pragma unroll
            for (int ai = 0; ai < 2; ++ai)
#pragma unroll
                for (int m = 0; m < 4; ++m) { float* rowp = (float*)O + (size_t)(row0 + ai * HALF + m * 16) * ldc + col0;
#pragma unroll
                    for (int bj = 0; bj < 2; ++bj) { *(f32x4*)(rowp + bj * HALF) = acc[ai][bj][m][0]; *(f32x4*)(rowp + bj * HALF + 4) = acc[ai][bj][m][1]; } }
        } else {
#pragma unroll
            for (int ai = 0; ai < 2; ++ai)
#pragma unroll
                for (int m = 0; m < 4; ++m) { bf16_t* rowp = (bf16_t*)O + (size_t)(row0 + ai * HALF + m * 16) * ldc + col0;
#pragma unroll
                    for (int bj = 0; bj < 2; ++bj) { const f32x4 v0 = acc[ai][bj][m][0], v1 = acc[ai][bj][m][1];
                        u32x4 w; w.x = cvt_pk_bf16(v0[0], v0[1]); w.y = cvt_pk_bf16(v0[2], v0[3]); w.z = cvt_pk_bf16(v1[0], v1[1]); w.w = cvt_pk_bf16(v1[2], v1[3]);
                        *(u32x4*)(rowp + bj * HALF) = w; } }
        }
    }
};

template <int CTRL> __device__ __forceinline__ float dpp_keep(float old, float x) { return __builtin_bit_cast(float, __builtin_amdgcn_update_dpp(__builtin_bit_cast(int, old), __builtin_bit_cast(int, x), CTRL, 0xf, 0xf, false)); }
struct EpiFfnAct {
    static constexpr bool PERM = true, AFTER_DRAIN = false;
    bf16_t* ACT; int ldact, dff, upn; const float* cw; const float* cb; float* HG; PG8_LAS unsigned char* hl;
    __device__ __forceinline__ void operator()(const f32x4 (&acc)[2][2][4][2], const Unit& u, int wr, int wc, int fr, int fq) const {
        const int colh = wc * 32 + 8 * fq;
#pragma unroll
        for (int ai = 0; ai < 2; ++ai)
#pragma unroll
            for (int bj = 0; bj < 2; ++bj) { const int q = 2 * ai + wr;
                if (fr == 0) { const f32x4 v0 = acc[ai][bj][0][0], v1 = acc[ai][bj][0][1]; u32x4 w; w.x = cvt_pk_bf16(v0[0], v0[1]); w.y = cvt_pk_bf16(v0[2], v0[3]); w.z = cvt_pk_bf16(v1[0], v1[1]); w.w = cvt_pk_bf16(v1[2], v1[3]);
                    *(PG8_LAS u32x4*)(hl + ((q * 2 + 0) * 2 + bj) * 256 + colh * 2) = w; }
                if (fr == 15) { const f32x4 v0 = acc[ai][bj][3][0], v1 = acc[ai][bj][3][1]; u32x4 w; w.x = cvt_pk_bf16(v0[0], v0[1]); w.y = cvt_pk_bf16(v0[2], v0[3]); w.z = cvt_pk_bf16(v1[0], v1[1]); w.w = cvt_pk_bf16(v1[2], v1[3]);
                    *(PG8_LAS u32x4*)(hl + ((q * 2 + 1) * 2 + bj) * 256 + colh * 2) = w; } }
        { float* hg = HG + ((size_t)(u.pm * (dff / 128) + u.pn) * 4) * 256 + colh;
          if (wr == 0 && fr < 2) {
#pragma unroll
              for (int bj = 0; bj < 2; ++bj) { *(f32x4*)(hg + fr * 256 + bj * 128) = acc[0][bj][0][0]; *(f32x4*)(hg + fr * 256 + bj * 128 + 4) = acc[0][bj][0][1]; } }
          if (wr == 1 && fr >= 14) {
#pragma unroll
              for (int bj = 0; bj < 2; ++bj) { *(f32x4*)(hg + (fr - 12) * 256 + bj * 128) = acc[1][bj][3][0]; *(f32x4*)(hg + (fr - 12) * 256 + bj * 128 + 4) = acc[1][bj][3][1]; } } }
        asm volatile("s_waitcnt lgkmcnt(0)" ::: "memory"); __builtin_amdgcn_s_barrier(); asm volatile("" ::: "memory");
        const int cg0 = u.pn * 128 + colh;
        unsigned pk[2][2][4][2];
#pragma unroll
        for (int n = 0; n < 2; ++n) {
            f32x4 wg[3], wv[3];
#pragma unroll
            for (int j = 0; j < 3; ++j) { wg[j] = *(const f32x4*)(cw + (size_t)j * upn + cg0 + 4 * n); wv[j] = *(const f32x4*)(cw + (size_t)j * upn + dff + cg0 + 4 * n); }
            const f32x4 bg = *(const f32x4*)(cb + cg0 + 4 * n), bv = *(const f32x4*)(cb + dff + cg0 + 4 * n);
#pragma unroll
            for (int ai = 0; ai < 2; ++ai) { const int q = 2 * ai + wr;
                f32x4 hp[2], hn[2];
#pragma unroll
                for (int bj = 0; bj < 2; ++bj) {
                    unsigned a0 = 0u, a1 = 0u, b0 = 0u, b1 = 0u;
                    if (q > 0) { const PG8_LAS unsigned* p = (const PG8_LAS unsigned*)(hl + (((q - 1) * 2 + 1) * 2 + bj) * 256 + colh * 2 + n * 8); a0 = p[0]; a1 = p[1]; }
                    if (q < 3) { const PG8_LAS unsigned* p = (const PG8_LAS unsigned*)(hl + (((q + 1) * 2 + 0) * 2 + bj) * 256 + colh * 2 + n * 8); b0 = p[0]; b1 = p[1]; }
                    hp[bj] = (f32x4){__uint_as_float(a0 << 16), __uint_as_float(a0 & 0xffff0000u), __uint_as_float(a1 << 16), __uint_as_float(a1 & 0xffff0000u)};
                    hn[bj] = (f32x4){__uint_as_float(b0 << 16), __uint_as_float(b0 & 0xffff0000u), __uint_as_float(b1 << 16), __uint_as_float(b1 & 0xffff0000u)}; }
#pragma unroll
                for (int m = 0; m < 4; ++m) {
                    f32x4 cv[2];
#pragma unroll
                    for (int bj = 0; bj < 2; ++bj) {
                        const f32x4 cur = acc[ai][bj][m][n]; f32x4 pv, nx;
#pragma unroll
                        for (int e = 0; e < 4; ++e) {
                            float t = hp[bj][e]; if (m > 0) t = dpp_keep<0x10F>(t, acc[ai][bj][m > 0 ? m - 1 : 0][n][e]);
                            pv[e] = dpp_keep<0x111>(t, cur[e]);
                            float s = hn[bj][e]; if (m < 3) s = dpp_keep<0x11F>(s, acc[ai][bj][m < 3 ? m + 1 : 3][n][e]);
                            nx[e] = dpp_keep<0x101>(s, cur[e]); }
                        cv[bj] = pv * (bj == 0 ? wg[0] : wv[0]) + cur * (bj == 0 ? wg[1] : wv[1]) + nx * (bj == 0 ? wg[2] : wv[2]) + (bj == 0 ? bg : bv);
                    }
                    float r[4];
#pragma unroll
                    for (int e = 0; e < 4; ++e) { const float g = cv[0][e]; r[e] = g * __builtin_amdgcn_rcpf(1.0f + __expf(-g)) * cv[1][e]; }
                    pk[n][ai][m][0] = cvt_pk_bf16(r[0], r[1]); pk[n][ai][m][1] = cvt_pk_bf16(r[2], r[3]);
                }
            }
            __builtin_amdgcn_sched_barrier(0);
        }
#pragma unroll
        for (int ai = 0; ai < 2; ++ai)
#pragma unroll
            for (int m = 0; m < 4; ++m) { u32x4 w; w.x = pk[0][ai][m][0]; w.y = pk[0][ai][m][1]; w.z = pk[1][ai][m][0]; w.w = pk[1][ai][m][1];
                *(u32x4*)(ACT + (size_t)(u.pm * BM + ai * HALF + wr * 64 + m * 16 + fr) * ldact + cg0) = w; }
    }
};
template <class Epi, class Sched, bool ALIGN_EPI = false, bool SP2 = false>
__device__ __forceinline__ void gemm_phase(PG8_LAS unsigned char* lds, const Gemm g, const Sched& S, const Epi& E) {
    int tid_ = threadIdx.x; asm volatile("" : "+v"(tid_));
    const int tid = tid_, wid = __builtin_amdgcn_readfirstlane(tid >> 6), lane = tid & 63, wr = wid >> 2, wc = wid & 3, fr = lane & 15, fq = lane >> 4;
    const int K = g.K, nt = K / BK;
    unsigned voffA[2], voffB[2];
#pragma unroll
    for (int i = 0; i < 2; ++i) { int R, C; stage_rc(tid * 16 + i * 8192, R, C); const int Rb = Epi::PERM ? ((R & ~31) + perm32(R & 31)) : R;
        voffA[i] = (unsigned)(R * g.lda + C) * 2u; voffB[i] = (unsigned)(Rb * K + C) * 2u; }
    const size_t kstep = (size_t)(BK * 2);
    const size_t hstep = (size_t)HALF * K * 2;
    const size_t tstep = 2 * hstep;
    const size_t hstepA = (size_t)HALF * g.lda * 2, tstepA = 2 * hstepA;
    const unsigned ldsw = (unsigned)wid * 1024u;
    const int aoff = lds_byte(wr * 64 + fr, fq * 8), boff = lds_byte(wc * 32 + fr, fq * 8);
#define PG8_SA(b, h) (((b) * 2 + (h)) * HTB)
#define PG8_SB(b, h) ((4 + (b) * 2 + (h)) * HTB)
#define PG8_STAGE(bufoff, gbase, voff) do { _Pragma("unroll") for (int _i = 0; _i < 2; ++_i) \
        __builtin_amdgcn_global_load_lds((const unsigned*)((const char*)(gbase) + (voff)[_i]), (PG8_LAS unsigned*)(lds + (bufoff) + ldsw + _i * 8192), 16, 0, 0); } while (0)
#define PG8_LDA(dst, b, h) do { _Pragma("unroll") for (int m = 0; m < 4; ++m) _Pragma("unroll") for (int k = 0; k < 2; ++k) dst[m][k] = *(const PG8_LAS bf16x8*)(lds + PG8_SA(b, h) + aoff + m * 2048 + k * 1024); } while (0)
#define PG8_LDB(dst, b, h) do { _Pragma("unroll") for (int n = 0; n < 2; ++n) _Pragma("unroll") for (int k = 0; k < 2; ++k) dst[n][k] = *(const PG8_LAS bf16x8*)(lds + PG8_SB(b, h) + boff + n * 2048 + k * 1024); } while (0)
#define PG8_MMA(ai, bj, At, Bt) do { __builtin_amdgcn_s_setprio(1); _Pragma("unroll") for (int m = 0; m < 4; ++m) _Pragma("unroll") for (int n = 0; n < 2; ++n) _Pragma("unroll") for (int k = 0; k < 2; ++k) \
        acc[ai][bj][m][n] = __builtin_amdgcn_mfma_f32_16x16x32_bf16(Bt[n][k], At[m][k], acc[ai][bj][m][n], 0, 0, 0); __builtin_amdgcn_s_setprio(0); } while (0)
#define PG8_WAIT_V(n) asm volatile("s_waitcnt vmcnt(" #n ")" ::: "memory")
#define PG8_WAIT_L(n) asm volatile("s_waitcnt lgkmcnt(" #n ")" ::: "memory")
#define PG8_BAR __builtin_amdgcn_s_barrier()
#define PG8_SCHED __builtin_amdgcn_sched_barrier(0)
    Unit cur, nxt; int ui = 0;
    if (!S.next(0, cur)) return;
    f32x4 acc[2][2][4][2];
#pragma unroll
    for (int a = 0; a < 2; ++a)
#pragma unroll
        for (int b = 0; b < 2; ++b)
#pragma unroll
            for (int m = 0; m < 4; ++m)
#pragma unroll
                for (int n = 0; n < 2; ++n) acc[a][b][m][n] = (f32x4){0.f, 0.f, 0.f, 0.f};
    bf16x8 At[4][2], B0[2][2], B1[2][2];
    const char* cA = (const char*)g.A + (size_t)cur.pm * tstepA; const char* cB = (const char*)g.Bt + (size_t)cur.pn * tstep;
    S.a_ready(cur);
    if constexpr (SP2) {
        PG8_STAGE(PG8_SB(0, 0), cB, voffB); PG8_STAGE(PG8_SB(0, 1), cB + hstep, voffB); PG8_STAGE(PG8_SA(0, 0), cA, voffA); PG8_STAGE(PG8_SA(0, 1), cA + hstepA, voffA);
        if (wr == 1) PG8_BAR;
        PG8_WAIT_V(2); PG8_BAR;
        PG8_STAGE(PG8_SB(1, 0), cB + kstep, voffB); PG8_STAGE(PG8_SA(1, 0), cA + kstep, voffA); PG8_STAGE(PG8_SB(1, 1), cB + hstep + kstep, voffB);
        PG8_WAIT_V(6); PG8_BAR;
    } else {
        PG8_STAGE(PG8_SB(0, 0), cB, voffB); PG8_STAGE(PG8_SA(0, 0), cA, voffA); PG8_STAGE(PG8_SB(0, 1), cB + hstep, voffB); PG8_STAGE(PG8_SA(0, 1), cA + hstepA, voffA);
        if (wr == 1) PG8_BAR;
        PG8_WAIT_V(4); PG8_BAR;
        PG8_STAGE(PG8_SB(1, 0), cB + kstep, voffB); PG8_STAGE(PG8_SA(1, 0), cA + kstep, voffA); PG8_STAGE(PG8_SB(1, 1), cB + hstep + kstep, voffB);
        PG8_WAIT_V(6); PG8_BAR;
    }
    for (;;) {
        const bool has_next = S.next(ui + 1, nxt);
        const char* nA = has_next ? (const char*)g.A + (size_t)nxt.pm * tstepA : cA; const char* nB = has_next ? (const char*)g.Bt + (size_t)nxt.pn * tstep : cB;
        for (int t = 0; t < nt; t += 2) {
            const bool last = (t == nt - 2);
            const char* a1 = cA + (size_t)(t + 1) * kstep;
            const char* a2 = last ? nA : cA + (size_t)(t + 2) * kstep; const char* b2 = last ? nB : cB + (size_t)(t + 2) * kstep;
            const char* a3 = a2 + kstep; const char* b3 = b2 + kstep;
            if (last && has_next) S.a_ready(nxt);
            if constexpr (SP2) {
            PG8_LDB(B0, 0, 0); PG8_LDB(B1, 0, 1); PG8_SCHED; PG8_LDA(At, 0, 0); PG8_STAGE(PG8_SA(1, 1), a1 + hstepA, voffA);
            PG8_WAIT_V(8); PG8_WAIT_L(0); PG8_BAR; PG8_MMA(0, 0, At, B0); PG8_MMA(0, 1, At, B1); PG8_BAR; PG8_SCHED;
            PG8_LDA(At, 0, 1); PG8_STAGE(PG8_SB(0, 0), b2, voffB); PG8_STAGE(PG8_SB(0, 1), b2 + hstep, voffB); PG8_STAGE(PG8_SA(0, 0), a2, voffA);
            PG8_WAIT_V(8); PG8_WAIT_L(0); PG8_BAR; PG8_MMA(1, 0, At, B0); PG8_MMA(1, 1, At, B1); PG8_BAR; PG8_SCHED;
            PG8_LDB(B0, 1, 0); PG8_LDB(B1, 1, 1); PG8_SCHED; PG8_LDA(At, 1, 0); PG8_STAGE(PG8_SA(0, 1), a2 + hstepA, voffA);
            PG8_WAIT_V(8); PG8_WAIT_L(0); PG8_BAR; PG8_MMA(0, 0, At, B0); PG8_MMA(0, 1, At, B1); PG8_BAR; PG8_SCHED;
            PG8_LDA(At, 1, 1); PG8_STAGE(PG8_SB(1, 0), b3, voffB); PG8_STAGE(PG8_SB(1, 1), b3 + hstep, voffB); PG8_STAGE(PG8_SA(1, 0), a3, voffA);
            PG8_WAIT_V(8); PG8_WAIT_L(0); PG8_BAR; PG8_MMA(1, 0, At, B0); PG8_MMA(1, 1, At, B1); PG8_BAR; PG8_SCHED;
            } else {
            PG8_LDB(B0, 0, 0); PG8_SCHED; PG8_LDA(At, 0, 0); PG8_STAGE(PG8_SA(1, 1), a1 + hstepA, voffA);
            PG8_WAIT_L(8); PG8_BAR; PG8_WAIT_L(0); PG8_MMA(0, 0, At, B0); PG8_BAR; PG8_SCHED;
            PG8_LDB(B1, 0, 1); PG8_STAGE(PG8_SB(0, 0), b2, voffB);
            PG8_BAR; PG8_WAIT_L(0); PG8_MMA(0, 1, At, B1); PG8_BAR;
            PG8_LDA(At, 0, 1); PG8_STAGE(PG8_SA(0, 0), a2, voffA);
            PG8_BAR; PG8_WAIT_L(0); PG8_MMA(1, 0, At, B0); PG8_BAR; PG8_SCHED;
            PG8_STAGE(PG8_SB(0, 1), b2 + hstep, voffB);
            PG8_WAIT_V(6); PG8_BAR; PG8_MMA(1, 1, At, B1); PG8_BAR;
            PG8_LDB(B0, 1, 0); PG8_SCHED; PG8_LDA(At, 1, 0); PG8_STAGE(PG8_SA(0, 1), a2 + hstepA, voffA);
            PG8_WAIT_L(8); PG8_BAR; PG8_WAIT_L(0); PG8_MMA(0, 0, At, B0); PG8_BAR; PG8_SCHED;
            PG8_LDB(B1, 1, 1); PG8_STAGE(PG8_SB(1, 0), b3, voffB);
            PG8_BAR; PG8_WAIT_L(0); PG8_MMA(0, 1, At, B1); PG8_BAR;
            PG8_LDA(At, 1, 1); PG8_STAGE(PG8_SA(1, 0), a3, voffA);
            PG8_BAR; PG8_WAIT_L(0); PG8_MMA(1, 0, At, B0); PG8_BAR; PG8_SCHED;
            PG8_STAGE(PG8_SB(1, 1), b3 + hstep, voffB);
            PG8_WAIT_V(6); PG8_BAR; PG8_MMA(1, 1, At, B1); PG8_BAR;
            }
        }
        if constexpr (ALIGN_EPI) { if (wr == 0) PG8_BAR; }
        if constexpr (!Epi::AFTER_DRAIN) { E(acc, cur, wr, wc, fr, fq); S.done(cur); }
        if (!has_next) break;
#pragma unroll
        for (int a = 0; a < 2; ++a)
#pragma unroll
            for (int b = 0; b < 2; ++b)
#pragma unroll
                for (int m = 0; m < 4; ++m)
#pragma unroll
                    for (int n = 0; n < 2; ++n) acc[a][b][m][n] = (f32x4){0.f, 0.f, 0.f, 0.f};
        cur = nxt; cA = nA; cB = nB; ++ui;
        if constexpr (ALIGN_EPI) { if (wr == 1) PG8_BAR; }
    }
    PG8_WAIT_V(0);
    if constexpr (!ALIGN_EPI) { if (wr == 0) PG8_BAR; }
    PG8_BAR;
    if constexpr (Epi::AFTER_DRAIN) { E.fused(acc, cur, wr, wc, fr, fq, lds, wid, lane); S.done(cur); }
#undef PG8_SA
#undef PG8_SB
#undef PG8_STAGE
#undef PG8_LDA
#undef PG8_LDB
#undef PG8_MMA
#undef PG8_WAIT_V
#undef PG8_WAIT_L
#undef PG8_BAR
#undef PG8_SCHED
}
}

constexpr int DM = 2048, NTOK = 8192, NCTX = 4096, DEPTH = 4, NIN = 34;
constexpr int INW = 3136, INP = 3328;
constexpr int OFF_KV = 512, OFF_KR = 768, OFF_XF = 832, OFF_RKV = 1344, OFF_WLO = 2880, OFF_ALO = 2944, OFF_GLO = 3008;
constexpr int DFF = 5632, UPN = 11264, KVROWS = 9216, LORAN = 2560, QW = 1536;
constexpr float EPS = 1e-6f, GN_EPS = 64e-5f, DECAY_SCALE = 0.6065306597126334f;
enum { I_XP = 0, I_XS, I_CKV, I_CKR, I_ST, I_C, I_CCTX, I_WMOD, I_BMOD, I_GPREMIX, I_GPOSTMIX, I_GPREFFN, I_GPOSTFFN, I_WIN, I_GQ, I_WUQ, I_GKV, I_WUKV,
       I_RCONV, I_RW0, I_RW2, I_RA0, I_RA2, I_RG2, I_RKK, I_RKA, I_RRK, I_GNG, I_GNB, I_WOUT, I_WUP, I_FCONV, I_FCONVB, I_WDOWN };
constexpr size_t OUT_X = 0, OUT_CKV = (size_t)NTOK * DM, OUT_KR = OUT_CKV + (size_t)16 * 4 * 256 * 256, OUT_ST = OUT_KR + (size_t)16 * 4 * 256 * 64, OUT_END = OUT_ST + (size_t)16 * 4 * 2 * 8 * 64 * 64;

constexpr size_t A256(size_t x) { return (x + 255) & ~(size_t)255; }
constexpr size_t WS_CTL = 0, CTL_BYTES = 1u << 20;
constexpr size_t WS_MOD   = WS_CTL + CTL_BYTES;
constexpr size_t WS_ROPE  = WS_MOD + A256((size_t)4 * 5 * 12288 * 4);
constexpr size_t WS_P256  = WS_ROPE + A256((size_t)2 * 1024 * 32 * 4);
constexpr size_t WS_P1024 = WS_P256 + A256((size_t)256 * 512 * 2);
constexpr size_t WS_MBD   = WS_P1024 + A256((size_t)1024 * 2048 * 2);
constexpr size_t WS_WL    = WS_MBD + A256((size_t)1024 * 512 * 2);
constexpr size_t WS_WIN   = WS_WL + A256((size_t)4 * LORAN * 256 * 2);
constexpr size_t WS_WUQ   = WS_WIN + A256((size_t)4 * INP * DM * 2);
constexpr size_t WS_WUKV  = WS_WUQ + A256((size_t)4 * QW * 512 * 2);
constexpr size_t WS_WOUT  = WS_WUKV + A256((size_t)4 * 2048 * 256 * 2);
constexpr size_t WS_WUP   = WS_WOUT + A256((size_t)4 * DM * DM * 2);
constexpr size_t WS_WDN   = WS_WUP + A256((size_t)4 * UPN * DM * 2);
constexpr size_t WS_H     = WS_WDN + A256((size_t)4 * DM * DFF * 2);
constexpr size_t WS_PROJ  = WS_H + A256((size_t)NTOK * DM * 2);
constexpr size_t WS_QN    = WS_PROJ + A256((size_t)NTOK * INP * 2);
constexpr size_t WS_CKVA  = WS_QN + A256((size_t)NTOK * 512 * 2);
constexpr size_t WS_KR    = WS_CKVA + A256((size_t)KVROWS * 256 * 2);
constexpr size_t WS_AL    = WS_KR + A256((size_t)KVROWS * 64 * 2);
constexpr size_t WS_RC    = WS_AL + A256((size_t)NTOK * 256 * 2);
constexpr size_t WS_KC    = WS_RC + A256((size_t)NTOK * 512 * 4);
constexpr size_t WS_VC    = WS_KC + A256((size_t)NTOK * 512 * 4);
constexpr size_t WS_NK    = WS_VC + A256((size_t)NTOK * 512 * 4);
constexpr size_t WS_Q     = WS_NK + A256((size_t)NTOK * 8 * 4);
constexpr size_t WS_KV    = WS_Q + A256((size_t)NTOK * QW * 2);
constexpr size_t WS_LORA  = WS_KV + A256((size_t)KVROWS * 2048 * 2);
constexpr size_t WS_Y     = WS_LORA + A256((size_t)NTOK * LORAN * 2);
constexpr size_t WS_YF    = WS_Y + A256((size_t)NTOK * 1024 * 2);
constexpr size_t WS_YB    = WS_YF + A256((size_t)NTOK * 512 * 4);
constexpr size_t WS_BON   = WS_YB + A256((size_t)NTOK * 512 * 4);
constexpr size_t WS_MIX   = WS_BON + A256((size_t)2 * NTOK * 8 * 4);
constexpr size_t WS_O     = WS_MIX + A256((size_t)NTOK * DM * 2);
constexpr size_t WS_HALO  = WS_O + A256((size_t)NTOK * DM * 4);
constexpr size_t WS_ACT   = WS_HALO + A256((size_t)32 * 44 * 4 * 256 * 4);
constexpr size_t WS_END   = WS_ACT + A256((size_t)NTOK * DFF * 2);
constexpr int CW_TMO = 0, CW_CODE = 1, CW_QUEUE = 64  , CW_BAR = 4096;
constexpr int NPHASES = 2 + 11 * DEPTH;
constexpr int RING_OFF = 0, RING_BYTES = 131072, LDSCTL_OFF = RING_BYTES, MISC_OFF = LDSCTL_OFF + 320, HALO_OFF = MISC_OFF + 128  , LDS_BYTES = 147456, NWAVES = 8;

#define GAS __attribute__((address_space(1)))
#define LAS __attribute__((address_space(3)))
typedef unsigned short bf16;
typedef unsigned v4u __attribute__((ext_vector_type(4)));
typedef unsigned v2u __attribute__((ext_vector_type(2)));
typedef float f32x4 __attribute__((ext_vector_type(4)));
typedef float f32x2 __attribute__((ext_vector_type(2)));
typedef float f32x16 __attribute__((ext_vector_type(16)));
typedef short bf16x8 __attribute__((ext_vector_type(8)));
typedef short s16x4 __attribute__((ext_vector_type(4)));
typedef GAS unsigned gu32;
#define RLX_AGENT __ATOMIC_RELAXED, __HIP_MEMORY_SCOPE_AGENT
#define LDS_WAIT() asm volatile("s_waitcnt lgkmcnt(0)" ::: "memory")
#define VM_WAIT() asm volatile("s_waitcnt vmcnt(0)" ::: "memory")
#define SBAR() __builtin_amdgcn_sched_barrier(0)
__device__ __forceinline__ unsigned cvtpk(float lo, float hi) { unsigned r; asm volatile("v_cvt_pk_bf16_f32 %0, %1, %2" : "=v"(r) : "v"(lo), "v"(hi)); return r; }
__device__ __forceinline__ bf16 f2bf(float f) { return (bf16)(cvtpk(f, 0.f) & 0xffffu); }
__device__ __forceinline__ float bf2f(short s) { return __uint_as_float(((unsigned)(unsigned short)s) << 16); }
__device__ __forceinline__ float wave_sum(float v) {
#pragma unroll
    for (int o = 1; o < 64; o <<= 1) v += __shfl_xor(v, o);
    return v;
}
template <int CTRL> __device__ __forceinline__ float dpp_mov(float x) { return __int_as_float(__builtin_amdgcn_update_dpp(0, __float_as_int(x), CTRL, 0xf, 0xf, true)); }
__device__ __forceinline__ float allred16(float x) {
    x += dpp_mov<0xB1>(x);
    x += dpp_mov<0x4E>(x);
    x += dpp_mov<0x141>(x);
    x += dpp_mov<0x140>(x);
    return x;
}
__device__ __forceinline__ float sigmoidf_(float x) { return 1.0f / (1.0f + __expf(-x)); }
#define XB_TMO      128
#define XB_XCNT(j)  (256  + 64 * (j))
#define XB_XSUB(j)  (1280 + 64 * (j))
#define XB_XGEN(j)  (2304 + 64 * (j))
#define XB_TOP      3328
#define XB_TOPGEN   3392
#define XCD_BAR_WORDS 3456
#define XB_SPIN_CAP (1u << 18)

__device__ __forceinline__ unsigned xb_ld(unsigned* p)              { return __hip_atomic_load(p, __ATOMIC_RELAXED, __HIP_MEMORY_SCOPE_AGENT); }
__device__ __forceinline__ unsigned xb_add(unsigned* p, unsigned v) { return __hip_atomic_fetch_add(p, v, __ATOMIC_RELAXED, __HIP_MEMORY_SCOPE_AGENT); }
__device__ __forceinline__ unsigned xb_xcc_id() { return (unsigned)__builtin_amdgcn_s_getreg((3 << 11) | 20) & 0xFu; }
#define XB_SPIN(cond, bar) do { unsigned _sp = 0; while (cond) { __builtin_amdgcn_s_sleep(1); \
    if ((++_sp & 255u) == 0u) { if (xb_ld(&(bar)[XB_TMO])) break; if (_sp > XB_SPIN_CAP) { atomicAdd(&(bar)[XB_TMO], 1u); break; } } } } while (0)

struct XcdBarrier {
    unsigned* bar; unsigned x;
    volatile LAS unsigned* st;
};

__device__ __forceinline__ XcdBarrier xcd_barrier_post(unsigned* bar, volatile LAS unsigned* st) {
    XcdBarrier b; b.bar = bar; b.x = xb_xcc_id(); b.st = st;
    if (threadIdx.x == 0) (void)xb_add(&bar[XB_XCNT(b.x)], 1u);
    return b;
}
__device__ __forceinline__ void xcd_barrier_complete(unsigned* bar, unsigned x, unsigned& nloc, unsigned& nx) {
    const unsigned G = gridDim.x * gridDim.y * gridDim.z;
    unsigned sum, cnt, mine, sp = 0u;
    for (;;) {
        sum = 0u; cnt = 0u; mine = 0u;
#pragma unroll
        for (unsigned j = 0; j < 16; ++j) { const unsigned c = xb_ld(&bar[XB_XCNT(j)]); sum += c; cnt += (c > 0u) ? 1u : 0u; mine = (j == x) ? c : mine; }
        if (sum == G) break;
        __builtin_amdgcn_s_sleep(1);
        if ((++sp & 255u) == 0u) { if (xb_ld(&bar[XB_TMO])) break; if (sp > XB_SPIN_CAP) { atomicAdd(&bar[XB_TMO], 1u); break; } }
    }
    nloc = mine > 0u ? mine : 1u; nx = cnt > 0u ? cnt : 1u;
}

__device__ __forceinline__ void xcd_barrier(const XcdBarrier& b) {
    asm volatile("s_waitcnt vmcnt(0)" ::: "memory");
    __syncthreads();
    if (threadIdx.x == 0) {
        unsigned* bar = b.bar;
        __builtin_amdgcn_s_waitcnt(0);
        unsigned nloc = b.st[0], nx = b.st[1];
        if (nloc == 0u) { xcd_barrier_complete(bar, b.x, nloc, nx); b.st[0] = nloc; b.st[1] = nx; }
        const unsigned old = xb_add(&bar[XB_XSUB(b.x)], 1u);
        const unsigned gen = old / nloc;
        if (old + 1u == (gen + 1u) * nloc) {
            __builtin_amdgcn_fence(__ATOMIC_RELEASE, "agent");
            asm volatile("s_waitcnt vmcnt(0)" ::: "memory");
            const unsigned og = xb_add(&bar[XB_TOP], 1u);
            const unsigned tg = og / nx;
            if (og + 1u == (tg + 1u) * nx) xb_add(&bar[XB_TOPGEN], 1u);
            else XB_SPIN(xb_ld(&bar[XB_TOPGEN]) == tg, bar);
            __builtin_amdgcn_fence(__ATOMIC_ACQUIRE, "agent");
            xb_add(&bar[XB_XGEN(b.x)], 1u);
            asm volatile("s_waitcnt vmcnt(0)" ::: "memory");
        } else {
            XB_SPIN(xb_ld(&bar[XB_XGEN(b.x)]) == gen, bar);
            __builtin_amdgcn_fence(__ATOMIC_ACQUIRE, "agent");
            asm volatile("s_waitcnt vmcnt(0)" ::: "memory");
        }
    }
    __syncthreads();
}

struct Frame {
    LAS unsigned char* lds;
    volatile LAS unsigned* MISC;
    gu32* ctl;
    int tid, lane, wave, vcu, G;
    const float* const* in;
    float* out; unsigned char* ws;
};
#define WSP(T, off) ((T*)(F.ws + (off)))

template <bool FFNPERM = false> __device__ __forceinline__ void p0_transpose_item(const float* W, int K, int N, bf16* WT, LAS float* scr, int item, int lane) {
    const int nblk = N / 32, kb = item / nblk, nb = item % nblk, k0 = 64 * kb, n0 = 32 * nb;
    const int d0 = !FFNPERM ? n0 : (n0 < DFF ? 256 * (n0 >> 7) + (n0 & 127) : 256 * ((n0 - DFF) >> 7) + 128 + ((n0 - DFF) & 127));
#pragma unroll 8
    for (int i = 0; i < 32; ++i) { const int kk = 2 * i + (lane >> 5); scr[kk * 33 + (lane & 31)] = W[(size_t)(k0 + kk) * N + n0 + (lane & 31)]; }
    LDS_WAIT(); asm volatile("" ::: "memory");
    const int c = lane & 7;
#pragma unroll
    for (int j = 0; j < 4; ++j) { const int n = (lane >> 3) + 8 * j; const LAS float* s = scr + (8 * c) * 33 + n;
        v4u o; o.x = cvtpk(s[0 * 33], s[1 * 33]); o.y = cvtpk(s[2 * 33], s[3 * 33]); o.z = cvtpk(s[4 * 33], s[5 * 33]); o.w = cvtpk(s[6 * 33], s[7 * 33]);
        *(GAS v4u*)(WT + (size_t)(d0 + n) * K + k0 + 8 * c) = o; }
    LDS_WAIT(); asm volatile("" ::: "memory");
}
constexpr int I_IN = (DM / 64) * (INW / 32), I_UQ = (512 / 64) * (QW / 32), I_UKV = (256 / 64) * (2048 / 32), I_OUT = (DM / 64) * (DM / 32), I_UP = (DM / 64) * (UPN / 32), I_DN = (DFF / 64) * (DM / 32);
constexpr int I_LAYER = I_IN + I_UQ + I_UKV + I_OUT + I_UP + I_DN;
__device__ __forceinline__ void convert_wave_item(Frame& F, int l, int r, LAS float* scr) {
    if (r < I_IN) { p0_transpose_item(F.in[I_WIN] + (size_t)l * DM * INW, DM, INW, WSP(bf16, WS_WIN) + (size_t)l * INP * DM, scr, r, F.lane); return; } r -= I_IN;
    if (r < I_UQ) { p0_transpose_item(F.in[I_WUQ] + (size_t)l * 512 * QW, 512, QW, WSP(bf16, WS_WUQ) + (size_t)l * QW * 512, scr, r, F.lane); return; } r -= I_UQ;
    if (r < I_UKV) { p0_transpose_item(F.in[I_WUKV] + (size_t)l * 256 * 2048, 256, 2048, WSP(bf16, WS_WUKV) + (size_t)l * 2048 * 256, scr, r, F.lane); return; } r -= I_UKV;
    if (r < I_OUT) { p0_transpose_item(F.in[I_WOUT] + (size_t)l * DM * DM, DM, DM, WSP(bf16, WS_WOUT) + (size_t)l * DM * DM, scr, r, F.lane); return; } r -= I_OUT;
    if (r < I_UP) { p0_transpose_item<true>(F.in[I_WUP] + (size_t)l * DM * UPN, DM, UPN, WSP(bf16, WS_WUP) + (size_t)l * UPN * DM, scr, r, F.lane); return; } r -= I_UP;
    p0_transpose_item(F.in[I_WDOWN] + (size_t)l * DFF * DM, DFF, DM, WSP(bf16, WS_WDN) + (size_t)l * DM * DFF, scr, r, F.lane);
}
__device__ __forceinline__ void mod_block_item(Frame& F, int l, int ch) {
    LAS float* sc = (LAS float*)(F.lds);
    LAS float* red = (LAS float*)(F.lds + 40960);
    for (int i = F.tid; i < 5 * 2048; i += 512) { const int cd = i >> 11, k = i & 2047; const float x = (cd == 0) ? F.in[I_CCTX][k] : F.in[I_C][(cd - 1) * 2048 + k]; sc[i] = x * sigmoidf_(x); }
    __syncthreads();
    const int kh = F.lane >> 5, c4 = F.lane & 31;
    const float* wp = F.in[I_WMOD] + (size_t)l * DM * 12288 + (size_t)ch * 128 + 4 * c4;
    f32x4 a0 = {0.f, 0.f, 0.f, 0.f}, a1 = a0, a2 = a0, a3 = a0, a4 = a0;
#pragma unroll 8
    for (int i = 0; i < 128; ++i) { const int k = 256 * F.wave + 2 * i + kh; const f32x4 wv = *(const f32x4*)(wp + (size_t)k * 12288);
        a0 += wv * sc[k]; a1 += wv * sc[2048 + k]; a2 += wv * sc[4096 + k]; a3 += wv * sc[6144 + k]; a4 += wv * sc[8192 + k]; }
    const int part = F.wave * 2 + kh;
    *(LAS f32x4*)(red + (part * 5 + 0) * 128 + 4 * c4) = a0; *(LAS f32x4*)(red + (part * 5 + 1) * 128 + 4 * c4) = a1; *(LAS f32x4*)(red + (part * 5 + 2) * 128 + 4 * c4) = a2;
    *(LAS f32x4*)(red + (part * 5 + 3) * 128 + 4 * c4) = a3; *(LAS f32x4*)(red + (part * 5 + 4) * 128 + 4 * c4) = a4;
    __syncthreads();
    for (int i = F.tid; i < 640; i += 512) { const int cd = i >> 7, col = i & 127; float s = F.in[I_BMOD][(size_t)l * 12288 + ch * 128 + col];
#pragma unroll
        for (int p = 0; p < 16; ++p) s += red[(p * 5 + cd) * 128 + col];
        WSP(float, WS_MOD)[((size_t)l * 5 + cd) * 12288 + ch * 128 + col] = s; }
    __syncthreads();
}
__device__ __forceinline__ void p0_prologue(Frame& F) {
    LAS float* scr = (LAS float*)(F.lds + RING_OFF + F.wave * 16384);
    const int gw = F.vcu * NWAVES + F.wave, NGW = F.G * NWAVES;
    for (int it = gw; it < I_LAYER; it += NGW) convert_wave_item(F, 0, it, scr);
    const long gt = (long)F.vcu * 512 + F.tid, NGT = (long)F.G * 512;
    for (long i = gt; i < (long)DEPTH * (INP - INW) * DM / 8; i += NGT) { const int l = (int)(i / ((INP - INW) * DM / 8)); const long r = i % ((INP - INW) * DM / 8);
        *(v4u*)(WSP(bf16, WS_WIN) + (size_t)l * INP * DM + (size_t)INW * DM + r * 8) = (v4u){0u, 0u, 0u, 0u}; }
    for (long i = gt; i < (long)DEPTH * LORAN * 256; i += NGT) { const int l = (int)(i / (LORAN * 256)), n = (int)((i / 256) % LORAN), k = (int)(i & 255);
        float v = 0.f;
        if (n < 1024) { if (k < 64) v = F.in[I_RW2][(((size_t)l * 2 + (n >> 9)) * 64 + k) * 512 + (n & 511)]; }
        else if (n < 2048) { if (k >= 64 && k < 128) v = F.in[I_RA2][(((size_t)l * 2 + ((n - 1024) >> 9)) * 64 + (k - 64)) * 512 + (n & 511)]; }
        else { if (k >= 128) v = F.in[I_RG2][((size_t)l * 128 + (k - 128)) * 512 + (n - 2048)]; }
        WSP(bf16, WS_WL)[i] = f2bf(v); }
    for (long i = gt; i < 1024 * 512; i += NGT) { const int n = (int)(i >> 9), k = (int)(i & 511), g = n >> 8, j = n & 255, g2 = k >> 7, c = k & 127;
        float v = 0.f; if (g == g2) { const int m = (c * (j & 127)) & 127; v = (j < 128) ? cospif((float)m * (1.0f / 64.0f)) : sinpif((float)m * (1.0f / 64.0f)); }
        WSP(bf16, WS_MBD)[i] = f2bf(v); }
    for (long i = gt; i < 256 * 512; i += NGT) { const int tp = (int)(i >> 9), t = (int)(i & 511), m = (tp * (t & 255)) & 255; const float sc = 0.005524271728019903f;
        const float v = (t < 256) ? cospif((float)m * (1.0f / 128.0f)) : -sinpif((float)m * (1.0f / 128.0f)); WSP(bf16, WS_P256)[i] = f2bf(v * sc); }
    for (long i = gt; i < 1024 * 2048; i += NGT) { const int tp = (int)(i >> 11), t = (int)(i & 2047), m = (tp * (t & 1023)) & 1023; const float sc = 0.0027621358640099515f;
        const float v = (t < 1024) ? cospif((float)m * (1.0f / 512.0f)) : -sinpif((float)m * (1.0f / 512.0f)); WSP(bf16, WS_P1024)[i] = f2bf(v * sc); }
    for (long i = gt; i < 1024 * 32; i += NGT) { const int t = (int)(i >> 5), ii = (int)(i & 31); const float pos = (ii < 16) ? (float)(t >> 6) : (float)(t & 63);
        const float inv = exp2f(-(float)(ii & 15) * (13.287712379549449f / 16.0f)); const float ang = pos * inv;
        WSP(float, WS_ROPE)[i] = cosf(ang); WSP(float, WS_ROPE)[1024 * 32 + i] = sinf(ang); }
    __syncthreads();
    for (int it = F.vcu; it < 96; it += F.G) mod_block_item(F, 0, it);
}

template <int MODE> __device__ __forceinline__ void norm_phase(Frame& F, int l) {
    LAS float* vA = (LAS float*)(F.lds); LAS float* vB = vA + 2048; LAS float* vC = vB + 2048;
    const float* MOD = WSP(float, WS_MOD);
    const bool doh = (MODE != 2) || (l < DEPTH - 1);
    for (int ch = F.vcu; ch < NTOK / 32; ch += F.G) {
        const int row0 = 32 * ch, cond = row0 < NCTX ? 0 : 1 + ((row0 - NCTX) >> 10);
        __syncthreads();
        { const int col = 4 * F.tid;
          if (MODE != 0) { const float* gate = MOD + ((size_t)l * 5 + cond) * 12288 + (MODE == 1 ? 4096 : 10240) + col; const float* gp = F.in[MODE == 1 ? I_GPOSTMIX : I_GPOSTFFN] + (size_t)l * DM + col;
              *(LAS f32x4*)(vA + col) = *(const f32x4*)gate * *(const f32x4*)gp; }
          if (doh) { const int ln = (MODE == 2) ? l + 1 : l; const float* mb = MOD + ((size_t)ln * 5 + cond) * 12288;
              const float* gpre = F.in[MODE == 1 ? I_GPREFFN : I_GPREMIX] + (size_t)ln * DM + col;
              const float* scp = mb + (MODE == 1 ? 8192 : 2048) + col; const float* shp = mb + (MODE == 1 ? 6144 : 0) + col;
              *(LAS f32x4*)(vB + col) = *(const f32x4*)gpre * (*(const f32x4*)scp + 1.0f); *(LAS f32x4*)(vC + col) = *(const f32x4*)shp; } }
        __syncthreads();
        for (int rr = 0; rr < 4; ++rr) {
            const int row = row0 + 4 * F.wave + rr;
            float* xrow = F.out + OUT_X + (size_t)row * DM;
            f32x4 x[8];
            if (MODE == 0) { const float* src = row < NCTX ? F.in[I_XP] + (size_t)row * DM : F.in[I_XS] + (size_t)(row - NCTX) * DM;
#pragma unroll
                for (int j = 0; j < 8; ++j) x[j] = *(const f32x4*)(src + 4 * F.lane + 256 * j); }
            else { const float* orow = WSP(float, WS_O) + (size_t)row * DM; f32x4 o[8]; float ss = 0.f;
#pragma unroll
                for (int j = 0; j < 8; ++j) { o[j] = *(const f32x4*)(orow + 4 * F.lane + 256 * j); x[j] = *(const f32x4*)(xrow + 4 * F.lane + 256 * j); ss += o[j].x * o[j].x + o[j].y * o[j].y + o[j].z * o[j].z + o[j].w * o[j].w; }
                const float rs = rsqrtf(wave_sum(ss) * (1.0f / DM) + EPS);
#pragma unroll
                for (int j = 0; j < 8; ++j) x[j] += *(const LAS f32x4*)(vA + 4 * F.lane + 256 * j) * (o[j] * rs); }
#pragma unroll
            for (int j = 0; j < 8; ++j) *(f32x4*)(xrow + 4 * F.lane + 256 * j) = x[j];
            if (doh) { float ss = 0.f;
#pragma unroll
                for (int j = 0; j < 8; ++j) ss += x[j].x * x[j].x + x[j].y * x[j].y + x[j].z * x[j].z + x[j].w * x[j].w;
                const float rs = rsqrtf(wave_sum(ss) * (1.0f / DM) + EPS);
                bf16* hrow = WSP(bf16, WS_H) + (size_t)row * DM;
#pragma unroll
                for (int j = 0; j < 8; ++j) { const f32x4 hv = (x[j] * rs) * *(const LAS f32x4*)(vB + 4 * F.lane + 256 * j) + *(const LAS f32x4*)(vC + 4 * F.lane + 256 * j);
                    v2u w; w.x = cvtpk(hv.x, hv.y); w.y = cvtpk(hv.z, hv.w); *(v2u*)(hrow + 4 * F.lane + 256 * j) = w; } }
        }
    }
}

__device__ __forceinline__ int kv_row(int row) { return row < NCTX ? row : NCTX + ((row - NCTX) >> 10) * 1280 + 256 + ((row - NCTX) & 1023); }
__device__ __forceinline__ void prep_phase(Frame& F, int l) {
    const int gw = F.vcu * NWAVES + F.wave, NGW = F.G * NWAVES, lane = F.lane;
    const bf16* PROJ = WSP(bf16, WS_PROJ);
    for (int row = gw; row < NTOK; row += NGW) {
        const bf16* pr = PROJ + (size_t)row * INP;
        const int kvr = kv_row(row);
        { const bf16x8 qv = *(const bf16x8*)(pr + 8 * lane); float q[8]; float ss = 0.f;
#pragma unroll
          for (int e = 0; e < 8; ++e) { q[e] = bf2f(qv[e]); ss += q[e] * q[e]; }
          const float rs = rsqrtf(wave_sum(ss) * (1.0f / 512.0f) + EPS);
          const float* g = F.in[I_GQ] + (size_t)l * 512 + 8 * lane; const f32x4 g0 = *(const f32x4*)g, g1 = *(const f32x4*)(g + 4);
          v4u w; w.x = cvtpk(q[0] * rs * g0.x, q[1] * rs * g0.y); w.y = cvtpk(q[2] * rs * g0.z, q[3] * rs * g0.w); w.z = cvtpk(q[4] * rs * g1.x, q[5] * rs * g1.y); w.w = cvtpk(q[6] * rs * g1.z, q[7] * rs * g1.w);
          *(v4u*)(WSP(bf16, WS_QN) + (size_t)row * 512 + 8 * lane) = w; }
        { const s16x4 kvv = *(const s16x4*)(pr + OFF_KV + 4 * lane); f32x4 kv = {bf2f(kvv[0]), bf2f(kvv[1]), bf2f(kvv[2]), bf2f(kvv[3])};
          const float rs = rsqrtf(wave_sum(kv.x * kv.x + kv.y * kv.y + kv.z * kv.z + kv.w * kv.w) * (1.0f / 256.0f) + EPS);
          kv = kv * rs * *(const f32x4*)(F.in[I_GKV] + (size_t)l * 256 + 4 * lane);
          v2u w; w.x = cvtpk(kv.x, kv.y); w.y = cvtpk(kv.z, kv.w); *(v2u*)(WSP(bf16, WS_CKVA) + (size_t)kvr * 256 + 4 * lane) = w;
          if (row < NCTX) *(f32x4*)(F.out + OUT_CKV + ((size_t)((row >> 8) * DEPTH + l) * 256 + (row & 255)) * 256 + 4 * lane) = kv; }
        { const float kr = bf2f((short)pr[OFF_KR + lane]); float val = kr;
          if (row < NCTX) F.out[OUT_KR + ((size_t)((row >> 8) * DEPTH + l) * 256 + (row & 255)) * 64 + lane] = kr;
          else { const int t = (row - NCTX) & 1023, i = lane & 31; const float c = WSP(float, WS_ROPE)[t * 32 + i], s = WSP(float, WS_ROPE)[1024 * 32 + t * 32 + i];
              const float other = __shfl_xor(kr, 32); val = (lane < 32) ? kr * c - other * s : other * s + kr * c; }
          WSP(bf16, WS_KR)[(size_t)kvr * 64 + lane] = f2bf(val); }
        { bf16* al = WSP(bf16, WS_AL) + (size_t)row * 256;
          al[lane] = f2bf(tanhf(bf2f((short)pr[OFF_WLO + lane]))); al[64 + lane] = pr[OFF_ALO + lane];
          const unsigned gg = *(const unsigned*)(pr + OFF_GLO + 2 * lane); *(unsigned*)(al + 128 + 2 * lane) = cvtpk(sigmoidf_(__uint_as_float(gg << 16)), sigmoidf_(__uint_as_float(gg & 0xffff0000u))); }
    }
    for (int it = gw; it < (NTOK / 32) * 24; it += NGW) {
        const int chunk = it / 24, grp = it % 24, row0 = 32 * chunk, which = grp >> 3, hh = grp & 7;
        const int s0 = row0 < NCTX ? (row0 & ~255) : NCTX + ((row0 - NCTX) & ~1023), send = s0 + (row0 < NCTX ? 256 : 1024);
        const int ch = 64 * grp + lane, cc = 64 * hh + lane;
        const float* cw = F.in[I_RCONV] + (size_t)l * 3 * 1536;
        const float w0 = cw[ch], w1 = cw[1536 + ch], w2 = cw[3072 + ch];
        const float kk = F.in[I_RKK][(size_t)l * 512 + cc];
        float* dst = WSP(float, which == 0 ? WS_RC : (which == 1 ? WS_KC : WS_VC));
        const bf16* src = PROJ + OFF_RKV + ch;
        float prev = row0 > s0 ? bf2f((short)src[(size_t)(row0 - 1) * INP]) : 0.f, cur = bf2f((short)src[(size_t)row0 * INP]);
#pragma unroll 4
        for (int i = 0; i < 32; ++i) { const int row = row0 + i; const float nxt = (row + 1 < send) ? bf2f((short)src[(size_t)(row + 1) * INP]) : 0.f;
            const float o = prev * w0 + cur * w1 + nxt * w2; dst[(size_t)row * 512 + cc] = o;
            if (which == 1) { const float kap = o * kk; const float ss = wave_sum(kap * kap); if (lane == 0) WSP(float, WS_NK)[row * 8 + hh] = rsqrtf(ss + EPS); }
            prev = cur; cur = nxt; }
    }
    { const long gt = (long)F.vcu * 512 + F.tid, NGT = (long)F.G * 512;
      for (long i = gt; i < 1024 * 64; i += NGT) { const int r = (int)(i >> 6), c4 = (int)(i & 63) * 4, b = r >> 8, j = r & 255;
          const f32x4 v = *(const f32x4*)(F.in[I_CKV] + (((size_t)b * DEPTH + l) * 256 + j) * 256 + c4); v2u w; w.x = cvtpk(v.x, v.y); w.y = cvtpk(v.z, v.w);
          *(v2u*)(WSP(bf16, WS_CKVA) + (size_t)(NCTX + b * 1280 + j) * 256 + c4) = w; }
      for (long i = gt; i < 1024 * 16; i += NGT) { const int r = (int)(i >> 4), c4 = (int)(i & 15) * 4, b = r >> 8, j = r & 255;
          const f32x4 v = *(const f32x4*)(F.in[I_CKR] + (((size_t)b * DEPTH + l) * 256 + j) * 64 + c4); v2u w; w.x = cvtpk(v.x, v.y); w.y = cvtpk(v.z, v.w);
          *(v2u*)(WSP(bf16, WS_KR) + (size_t)(NCTX + b * 1280 + j) * 64 + c4) = w; } }
}

__device__ __forceinline__ void post_phase(Frame& F, int l) {
    const int gw = F.vcu * NWAVES + F.wave, NGW = F.G * NWAVES, lane = F.lane;
    for (int row = gw; row < NTOK; row += NGW) {
#pragma unroll
        for (int h = 0; h < 8; ++h) { const int c = 64 * h + lane;
            const float y = WSP(float, WS_YF)[(size_t)row * 512 + c] + WSP(float, WS_YB)[(size_t)row * 512 + c];
            const float mu = wave_sum(y) * (1.0f / 64.0f); const float d = y - mu; const float var = wave_sum(d * d) * (1.0f / 64.0f);
            const float yn = d * rsqrtf(var + GN_EPS) * F.in[I_GNG][(size_t)l * 512 + c] + F.in[I_GNB][(size_t)l * 512 + c];
            const float bonus = WSP(float, WS_BON)[(size_t)row * 8 + h] + WSP(float, WS_BON)[(size_t)NTOK * 8 + (size_t)row * 8 + h];
            const float o = (yn + bonus * WSP(float, WS_VC)[(size_t)row * 512 + c]) * bf2f((short)WSP(bf16, WS_LORA)[(size_t)row * LORAN + 2048 + c]);
            WSP(bf16, WS_MIX)[(size_t)row * DM + 1536 + c] = f2bf(o); }
    }
}

__device__ __forceinline__ void ffn_fix_phase(Frame& F, int l) {
    const long gt = (long)F.vcu * 512 + F.tid, NGT = (long)F.G * 512;
    const float* cw = F.in[I_FCONV] + (size_t)l * 3 * UPN; const float* cb = F.in[I_FCONVB] + (size_t)l * UPN; const float* HG = WSP(float, WS_HALO);
    for (long i = gt; i < 12L * DFF; i += NGT) { const int sb = (int)(i / DFF), c = (int)(i % DFF), pmA = 16 + 4 * (sb / 3) + (sb % 3), pn = c >> 7, ch = c & 127;
        const float* hA = HG + ((size_t)(pmA * (DFF / 128) + pn) * 4) * 256 + ch; const float* hB = hA + (size_t)(DFF / 128) * 4 * 256;
        const float wg0 = cw[c], wg1 = cw[UPN + c], wg2 = cw[2 * UPN + c], wv0 = cw[DFF + c], wv1 = cw[UPN + DFF + c], wv2 = cw[2 * UPN + DFF + c], bg = cb[c], bv = cb[DFF + c];
        const float gA254 = hA[2 * 256], gA255 = hA[3 * 256], gB0 = hB[0], gB1 = hB[256], vA254 = hA[2 * 256 + 128], vA255 = hA[3 * 256 + 128], vB0 = hB[128], vB1 = hB[256 + 128];
        { const float g = wg0 * gA254 + wg1 * gA255 + wg2 * gB0 + bg, v = wv0 * vA254 + wv1 * vA255 + wv2 * vB0 + bv; WSP(bf16, WS_ACT)[(size_t)(256 * pmA + 255) * DFF + c] = f2bf(g * sigmoidf_(g) * v); }
        { const float g = wg0 * gA255 + wg1 * gB0 + wg2 * gB1 + bg, v = wv0 * vA255 + wv1 * vB0 + wv2 * vB1 + bv; WSP(bf16, WS_ACT)[(size_t)(256 * pmA + 256) * DFF + c] = f2bf(g * sigmoidf_(g) * v); } }
}

constexpr int SC_STEP = 448, SC_BUF = 32 * SC_STEP;
__device__ __forceinline__ void scan_unit(Frame& F, int l, int s, int h, int d) {
    const int tid = F.tid, lane = F.lane, wv = F.wave;
    const int T = s < 16 ? 256 : 1024, row0 = s < 16 ? 256 * s : NCTX + 1024 * (s - 16), NCH = T / 32;
    LAS float* SV = (LAS float*)F.lds;
    LAS float* YS = (LAS float*)(F.lds + 2 * SC_BUF * 4);
    const int rp = lane >> 4, kq = lane & 15, rowA = 8 * wv + 2 * rp;
    f32x2 ST[4];
    if (s >= 16) { const float* sp = F.in[I_ST] + ((((size_t)(s - 16) * DEPTH + l) * 2 + d) * 8 + h) * 4096 + rowA * 64 + 4 * kq; const f32x4 a = *(const f32x4*)sp, b = *(const f32x4*)(sp + 64);
#pragma unroll
        for (int k = 0; k < 4; ++k) ST[k] = (f32x2){a[k], b[k]}; }
    else {
#pragma unroll
        for (int k = 0; k < 4; ++k) ST[k] = (f32x2){0.f, 0.f}; }
    const int si = tid >> 4, sj = tid & 15, sn = sj * 4, cbase = 64 * h + sn;
    const f32x4 w0v = *(const f32x4*)(F.in[I_RW0] + ((size_t)l * 2 + d) * 512 + cbase), a0v = *(const f32x4*)(F.in[I_RA0] + ((size_t)l * 2 + d) * 512 + cbase);
    const f32x4 kkv = *(const f32x4*)(F.in[I_RKK] + (size_t)l * 512 + cbase), kav = *(const f32x4*)(F.in[I_RKA] + (size_t)l * 512 + cbase), rkv = *(const f32x4*)(F.in[I_RRK] + (size_t)l * 512 + cbase);
    float* Yout = WSP(float, d == 0 ? WS_YF : WS_YB); float* BON = WSP(float, WS_BON) + (size_t)d * NTOK * 8;
    const float* RC = WSP(float, WS_RC); const float* KC = WSP(float, WS_KC); const float* VC = WSP(float, WS_VC); const float* NK = WSP(float, WS_NK); const bf16* LORA = WSP(bf16, WS_LORA);
    f32x4 gr, gk, gv, gwp, gap; float gnk;
#define SCAN_ROW(c) (row0 + (d == 0 ? 32 * (c) + si : T - 1 - (32 * (c) + si)))
#define SCAN_LOADG(c) do { const size_t row_ = (size_t)SCAN_ROW(c); gr = *(const f32x4*)(RC + row_ * 512 + cbase); gk = *(const f32x4*)(KC + row_ * 512 + cbase); gv = *(const f32x4*)(VC + row_ * 512 + cbase); \
        { const s16x4 a_ = *(const s16x4*)(LORA + row_ * LORAN + d * 512 + cbase), b_ = *(const s16x4*)(LORA + row_ * LORAN + 1024 + d * 512 + cbase); \
          gwp = (f32x4){bf2f(a_[0]), bf2f(a_[1]), bf2f(a_[2]), bf2f(a_[3])}; gap = (f32x4){bf2f(b_[0]), bf2f(b_[1]), bf2f(b_[2]), bf2f(b_[3])}; } gnk = NK[row_ * 8 + h]; } while (0)
#define SCAN_WRITES(buf, c) do { const f32x4 kh_ = gk * kkv * gnk; f32x4 w_, a_; \
        _Pragma("unroll") for (int e = 0; e < 4; ++e) { w_[e] = __expf(-DECAY_SCALE * sigmoidf_(w0v[e] + gwp[e])); a_[e] = sigmoidf_(a0v[e] + gap[e]); } \
        const f32x4 b_ = a_ * kh_, kt_ = gk * ((a_ - 1.0f) * kav + 1.0f); const f32x4 bb_ = gr * rkv * kt_, br4_ = b_ * gr, kr4_ = kt_ * gr; \
        const float bon_ = allred16((bb_.x + bb_.y) + (bb_.z + bb_.w)), br_ = allred16((br4_.x + br4_.y) + (br4_.z + br4_.w)), ktr_ = allred16((kr4_.x + kr4_.y) + (kr4_.z + kr4_.w)); \
        if (sj == 0) BON[(size_t)SCAN_ROW(c) * 8 + h] = bon_; \
        LAS float* p_ = SV + (buf) * SC_BUF + si * SC_STEP; *(LAS f32x4*)(p_ + sn) = w_; *(LAS f32x4*)(p_ + 64 + sn) = kh_; *(LAS f32x4*)(p_ + 128 + sn) = b_; *(LAS f32x4*)(p_ + 192 + sn) = kt_; \
        *(LAS f32x4*)(p_ + 256 + sn) = gr; *(LAS f32x4*)(p_ + 320 + 8 * sj) = (f32x4){gv.x, gv.y, br_, ktr_}; *(LAS f32x4*)(p_ + 324 + 8 * sj) = (f32x4){gv.z, gv.w, br_, ktr_}; } while (0)
    SCAN_LOADG(0); SCAN_WRITES(0, 0); __syncthreads();
    const int vo = 4 * kq, ao = 320 + 4 * (4 * wv + rp);
    for (int c = 0; c < NCH; ++c) {
        if (c + 1 < NCH) SCAN_LOADG(c + 1);
        const LAS float* sv = SV + (c & 1) * SC_BUF; LAS float* ys = YS + (c & 1) * 2048;
        f32x4 w4 = *(const LAS f32x4*)(sv + vo), kh4 = *(const LAS f32x4*)(sv + 64 + vo), b4 = *(const LAS f32x4*)(sv + 128 + vo), kt4 = *(const LAS f32x4*)(sv + 192 + vo), r4 = *(const LAS f32x4*)(sv + 256 + vo), ax = *(const LAS f32x4*)(sv + ao);
#pragma unroll 4
        for (int i = 0; i < 32; ++i) {
            const LAS float* pn = sv + ((i + 1) & 31) * SC_STEP;
            const f32x4 nw = *(const LAS f32x4*)(pn + vo), nkh = *(const LAS f32x4*)(pn + 64 + vo), nb = *(const LAS f32x4*)(pn + 128 + vo), nkt = *(const LAS f32x4*)(pn + 192 + vo), nr = *(const LAS f32x4*)(pn + 256 + vo), nax = *(const LAS f32x4*)(pn + ao);
            f32x2 SW[4];
#pragma unroll
            for (int k = 0; k < 4; ++k) SW[k] = ST[k] * w4[k];
            f32x2 P = ST[0] * kh4[0], A = SW[0] * r4[0];
#pragma unroll
            for (int k = 1; k < 4; ++k) { P += ST[k] * kh4[k]; A += SW[k] * r4[k]; }
            float p0 = P.x, p1 = P.y, q0 = A.x, q1 = A.y;
            p0 += dpp_mov<0xB1>(p0); p1 += dpp_mov<0xB1>(p1); q0 += dpp_mov<0xB1>(q0); q1 += dpp_mov<0xB1>(q1);
            p0 += dpp_mov<0x4E>(p0); p1 += dpp_mov<0x4E>(p1); q0 += dpp_mov<0x4E>(q0); q1 += dpp_mov<0x4E>(q1);
            p0 += dpp_mov<0x141>(p0); p1 += dpp_mov<0x141>(p1); q0 += dpp_mov<0x141>(q0); q1 += dpp_mov<0x141>(q1);
            p0 += dpp_mov<0x140>(p0); p1 += dpp_mov<0x140>(p1); q0 += dpp_mov<0x140>(q0); q1 += dpp_mov<0x140>(q1);
            const f32x2 SK = {p0, p1}, V2 = {ax.x, ax.y};
            const f32x2 Y = (f32x2){q0, q1} - SK * ax.z + V2 * ax.w;
#pragma unroll
            for (int k = 0; k < 4; ++k) ST[k] = SW[k] - SK * b4[k] + V2 * kt4[k];
            if (kq == 0) *(LAS f32x2*)(ys + i * 64 + rowA) = Y;
            w4 = nw; kh4 = nkh; b4 = nb; kt4 = nkt; r4 = nr; ax = nax;
        }
        if (c + 1 < NCH) SCAN_WRITES((c + 1) & 1, c + 1);
        __syncthreads();
        *(f32x4*)(Yout + (size_t)SCAN_ROW(c) * 512 + cbase) = *(const LAS f32x4*)(ys + si * 64 + sn);
    }
    if (s < 16) { float* op = F.out + OUT_ST + ((((size_t)s * DEPTH + l) * 2 + d) * 8 + h) * 4096 + rowA * 64 + 4 * kq;
        *(f32x4*)op = (f32x4){ST[0].x, ST[1].x, ST[2].x, ST[3].x}; *(f32x4*)(op + 64) = (f32x4){ST[0].y, ST[1].y, ST[2].y, ST[3].y}; }
#undef SCAN_ROW
#undef SCAN_LOADG
#undef SCAN_WRITES
}

constexpr float ATT_SCALE = 0.07216878364870322f;
constexpr float ATT_THR = 8.f;
#define KSWZ(row, colB) ((row) * 256 + ((colB) ^ (((row) & 7) << 4)))
__device__ __forceinline__ int crow(int r, int hi) { return (r & 3) + 8 * (r >> 2) + 4 * hi; }
__device__ __forceinline__ void partialSM(f32x16& p0, f32x16& p1, float& m_reg, float& mn, float& alpha) {
    constexpr float C = ATT_SCALE * 1.4426950408889634f;
    float pmax = p0[0];
#pragma unroll
    for (int r = 1; r < 16; ++r) pmax = fmaxf(pmax, p0[r]);
#pragma unroll
    for (int r = 0; r < 16; ++r) pmax = fmaxf(pmax, p1[r]);
    { auto rr = __builtin_amdgcn_permlane32_swap(__float_as_uint(pmax), __float_as_uint(pmax), false, false); pmax = fmaxf(__uint_as_float(rr[0]), __uint_as_float(rr[1])); }
    if (__builtin_expect(__all(pmax - m_reg <= ATT_THR / ATT_SCALE), 1)) { mn = m_reg; alpha = 1.f; }
    else { mn = fmaxf(m_reg, pmax); alpha = __builtin_amdgcn_exp2f((m_reg - mn) * C); m_reg = mn; }
    const float mnC = -mn * C;
#pragma unroll
    for (int r = 0; r < 16; ++r) p0[r] = __builtin_amdgcn_exp2f(fmaf(p0[r], C, mnC));
#pragma unroll
    for (int r = 0; r < 16; ++r) p1[r] = __builtin_amdgcn_exp2f(fmaf(p1[r], C, mnC));
}
__device__ __forceinline__ void finishSM(f32x16& p0, f32x16& p1, float alpha, float& l_reg, bf16x8& pa0, bf16x8& pa1, bf16x8& pa2, bf16x8& pa3) {
    float ps = 0;
#pragma unroll
    for (int r = 0; r < 16; ++r) ps += p0[r];
#pragma unroll
    for (int r = 0; r < 16; ++r) ps += p1[r];
    { auto rr = __builtin_amdgcn_permlane32_swap(__float_as_uint(ps), __float_as_uint(ps), false, false); ps = __uint_as_float(rr[0]) + __uint_as_float(rr[1]); }
    l_reg = l_reg * alpha + ps;
#define PK4(P, BASE, OUT) do { unsigned a0 = cvtpk(P[BASE + 0], P[BASE + 1]), a1 = cvtpk(P[BASE + 2], P[BASE + 3]);   \
    unsigned b0 = cvtpk(P[BASE + 4], P[BASE + 5]), b1 = cvtpk(P[BASE + 6], P[BASE + 7]);                              \
    auto r0 = __builtin_amdgcn_permlane32_swap(a0, b0, false, false); auto r1 = __builtin_amdgcn_permlane32_swap(a1, b1, false, false); \
    v4u w = {r0[0], r1[0], r0[1], r1[1]}; OUT = *reinterpret_cast<bf16x8*>(&w); } while (0)
    PK4(p0, 0, pa0); PK4(p0, 8, pa1); PK4(p1, 0, pa2); PK4(p1, 8, pa3);
#undef PK4
}
__device__ __forceinline__ int v_st(int k, int c) { const int kk = (k & ~0xC) | ((k & 4) << 1) | ((k & 8) >> 1); return ((kk >> 3) * 4 + (c >> 5)) * 512 + ((kk & 7) * 32 + (c & 31)) * 2; }
__device__ __forceinline__ int v_rd_base(int lane) { return ((lane & 3) << 3) | (((lane >> 2) & 3) << 6) | (((lane >> 4) & 1) << 5) | (((lane >> 5) & 1) << 8); }
constexpr int v_rd_off(int d0, int ks, int half) { return d0 * 512 + ks * 4096 + half * 2048; }
template <int OFF> __device__ __forceinline__ s16x4 tr_read(int vb) { s16x4 r; asm volatile("ds_read_b64_tr_b16 %0, %1 offset:%2" : "=&v"(r) : "v"(vb), "i"(OFF) : "memory"); return r; }
template <int D0> __device__ __forceinline__ void pv_one(f32x16& od, int vb, bf16x8 pa0, bf16x8 pa1, bf16x8 pa2, bf16x8 pa3) {
    const s16x4 l0 = tr_read<v_rd_off(D0, 0, 0)>(vb), h0 = tr_read<v_rd_off(D0, 0, 1)>(vb), l1 = tr_read<v_rd_off(D0, 1, 0)>(vb), h1 = tr_read<v_rd_off(D0, 1, 1)>(vb);
    const s16x4 l2 = tr_read<v_rd_off(D0, 2, 0)>(vb), h2 = tr_read<v_rd_off(D0, 2, 1)>(vb), l3 = tr_read<v_rd_off(D0, 3, 0)>(vb), h3 = tr_read<v_rd_off(D0, 3, 1)>(vb);
    asm volatile("s_waitcnt lgkmcnt(0)" ::: "memory"); SBAR();
#define PK(L, H) (bf16x8){L[0], L[1], L[2], L[3], H[0], H[1], H[2], H[3]}
    od = __builtin_amdgcn_mfma_f32_32x32x16_bf16(pa0, PK(l0, h0), od, 0, 0, 0);
    od = __builtin_amdgcn_mfma_f32_32x32x16_bf16(pa1, PK(l1, h1), od, 0, 0, 0);
    od = __builtin_amdgcn_mfma_f32_32x32x16_bf16(pa2, PK(l2, h2), od, 0, 0, 0);
    od = __builtin_amdgcn_mfma_f32_32x32x16_bf16(pa3, PK(l3, h3), od, 0, 0, 0);
#undef PK
}
__device__ __forceinline__ void pv_d0(f32x16* o, int vb, bf16x8 pa0, bf16x8 pa1, bf16x8 pa2, bf16x8 pa3) {
    pv_one<0>(o[0], vb, pa0, pa1, pa2, pa3); pv_one<1>(o[1], vb, pa0, pa1, pa2, pa3); pv_one<2>(o[2], vb, pa0, pa1, pa2, pa3); pv_one<3>(o[3], vb, pa0, pa1, pa2, pa3);
}
__device__ __forceinline__ bf16x8 pack8(const float* x) { v4u w = {cvtpk(x[0], x[1]), cvtpk(x[2], x[3]), cvtpk(x[4], x[5]), cvtpk(x[6], x[7])}; return *reinterpret_cast<bf16x8*>(&w); }

#define GLDS16(gp, lp) __builtin_amdgcn_global_load_lds((const unsigned*)(gp), (LAS unsigned*)(lp), 16, 0, 0)
constexpr int AT_BUF = 40960;
__device__ __forceinline__ void attn_unit(Frame& F, int s, int h, int qb) {
    const int wid = F.wave, lane = F.lane, r32 = lane & 31, hi = lane >> 5;
    const int grow0 = (s < 16 ? 256 * s : NCTX + 1024 * (s - 16)) + 256 * qb;
    const int kvr0 = s < 16 ? 256 * s : NCTX + 1280 * (s - 16), NT = s < 16 ? 4 : 20;
    LAS char* L0 = (LAS char*)F.lds;
    LAS float* wsx = (LAS float*)(L0 + 2 * AT_BUF) + wid * 64; LAS float* li_l = wsx; LAS float* al_l = wsx + 32;
    bf16x8 qr[12];
    { const bf16* Qw = WSP(bf16, WS_Q) + (size_t)(grow0 + wid * 32 + r32) * QW + h * 192 + hi * 8;
#pragma unroll
      for (int d0 = 0; d0 < 12; ++d0) qr[d0] = *(const bf16x8*)(Qw + d0 * 16); }
    if (s >= 16) {
        const int t = 256 * qb + wid * 32 + r32; const float* ct = WSP(float, WS_ROPE) + t * 32; const float* stb = ct + 1024 * 32;
#pragma unroll
        for (int pr = 0; pr < 2; ++pr) { const int ib = 16 * pr + 8 * hi; float n1[8], n2[8];
#pragma unroll
            for (int j = 0; j < 8; ++j) { const float c = ct[ib + j], sn = stb[ib + j], x1 = bf2f(qr[8 + pr][j]), x2 = bf2f(qr[10 + pr][j]); n1[j] = x1 * c - x2 * sn; n2[j] = x1 * sn + x2 * c; }
            qr[8 + pr] = pack8(n1); qr[10 + pr] = pack8(n2); }
    }
    const bf16* KVb = WSP(bf16, WS_KV) + (size_t)kvr0 * 2048 + h * 256; const bf16* KRb = WSP(bf16, WS_KR) + (size_t)kvr0 * 64;
    int okn[2], ov[2], okr;
#pragma unroll
    for (int j = 0; j < 2; ++j) { const int p = 2 * wid + j;
        { const int row = 4 * p + (lane >> 4), ch = (lane & 15) ^ (row & 7); okn[j] = row * 2048 + 8 * ch; }
        { const int st = 2 * p + (lane >> 5), kk = 8 * (st >> 2) + ((lane & 31) >> 2), k = (kk & ~0xC) | ((kk & 4) << 1) | ((kk & 8) >> 1), col = 32 * (st & 3) + 8 * (lane & 3); ov[j] = k * 2048 + 128 + col; } }
    { const int row = 8 * wid + (lane >> 3), ch = (lane & 7) ^ ((row >> 1) & 7); okr = row * 64 + 8 * ch; }
#define AT_ISSUE(kt, b) do { LAS char* B_ = L0 + (b) * AT_BUF; const bf16* kv_ = KVb + (size_t)(kt) * (64 * 2048); \
        GLDS16(kv_ + ov[0], B_ + (2 * wid) * 1024); GLDS16(kv_ + ov[1], B_ + (2 * wid + 1) * 1024); \
        GLDS16(kv_ + okn[0], B_ + 16384 + (2 * wid) * 1024); GLDS16(kv_ + okn[1], B_ + 16384 + (2 * wid + 1) * 1024); \
        GLDS16(KRb + (size_t)(kt) * (64 * 64) + okr, B_ + 32768 + wid * 1024); } while (0)
    const int vb0 = (int)(unsigned)(size_t)L0 + v_rd_base(lane);
    float m_reg = -1e30f, l_reg = 0.f; f32x16 o[4];
#pragma unroll
    for (int d = 0; d < 4; ++d)
#pragma unroll
        for (int r = 0; r < 16; ++r) o[d][r] = 0.f;
    AT_ISSUE(0, 0);
    for (int kt = 0; kt < NT; ++kt) {
        VM_WAIT(); __syncthreads();
        if (kt + 1 < NT) AT_ISSUE(kt + 1, (kt + 1) & 1);
        const LAS char* Kn_lds = L0 + (kt & 1) * AT_BUF + 16384; const LAS char* Kr_lds = L0 + (kt & 1) * AT_BUF + 32768;
        f32x16 p0, p1;
#pragma unroll
        for (int r = 0; r < 16; ++r) { p0[r] = 0.f; p1[r] = 0.f; }
#pragma unroll
        for (int d0 = 0; d0 < 8; ++d0) { const int cb = (d0 * 16 + hi * 8) * 2;
            const bf16x8 b0 = *(const LAS bf16x8*)(Kn_lds + KSWZ(r32, cb)), b1 = *(const LAS bf16x8*)(Kn_lds + KSWZ(32 + r32, cb));
            p0 = __builtin_amdgcn_mfma_f32_32x32x16_bf16(b0, qr[d0], p0, 0, 0, 0); p1 = __builtin_amdgcn_mfma_f32_32x32x16_bf16(b1, qr[d0], p1, 0, 0, 0);
            if ((d0 & 3) == 3) SBAR(); }
#pragma unroll
        for (int d0 = 0; d0 < 4; ++d0) { const int ko = r32 * 128 + (((2 * d0 + hi) ^ ((r32 >> 1) & 7)) << 4);
            const bf16x8 b0 = *(const LAS bf16x8*)(Kr_lds + ko), b1 = *(const LAS bf16x8*)(Kr_lds + 32 * 128 + ko);
            p0 = __builtin_amdgcn_mfma_f32_32x32x16_bf16(b0, qr[8 + d0], p0, 0, 0, 0); p1 = __builtin_amdgcn_mfma_f32_32x32x16_bf16(b1, qr[8 + d0], p1, 0, 0, 0); }
        SBAR();
        float mn, alpha; bf16x8 pa0, pa1, pa2, pa3;
        partialSM(p0, p1, m_reg, mn, alpha);
        if (__any(alpha < 1.f)) { if (hi == 0) al_l[r32] = alpha; LDS_WAIT();
#pragma unroll
            for (int d = 0; d < 4; ++d)
#pragma unroll
                for (int r = 0; r < 16; ++r) o[d][r] *= al_l[crow(r, hi)]; }
        finishSM(p0, p1, alpha, l_reg, pa0, pa1, pa2, pa3); SBAR();
        pv_d0(o, vb0 + (kt & 1) * AT_BUF, pa0, pa1, pa2, pa3);
    }
    if (hi == 0) li_l[r32] = l_reg; LDS_WAIT();
    bf16* Ow = WSP(bf16, WS_MIX) + (size_t)(grow0 + wid * 32) * DM + h * 128 + r32;
#pragma unroll
    for (int r = 0; r < 16; ++r) { const int orow = crow(r, hi); const float rl = __builtin_amdgcn_rcpf(li_l[orow]);
#pragma unroll
        for (int d0 = 0; d0 < 4; ++d0) Ow[(size_t)orow * DM + d0 * 32] = f2bf(o[d0][r] * rl); }
#undef AT_ISSUE
}

__device__ __forceinline__ void four_unit(Frame& F, int s, int g, int ob) {
    const int wid = F.wave, lane = F.lane, r32 = lane & 31, hi = lane >> 5;
    const int T = s < 16 ? 256 : 1024, row0 = s < 16 ? 256 * s : NCTX + 1024 * (s - 16), NTH = T / 64, NT = 2 * NTH, ldp = 2 * T;
    LAS char* L0 = (LAS char*)F.lds;
    const bf16* Pw = (s < 16 ? WSP(bf16, WS_P256) : WSP(bf16, WS_P1024)) + (size_t)(256 * ob + wid * 32 + r32) * ldp + hi * 8;
    const bf16* Y = WSP(bf16, WS_Y) + (size_t)row0 * 1024 + g * 256;
    int ov[2];
#pragma unroll
    for (int j = 0; j < 2; ++j) { const int p = 2 * wid + j, st = 2 * p + (lane >> 5), kk = 8 * (st >> 2) + ((lane & 31) >> 2), k = (kk & ~0xC) | ((kk & 4) << 1) | ((kk & 8) >> 1), col = 32 * (st & 3) + 8 * (lane & 3); ov[j] = k * 1024 + col; }
    const int vb0 = (int)(unsigned)(size_t)L0 + v_rd_base(lane);
    bf16x8 na0, na1, na2, na3;
#define FO_ISSUE(kt, b) do { const int part_ = (kt) >= NTH ? 1 : 0; const bf16* yp_ = Y + (size_t)(64 * ((kt) - part_ * NTH)) * 1024 + part_ * 128; \
        GLDS16(yp_ + ov[0], L0 + (b) * 16384 + (2 * wid) * 1024); GLDS16(yp_ + ov[1], L0 + (b) * 16384 + (2 * wid + 1) * 1024); } while (0)
#define FO_LOADP(kt) do { na0 = *(const bf16x8*)(Pw + 64 * (kt)); na1 = *(const bf16x8*)(Pw + 64 * (kt) + 16); na2 = *(const bf16x8*)(Pw + 64 * (kt) + 32); na3 = *(const bf16x8*)(Pw + 64 * (kt) + 48); } while (0)
    f32x16 o[4];
#pragma unroll
    for (int d = 0; d < 4; ++d)
#pragma unroll
        for (int r = 0; r < 16; ++r) o[d][r] = 0.f;
    FO_ISSUE(0, 0); FO_LOADP(0);
    for (int kt = 0; kt < NT; ++kt) {
        VM_WAIT(); __syncthreads();
        const bf16x8 pa0 = na0, pa1 = na1, pa2 = na2, pa3 = na3;
        if (kt + 1 < NT) { FO_ISSUE(kt + 1, (kt + 1) & 1); FO_LOADP(kt + 1); }
        pv_d0(o, vb0 + (kt & 1) * 16384, pa0, pa1, pa2, pa3);
    }
    bf16* Ow = WSP(bf16, WS_MIX) + (size_t)(row0 + 256 * ob + wid * 32) * DM + 1024 + g * 128 + r32;
#pragma unroll
    for (int r = 0; r < 16; ++r) { const int orow = crow(r, hi);
#pragma unroll
        for (int d0 = 0; d0 < 4; ++d0) Ow[(size_t)orow * DM + d0 * 32] = f2bf(o[d0][r]); }
#undef FO_ISSUE
#undef FO_LOADP
}

constexpr int NUNITS = 704, CV_PER_UNIT = 64, NCVU = (I_LAYER + CV_PER_UNIT - 1) / CV_PER_UNIT, NMODU = 96;
__device__ __forceinline__ void mixer_phase(Frame& F, int lq) {
    const int l = lq & 3; gu32* ctr = F.ctl + CW_QUEUE + 64 * lq;
    const int ntot = (l < DEPTH - 1 && lq < 4) ? NUNITS + NCVU + NMODU : NUNITS;
    for (;;) {
        __syncthreads();
        if (F.tid == 0) F.MISC[0] = __hip_atomic_fetch_add(ctr, 1u, RLX_AGENT);
        __syncthreads();
        const int u = (int)F.MISC[0];
        if (u >= ntot) break;
        { int t_ = threadIdx.x; asm volatile("" : "+v"(t_)); F.tid = t_; F.lane = t_ & 63; F.wave = __builtin_amdgcn_readfirstlane(t_ >> 6); }
        if (u >= NUNITS) {
            if (u < NUNITS + NCVU) { LAS float* scr = (LAS float*)(F.lds + RING_OFF + F.wave * 16384); const int base = (u - NUNITS) * CV_PER_UNIT + F.wave * (CV_PER_UNIT / NWAVES);
                for (int i = 0; i < CV_PER_UNIT / NWAVES; ++i) if (base + i < I_LAYER) convert_wave_item(F, l + 1, base + i, scr); }
            else mod_block_item(F, l + 1, u - NUNITS - NCVU);
            continue;
        }
        int ty, a, b, c;
        if (u < 64) { ty = 0; a = 16 + (u >> 4); b = (u & 15) >> 1; c = u & 1; }
        else if (u < 192) { const int i = u - 64; ty = 1; a = 16 + (i >> 5); b = (i >> 2) & 7; c = i & 3; }
        else if (u < 256) { const int i = u - 192; ty = 2; a = 16 + (i >> 4); b = (i >> 2) & 3; c = i & 3; }
        else if (u < 512) { const int i = u - 256; ty = 0; a = i >> 4; b = (i & 15) >> 1; c = i & 1; }
        else if (u < 640) { const int i = u - 512; ty = 1; a = i >> 3; b = i & 7; c = 0; }
        else { const int i = u - 640; ty = 2; a = i >> 2; b = i & 3; c = 0; }
        if (ty == 0) scan_unit(F, l, a, b, c); else if (ty == 1) attn_unit(F, a, b, c); else four_unit(F, a, b, c);
    }
}

#ifndef MK_MODE
#define MK_MODE 1
#endif
struct Args { const float* in[NIN]; float* out; unsigned char* ws; int ph_lo, ph_hi, li, pad; };
__global__ void __launch_bounds__(NWAVES * 64, 2) mk_fwd(Args args) {
    extern __shared__ __attribute__((aligned(16))) unsigned char lds_raw[];
    Frame F;
    F.lds = (LAS unsigned char*)lds_raw;
    F.MISC = (volatile LAS unsigned*)(F.lds + MISC_OFF);
    F.tid = threadIdx.x; F.lane = F.tid & 63; F.wave = __builtin_amdgcn_readfirstlane(F.tid >> 6);
    F.G = gridDim.x; { const int bx = blockIdx.x; F.vcu = (F.G % 8 == 0) ? (bx % 8) * (F.G / 8) + bx / 8 : bx; }
    F.in = args.in; F.out = args.out; F.ws = args.ws; F.ctl = (gu32*)(args.ws + WS_CTL);
    for (int u = F.tid; u < (LDS_BYTES - LDSCTL_OFF) / 4; u += NWAVES * 64) ((LAS unsigned*)(F.lds + LDSCTL_OFF))[u] = 0u;
    __syncthreads();
    const int lo = args.ph_lo, hi = args.ph_hi;
    XcdBarrier bar; bar.bar = (unsigned*)(F.ctl + CW_BAR) + args.li * XCD_BAR_WORDS; bar.x = 0; bar.st = nullptr;
    if (hi - lo > 1) bar = xcd_barrier_post((unsigned*)(F.ctl + CW_BAR) + args.li * XCD_BAR_WORDS, F.MISC + 8);
#ifdef ONLY
#define KIND_ON(x) ((x) == ONLY)
#else
#define KIND_ON(x) true
#endif
#define IN(k) (lo <= (k) && (k) < hi)
#ifndef REPMASK
#define REPMASK 0
#endif
#define NREP(kind) (1 + ((REPMASK >> (kind)) & 1))
#define RELANE() do { int t_ = threadIdx.x; asm volatile("" : "+v"(t_)); F.tid = t_; F.lane = t_ & 63; F.wave = __builtin_amdgcn_readfirstlane(t_ >> 6); } while (0)
#define SEAM(k) do { if (IN(k) && IN((k) + 1)) xcd_barrier(bar); } while (0)
    const int cb = (int)blockIdx.x;

    if (KIND_ON(0) && IN(0)) { for (int rep = 0; rep < NREP(0); ++rep) { RELANE(); p0_prologue(F); } SEAM(0); }
    if (KIND_ON(1) && IN(1)) { for (int rep = 0; rep < NREP(1); ++rep) { RELANE(); norm_phase<0>(F, 0); } SEAM(1); }
    for (int l = 0; l < DEPTH; ++l) {
        const int pb = 2 + 11 * l;
        if (KIND_ON(2) && IN(pb + 0)) {
            for (int rep = 0; rep < NREP(2); ++rep) {
            pg8::Gemm g{WSP(bf16, WS_H), WSP(bf16, WS_WIN) + (size_t)l * INP * DM, NTOK, INP, DM, DM}; pg8::StaticOrder S; S.init(NTOK, INP, F.G, cb);
            pg8::EpiAny E{(void*)WSP(bf16, WS_PROJ), INP, 0};
            pg8::gemm_phase<pg8::EpiAny, pg8::StaticOrder, true, true>(F.lds + RING_OFF, g, S, E); }
            SEAM(pb + 0);
        }
        if (KIND_ON(3) && IN(pb + 1)) { for (int rep = 0; rep < NREP(3); ++rep) { RELANE(); prep_phase(F, l); } SEAM(pb + 1); }
        if (KIND_ON(4) && IN(pb + 2)) {
            for (int gi = 0; gi < 4 * NREP(4); ++gi) {
                const bf16* A_; const bf16* B_; void* O_; int M_, N_, K_, f_, rot_, lda_;
                if ((gi & 3) == 0) { A_ = WSP(bf16, WS_QN); B_ = WSP(bf16, WS_WUQ) + (size_t)l * QW * 512; O_ = WSP(bf16, WS_Q); M_ = NTOK; N_ = QW; K_ = 512; f_ = 0; rot_ = 0; lda_ = 512; }
                else if ((gi & 3) == 1) { A_ = WSP(bf16, WS_PROJ) + OFF_XF; B_ = WSP(bf16, WS_MBD); O_ = WSP(bf16, WS_Y); M_ = NTOK; N_ = 1024; K_ = 512; f_ = 0; rot_ = 192; lda_ = INP; }
                else if ((gi & 3) == 2) { A_ = WSP(bf16, WS_CKVA); B_ = WSP(bf16, WS_WUKV) + (size_t)l * 2048 * 256; O_ = WSP(bf16, WS_KV); M_ = KVROWS; N_ = 2048; K_ = 256; f_ = 0; rot_ = 64; lda_ = 256; }
                else { A_ = WSP(bf16, WS_AL); B_ = WSP(bf16, WS_WL) + (size_t)l * LORAN * 256; O_ = WSP(bf16, WS_LORA); M_ = NTOK; N_ = LORAN; K_ = 256; f_ = 0; rot_ = 96; lda_ = 256; }
                pg8::Gemm g{A_, B_, M_, N_, K_, lda_}; pg8::StaticOrder S; S.init(M_, N_, F.G, (cb + F.G - rot_ % F.G) % F.G);
                pg8::EpiAny E{O_, N_, f_};
                pg8::gemm_phase<pg8::EpiAny, pg8::StaticOrder, true, true>(F.lds + RING_OFF, g, S, E);
            }
            SEAM(pb + 2);
        }
        if (KIND_ON(5) && IN(pb + 3)) { for (int rep = 0; rep < NREP(5); ++rep) { RELANE(); mixer_phase(F, l + 4 * rep); } SEAM(pb + 3); }
        if (KIND_ON(6) && IN(pb + 4)) { for (int rep = 0; rep < NREP(6); ++rep) { RELANE(); post_phase(F, l); } SEAM(pb + 4); }
        if (KIND_ON(7) && IN(pb + 5)) {
            for (int rep = 0; rep < NREP(7); ++rep) {
            pg8::Gemm g{WSP(bf16, WS_MIX), WSP(bf16, WS_WOUT) + (size_t)l * DM * DM, NTOK, DM, DM, DM}; pg8::StaticOrder S; S.init(NTOK, DM, F.G, cb);
            pg8::EpiAny E{(void*)WSP(float, WS_O), DM, 1};
            pg8::gemm_phase<pg8::EpiAny, pg8::StaticOrder, true, true>(F.lds + RING_OFF, g, S, E); }
            SEAM(pb + 5);
        }
        if (KIND_ON(8) && IN(pb + 6)) { RELANE(); norm_phase<1>(F, l); SEAM(pb + 6); }
        if (KIND_ON(9) && IN(pb + 7)) {
            for (int rep = 0; rep < NREP(9); ++rep) {
            pg8::Gemm g{WSP(bf16, WS_H), WSP(bf16, WS_WUP) + (size_t)l * UPN * DM, NTOK, UPN, DM, DM}; pg8::StaticOrder S; S.init(NTOK, UPN, F.G, cb);
            pg8::EpiFfnAct E{WSP(bf16, WS_ACT), DFF, DFF, UPN, F.in[I_FCONV] + (size_t)l * 3 * UPN, F.in[I_FCONVB] + (size_t)l * UPN, WSP(float, WS_HALO), F.lds + HALO_OFF};
            pg8::gemm_phase<pg8::EpiFfnAct, pg8::StaticOrder, true, true>(F.lds + RING_OFF, g, S, E); }
            SEAM(pb + 7);
        }
        if (KIND_ON(10) && IN(pb + 8)) { for (int rep = 0; rep < NREP(10); ++rep) { RELANE(); ffn_fix_phase(F, l); } SEAM(pb + 8); }
        if (KIND_ON(11) && IN(pb + 9)) {
            for (int rep = 0; rep < NREP(11); ++rep) {
            pg8::Gemm g{WSP(bf16, WS_ACT), WSP(bf16, WS_WDN) + (size_t)l * DM * DFF, NTOK, DM, DFF, DFF}; pg8::StaticOrder S; S.init(NTOK, DM, F.G, cb);
            pg8::EpiAny E{(void*)WSP(float, WS_O), DM, 1};
            pg8::gemm_phase<pg8::EpiAny, pg8::StaticOrder, true, true>(F.lds + RING_OFF, g, S, E); }
            SEAM(pb + 9);
        }
        if (KIND_ON(12) && IN(pb + 10)) { RELANE(); norm_phase<2>(F, l); SEAM(pb + 10); }
    }
#undef IN
#undef SEAM
}

extern "C" void kernel_launch(void* const* d_in, const int* in_sizes, int n_in, void* d_out, int out_size, void* d_ws, size_t ws_size, hipStream_t stream) {
    static int grid = 0;
    if (grid == 0) {
        if (n_in != NIN || (size_t)out_size != OUT_END || ws_size < WS_END) { fprintf(stderr, "kernel_launch: built for %d inputs, %zu outputs, >= %zu bytes of workspace; got n_in %d, out %d, ws %zu; nothing launched\n", NIN, (size_t)OUT_END, (size_t)WS_END, n_in, out_size, ws_size); grid = -1; return; }
        int dev = 0, cus = 0, per_cu = 0;
        if (hipGetDevice(&dev) != hipSuccess || hipDeviceGetAttribute(&cus, hipDeviceAttributeMultiprocessorCount, dev) != hipSuccess) { fprintf(stderr, "kernel_launch: device query failed\n"); grid = -1; return; }
        if (hipFuncSetAttribute((const void*)mk_fwd, hipFuncAttributeMaxDynamicSharedMemorySize, LDS_BYTES) != hipSuccess) { fprintf(stderr, "kernel_launch: hipFuncSetAttribute failed\n"); grid = -1; return; }
        if (hipOccupancyMaxActiveBlocksPerMultiprocessor(&per_cu, (const void*)mk_fwd, NWAVES * 64, LDS_BYTES) != hipSuccess || per_cu < 1)
            fprintf(stderr, "kernel_launch: note: occupancy query reports %d workgroups per CU\n", per_cu);
        (void)hipGetLastError();
        grid = cus;
    }
    if (grid < 0) return;
    if (hipMemsetAsync((char*)d_ws + WS_CTL, 0, CTL_BYTES, stream) != hipSuccess) { fprintf(stderr, "kernel_launch: memset failed\n"); return; }
    Args a{};
    for (int i = 0; i < NIN; ++i) a.in[i] = (const float*)d_in[i];
    a.out = (float*)d_out; a.ws = (unsigned char*)d_ws; a.pad = 0;
#if MK_MODE == 1
    const int nl = 1; const int cuts[2] = {0, NPHASES};
#else
    const int nl = NPHASES; int cuts[NPHASES + 1]; for (int i = 0; i <= NPHASES; ++i) cuts[i] = i;
#endif
    for (int li = 0; li < nl; ++li) {
        a.ph_lo = cuts[li]; a.ph_hi = cuts[li + 1]; a.li = li;
        hipLaunchKernelGGL(mk_fwd, dim3(grid), dim3(NWAVES * 64), LDS_BYTES, stream, a);
        const hipError_t le = hipPeekAtLastError();
        if (le != hipSuccess) { fprintf(stderr, "kernel_launch: launch %d failed: %s\n", li, hipGetErrorName(le)); break; }
    }
}
```

```cpp
#include <hip/hip_runtime.h>
#include <cstdio>
#include <cstdint>
namespace pg8 {
#define PG8_LAS __attribute__((address_space(3)))
typedef unsigned short bf16_t;
typedef short bf16x8 __attribute__((ext_vector_type(8)));
typedef float f32x4 __attribute__((ext_vector_type(4)));
typedef unsigned u32x4 __attribute__((ext_vector_type(4)));
constexpr int BM = 256, BK = 64, HALF = 128, HTB = HALF * BK * 2  , STAGE_BYTES = 8 * HTB, NXCD = 8, WGM = 8;

__host__ __device__ __forceinline__ int lds_byte(int r, int c) { const int st = (r >> 4) * 2 + (c >> 5), rr = r & 15, cc = c & 31, ob = rr * 64 + cc * 2; return st * 1024 + (ob ^ (((ob >> 9) & 1) << 5)); }
__host__ __device__ __forceinline__ void stage_rc(int b, int& R, int& C) { const int st = b / 1024, sb = b % 1024, swz = sb ^ (((sb >> 9) & 1) << 5); R = (st >> 1) * 16 + swz / 64; C = (st & 1) * 32 + (swz % 64) / 2; }
__host__ __device__ __forceinline__ int perm32(int rho) { const int n = rho >> 4, i = rho & 15; return 8 * (i >> 2) + 4 * n + (i & 3); }

struct Unit { int pm, pn; };
struct Gemm { const bf16_t* A; const bf16_t* Bt; int M, N, K, lda; };

struct StaticOrder {
    int nM, nN, nwg, G, c;
    __host__ __device__ void init(int M, int N, int G_, int c_) { nM = M / BM; nN = N / BM; nwg = nM * nN; G = G_; c = c_; }
    __host__ __device__ bool next(int i, Unit& u) const {
        const long L = (long)i * G + c; if (L >= nwg) return false;
        int wgid = (int)L; { const int q = nwg / NXCD, r = nwg % NXCD, xcd = wgid % NXCD, off = wgid / NXCD; wgid = (xcd < r ? xcd * (q + 1) : r * (q + 1) + (xcd - r) * q) + off; }
        const int nig = WGM * nN, gid = wgid / nig, fm = gid * WGM, gsz = (nM - fm) < WGM ? (nM - fm) : WGM;
        u.pm = fm + ((wgid % nig) % gsz); u.pn = (wgid % nig) / gsz; return true;
    }
    __device__ __forceinline__ void a_ready(const Unit&) const {}
    __device__ __forceinline__ void done(const Unit&) const {}
};

__device__ __forceinline__ unsigned cvt_pk_bf16(float lo, float hi) { unsigned r; asm volatile("v_cvt_pk_bf16_f32 %0, %1, %2" : "=v"(r) : "v"(lo), "v"(hi)); return r; }
typedef float f32x2 __attribute__((ext_vector_type(2)));
struct EpiF32 {
    static constexpr bool PERM = false, AFTER_DRAIN = false;
    float* C; int ldc; const float* bias;
    __device__ __forceinline__ void operator()(const f32x4 (&acc)[2][2][4][2], const Unit& u, int wr, int wc, int fr, int fq) const {
        const int row0 = u.pm * BM + wr * 64 + fr, col0 = u.pn * BM + wc * 32 + 4 * fq;
        f32x4 bv[2][2];
#pragma unroll
        for (int bj = 0; bj < 2; ++bj)
#pragma unroll
            for (int n = 0; n < 2; ++n) bv[bj][n] = bias ? *(const f32x4*)(bias + col0 + bj * HALF + n * 16) : (f32x4){0.f, 0.f, 0.f, 0.f};
#pragma unroll
        for (int ai = 0; ai < 2; ++ai)
#pragma unroll
            for (int m = 0; m < 4; ++m) { float* rowp = C + (size_t)(row0 + ai * HALF + m * 16) * ldc + col0;
#pragma unroll
                for (int bj = 0; bj < 2; ++bj)
#pragma unroll
                    for (int n = 0; n < 2; ++n) *(f32x4*)(rowp + bj * HALF + n * 16) = acc[ai][bj][m][n] + bv[bj][n]; }
    }
};
struct EpiAny {
    static constexpr bool PERM = true, AFTER_DRAIN = false;
    void* O; int ldc; int f32;
    __device__ __forceinline__ void operator()(const f32x4 (&acc)[2][2][4][2], const Unit& u, int wr, int wc, int fr, int fq) const {
        const int row0 = u.pm * BM + wr * 64 + fr, col0 = u.pn * BM + wc * 32 + 8 * fq;
        if (f32) {
#pragma unroll
            for (int ai = 0; ai < 2; ++ai)
#pragma unroll
                for (int m = 0; m < 4; ++m) { float* rowp = (float*)O + (size_t)(row0 + ai * HALF + m * 16) * ldc + col0;
#pragma unroll
                    for (int bj = 0; bj < 2; ++bj) { *(f32x4*)(rowp + bj * HALF) = acc[ai][bj][m][0]; *(f32x4*)(rowp + bj * HALF + 4) = acc[ai][bj][m][1]; } }
        } else {
#pragma unroll
            for (int ai = 0; ai < 2; ++ai)
#pragma unroll
                for (int m = 0; m < 4; ++m) { bf16_t* rowp = (bf16_t*)O + (size_t)(row0 + ai * HALF + m * 16) * ldc + col0;
#pragma unroll
                    for (int bj = 0; bj < 2; ++bj) { const f32x4 v0 = acc[ai][bj][m][0], v1 = acc[ai][bj][m][1];
                        u32x4 w; w.x = cvt_pk_bf16(v0[0], v0[1]); w.y = cvt_pk_bf16(v0[2], v0[3]); w.z = cvt_pk_bf16(v1[0], v1[1]); w.w = cvt_pk_bf16(v1[2], v1[3]);
                        *(u32x4*)(rowp + bj * HALF) = w; } }
        }
    }
};

template <int CTRL> __device__ __forceinline__ float dpp_keep(float old, float x) { return __builtin_bit_cast(float, __builtin_amdgcn_update_dpp(__builtin_bit_cast(int, old), __builtin_bit_cast(int, x), CTRL, 0xf, 0xf, false)); }
struct EpiFfnAct {
    static constexpr bool PERM = true, AFTER_DRAIN = false;
    bf16_t* ACT; int ldact, dff, upn; const float* cw; const float* cb; float* HG; PG8_LAS unsigned char* hl;
    __device__ __forceinline__ void operator()(const f32x4 (&acc)[2][2][4][2], const Unit& u, int wr, int wc, int fr, int fq) const {
        const int colh = wc * 32 + 8 * fq;
#pragma unroll
        for (int ai = 0; ai < 2; ++ai)
#pragma unroll
            for (int bj = 0; bj < 2; ++bj) { const int q = 2 * ai + wr;
                if (fr == 0) { const f32x4 v0 = acc[ai][bj][0][0], v1 = acc[ai][bj][0][1]; u32x4 w; w.x = cvt_pk_bf16(v0[0], v0[1]); w.y = cvt_pk_bf16(v0[2], v0[3]); w.z = cvt_pk_bf16(v1[0], v1[1]); w.w = cvt_pk_bf16(v1[2], v1[3]);
                    *(PG8_LAS u32x4*)(hl + ((q * 2 + 0) * 2 + bj) * 256 + colh * 2) = w; }
                if (fr == 15) { const f32x4 v0 = acc[ai][bj][3][0], v1 = acc[ai][bj][3][1]; u32x4 w; w.x = cvt_pk_bf16(v0[0], v0[1]); w.y = cvt_pk_bf16(v0[2], v0[3]); w.z = cvt_pk_bf16(v1[0], v1[1]); w.w = cvt_pk_bf16(v1[2], v1[3]);
                    *(PG8_LAS u32x4*)(hl + ((q * 2 + 1) * 2 + bj) * 256 + colh * 2) = w; } }
        { float* hg = HG + ((size_t)(u.pm * (dff / 128) + u.pn) * 4) * 256 + colh;
          if (wr == 0 && fr < 2) {
#pragma unroll
              for (int bj = 0; bj < 2; ++bj) { *(f32x4*)(hg + fr * 256 + bj * 128) = acc[0][bj][0][0]; *(f32x4*)(hg + fr * 256 + bj * 128 + 4) = acc[0][bj][0][1]; } }
          if (wr == 1 && fr >= 14) {
#pragma unroll
              for (int bj = 0; bj < 2; ++bj) { *(f32x4*)(hg + (fr - 12) * 256 + bj * 128) = acc[1][bj][3][0]; *(f32x4*)(hg + (fr - 12) * 256 + bj * 128 + 4) = acc[1][bj][3][1]; } } }
        asm volatile("s_waitcnt lgkmcnt(0)" ::: "memory"); __builtin_amdgcn_s_barrier(); asm volatile("" ::: "memory");
        const int cg0 = u.pn * 128 + colh;
        unsigned pk[2][2][4][2];
#pragma unroll
        for (int n = 0; n < 2; ++n) {
            f32x4 wg[3], wv[3];
#pragma unroll
            for (int j = 0; j < 3; ++j) { wg[j] = *(const f32x4*)(cw + (size_t)j * upn + cg0 + 4 * n); wv[j] = *(const f32x4*)(cw + (size_t)j * upn + dff + cg0 + 4 * n); }
            const f32x4 bg = *(const f32x4*)(cb + cg0 + 4 * n), bv = *(const f32x4*)(cb + dff + cg0 + 4 * n);
#pragma unroll
            for (int ai = 0; ai < 2; ++ai) { const int q = 2 * ai + wr;
                f32x4 hp[2], hn[2];
#pragma unroll
                for (int bj = 0; bj < 2; ++bj) {
                    unsigned a0 = 0u, a1 = 0u, b0 = 0u, b1 = 0u;
                    if (q > 0) { const PG8_LAS unsigned* p = (const PG8_LAS unsigned*)(hl + (((q - 1) * 2 + 1) * 2 + bj) * 256 + colh * 2 + n * 8); a0 = p[0]; a1 = p[1]; }
                    if (q < 3) { const PG8_LAS unsigned* p = (const PG8_LAS unsigned*)(hl + (((q + 1) * 2 + 0) * 2 + bj) * 256 + colh * 2 + n * 8); b0 = p[0]; b1 = p[1]; }
                    hp[bj] = (f32x4){__uint_as_float(a0 << 16), __uint_as_float(a0 & 0xffff0000u), __uint_as_float(a1 << 16), __uint_as_float(a1 & 0xffff0000u)};
                    hn[bj] = (f32x4){__uint_as_float(b0 << 16), __uint_as_float(b0 & 0xffff0000u), __uint_as_float(b1 << 16), __uint_as_float(b1 & 0xffff0000u)}; }
#pragma unroll
                for (int m = 0; m < 4; ++m) {
                    f32x4 cv[2];
#pragma unroll
                    for (int bj = 0; bj < 2; ++bj) {
                        const f32x4 cur = acc[ai][bj][m][n]; f32x4 pv, nx;
#pragma unroll
                        for (int e = 0; e < 4; ++e) {
                            float t = hp[bj][e]; if (m > 0) t = dpp_keep<0x10F>(t, acc[ai][bj][m > 0 ? m - 1 : 0][n][e]);
                            pv[e] = dpp_keep<0x111>(t, cur[e]);
                            float s = hn[bj][e]; if (m < 3) s = dpp_keep<0x11F>(s, acc[ai][bj][m < 3 ? m + 1 : 3][n][e]);
                            nx[e] = dpp_keep<0x101>(s, cur[e]); }
                        cv[bj] = pv * (bj == 0 ? wg[0] : wv[0]) + cur * (bj == 0 ? wg[1] : wv[1]) + nx * (bj == 0 ? wg[2] : wv[2]) + (bj == 0 ? bg : bv);
                    }
                    float r[4];
#pragma unroll
                    for (int e = 0; e < 4; ++e) { const float g = cv[0][e]; r[e] = g * __builtin_amdgcn_rcpf(1.0f + __expf(-g)) * cv[1][e]; }
                    pk[n][ai][m][0] = cvt_pk_bf16(r[0], r[1]); pk[n][ai][m][1] = cvt_pk_bf16(r[2], r[3]);
                }
            }
            __builtin_amdgcn_sched_barrier(0);
        }
#pragma unroll
        for (int ai = 0; ai < 2; ++ai)
#pragma unroll
            for (int m = 0; m < 4; ++m) { u32x4 w; w.x = pk[0][ai][m][0]; w.y = pk[0][ai][m][1]; w.z = pk[1][ai][m][0]; w.w = pk[1][ai][m][1];
                *(u32x4*)(ACT + (size_t)(u.pm * BM + ai * HALF + wr * 64 + m * 16 + fr) * ldact + cg0) = w; }
    }
};
template <class Epi, class Sched, bool ALIGN_EPI = false, bool SP2 = false>
__device__ __forceinline__ void gemm_phase(PG8_LAS unsigned char* lds, const Gemm g, const Sched& S, const Epi& E) {
    int tid_ = threadIdx.x; asm volatile("" : "+v"(tid_));
    const int tid = tid_, wid = __builtin_amdgcn_readfirstlane(tid >> 6), lane = tid & 63, wr = wid >> 2, wc = wid & 3, fr = lane & 15, fq = lane >> 4;
    const int K = g.K, nt = K / BK;
    unsigned voffA[2], voffB[2];
#pragma unroll
    for (int i = 0; i < 2; ++i) { int R, C; stage_rc(tid * 16 + i * 8192, R, C); const int Rb = Epi::PERM ? ((R & ~31) + perm32(R & 31)) : R;
        voffA[i] = (unsigned)(R * g.lda + C) * 2u; voffB[i] = (unsigned)(Rb * K + C) * 2u; }
    const size_t kstep = (size_t)(BK * 2);
    const size_t hstep = (size_t)HALF * K * 2;
    const size_t tstep = 2 * hstep;
    const size_t hstepA = (size_t)HALF * g.lda * 2, tstepA = 2 * hstepA;
    const unsigned ldsw = (unsigned)wid * 1024u;
    const int aoff = lds_byte(wr * 64 + fr, fq * 8), boff = lds_byte(wc * 32 + fr, fq * 8);
#define PG8_SA(b, h) (((b) * 2 + (h)) * HTB)
#define PG8_SB(b, h) ((4 + (b) * 2 + (h)) * HTB)
#define PG8_STAGE(bufoff, gbase, voff) do { _Pragma("unroll") for (int _i = 0; _i < 2; ++_i) \
        __builtin_amdgcn_global_load_lds((const unsigned*)((const char*)(gbase) + (voff)[_i]), (PG8_LAS unsigned*)(lds + (bufoff) + ldsw + _i * 8192), 16, 0, 0); } while (0)
#define PG8_LDA(dst, b, h) do { _Pragma("unroll") for (int m = 0; m < 4; ++m) _Pragma("unroll") for (int k = 0; k < 2; ++k) dst[m][k] = *(const PG8_LAS bf16x8*)(lds + PG8_SA(b, h) + aoff + m * 2048 + k * 1024); } while (0)
#define PG8_LDB(dst, b, h) do { _Pragma("unroll") for (int n = 0; n < 2; ++n) _Pragma("unroll") for (int k = 0; k < 2; ++k) dst[n][k] = *(const PG8_LAS bf16x8*)(lds + PG8_SB(b, h) + boff + n * 2048 + k * 1024); } while (0)
#define PG8_MMA(ai, bj, At, Bt) do { __builtin_amdgcn_s_setprio(1); _Pragma("unroll") for (int m = 0; m < 4; ++m) _Pragma("unroll") for (int n = 0; n < 2; ++n) _Pragma("unroll") for (int k = 0; k < 2; ++k) \
        acc[ai][bj][m][n] = __builtin_amdgcn_mfma_f32_16x16x32_bf16(Bt[n][k], At[m][k], acc[ai][bj][m][n], 0, 0, 0); __builtin_amdgcn_s_setprio(0); } while (0)
#define PG8_WAIT_V(n) asm volatile("s_waitcnt vmcnt(" #n ")" ::: "memory")
#define PG8_WAIT_L(n) asm volatile("s_waitcnt lgkmcnt(" #n ")" ::: "memory")
#define PG8_BAR __builtin_amdgcn_s_barrier()
#define PG8_SCHED __builtin_amdgcn_sched_barrier(0)
    Unit cur, nxt; int ui = 0;
    if (!S.next(0, cur)) return;
    f32x4 acc[2][2][4][2];
#pragma unroll
    for (int a = 0; a < 2; ++a)
#pragma unroll
        for (int b = 0; b < 2; ++b)
#pragma unroll
            for (int m = 0; m < 4; ++m)
#pragma unroll
                for (int n = 0; n < 2; ++n) acc[a][b][m][n] = (f32x4){0.f, 0.f, 0.f, 0.f};
    bf16x8 At[4][2], B0[2][2], B1[2][2];
    const char* cA = (const char*)g.A + (size_t)cur.pm * tstepA; const char* cB = (const char*)g.Bt + (size_t)cur.pn * tstep;
    S.a_ready(cur);
    if constexpr (SP2) {
        PG8_STAGE(PG8_SB(0, 0), cB, voffB); PG8_STAGE(PG8_SB(0, 1), cB + hstep, voffB); PG8_STAGE(PG8_SA(0, 0), cA, voffA); PG8_STAGE(PG8_SA(0, 1), cA + hstepA, voffA);
        if (wr == 1) PG8_BAR;
        PG8_WAIT_V(2); PG8_BAR;
        PG8_STAGE(PG8_SB(1, 0), cB + kstep, voffB); PG8_STAGE(PG8_SA(1, 0), cA + kstep, voffA); PG8_STAGE(PG8_SB(1, 1), cB + hstep + kstep, voffB);
        PG8_WAIT_V(6); PG8_BAR;
    } else {
        PG8_STAGE(PG8_SB(0, 0), cB, voffB); PG8_STAGE(PG8_SA(0, 0), cA, voffA); PG8_STAGE(PG8_SB(0, 1), cB + hstep, voffB); PG8_STAGE(PG8_SA(0, 1), cA + hstepA, voffA);
        if (wr == 1) PG8_BAR;
        PG8_WAIT_V(4); PG8_BAR;
        PG8_STAGE(PG8_SB(1, 0), cB + kstep, voffB); PG8_STAGE(PG8_SA(1, 0), cA + kstep, voffA); PG8_STAGE(PG8_SB(1, 1), cB + hstep + kstep, voffB);
        PG8_WAIT_V(6); PG8_BAR;
    }
    for (;;) {
        const bool has_next = S.next(ui + 1, nxt);
        const char* nA = has_next ? (const char*)g.A + (size_t)nxt.pm * tstepA : cA; const char* nB = has_next ? (const char*)g.Bt + (size_t)nxt.pn * tstep : cB;
        for (int t = 0; t < nt; t += 2) {
            const bool last = (t == nt - 2);
            const char* a1 = cA + (size_t)(t + 1) * kstep;
            const char* a2 = last ? nA : cA + (size_t)(t + 2) * kstep; const char* b2 = last ? nB : cB + (size_t)(t + 2) * kstep;
            const char* a3 = a2 + kstep; const char* b3 = b2 + kstep;
            if (last && has_next) S.a_ready(nxt);
            if constexpr (SP2) {
            PG8_LDB(B0, 0, 0); PG8_LDB(B1, 0, 1); PG8_SCHED; PG8_LDA(At, 0, 0); PG8_STAGE(PG8_SA(1, 1), a1 + hstepA, voffA);
            PG8_WAIT_V(8); PG8_WAIT_L(0); PG8_BAR; PG8_MMA(0, 0, At, B0); PG8_MMA(0, 1, At, B1); PG8_BAR; PG8_SCHED;
            PG8_LDA(At, 0, 1); PG8_STAGE(PG8_SB(0, 0), b2, voffB); PG8_STAGE(PG8_SB(0, 1), b2 + hstep, voffB); PG8_STAGE(PG8_SA(0, 0), a2, voffA);
            PG8_WAIT_V(8); PG8_WAIT_L(0); PG8_BAR; PG8_MMA(1, 0, At, B0); PG8_MMA(1, 1, At, B1); PG8_BAR; PG8_SCHED;
            PG8_LDB(B0, 1, 0); PG8_LDB(B1, 1, 1); PG8_SCHED; PG8_LDA(At, 1, 0); PG8_STAGE(PG8_SA(0, 1), a2 + hstepA, voffA);
            PG8_WAIT_V(8); PG8_WAIT_L(0); PG8_BAR; PG8_MMA(0, 0, At, B0); PG8_MMA(0, 1, At, B1); PG8_BAR; PG8_SCHED;
            PG8_LDA(At, 1, 1); PG8_STAGE(PG8_SB(1, 0), b3, voffB); PG8_STAGE(PG8_SB(1, 1), b3 + hstep, voffB); PG8_STAGE(PG8_SA(1, 0), a3, voffA);
            PG8_WAIT_V(8); PG8_WAIT_L(0); PG8_BAR; PG8_MMA(1, 0, At, B0); PG8_MMA(1, 1, At, B1); PG8_BAR; PG8_SCHED;
            } else {
            PG8_LDB(B0, 0, 0); PG8_SCHED; PG8_LDA(At, 0, 0); PG8_STAGE(PG8_SA(1, 1), a1 + hstepA, voffA);
            PG8_WAIT_L(8); PG8_BAR; PG8_WAIT_L(0); PG8_MMA(0, 0, At, B0); PG8_BAR; PG8_SCHED;
            PG8_LDB(B1, 0, 1); PG8_STAGE(PG8_SB(0, 0), b2, voffB);
            PG8_BAR; PG8_WAIT_L(0); PG8_MMA(0, 1, At, B1); PG8_BAR;
            PG8_LDA(At, 0, 1); PG8_STAGE(PG8_SA(0, 0), a2, voffA);
            PG8_BAR; PG8_WAIT_L(0); PG8_MMA(1, 0, At, B0); PG8_BAR; PG8_SCHED;
            PG8_STAGE(PG8_SB(0, 1), b2 + hstep, voffB);
            PG8_WAIT_V(6); PG8_BAR; PG8_MMA(1, 1, At, B1); PG8_BAR;
            PG8_LDB(B0, 1, 0); PG8_SCHED; PG8_LDA(At, 1, 0); PG8_STAGE(PG8_SA(0, 1), a2 + hstepA, voffA);
            PG8_WAIT_L(8); PG8_BAR; PG8_WAIT_L(0); PG8_MMA(0, 0, At, B0); PG8_BAR; PG8_SCHED;
            PG8_LDB(B1, 1, 1); PG8_STAGE(PG8_SB(1, 0), b3, voffB);
            PG8_BAR; PG8_WAIT_L(0); PG8_MMA(0, 1, At, B1); PG8_BAR;
            PG8_LDA(At, 1, 1); PG8_STAGE(PG8_SA(1, 0), a3, voffA);
            PG8_BAR; PG8_WAIT_L(0); PG8_MMA(1, 0, At, B0); PG8_BAR; PG8_SCHED;
            PG8_STAGE(PG8_SB(1, 1), b3 + hstep, voffB);
            PG8_WAIT_V(6); PG8_BAR; PG8_MMA(1, 1, At, B1); PG8_BAR;
            }
        }
        if constexpr (ALIGN_EPI) { if (wr == 0) PG8_BAR; }
        if constexpr (!Epi::AFTER_DRAIN) { E(acc, cur, wr, wc, fr, fq); S.done(cur); }
        if (!has_next) break;
#pragma unroll
        for (int a = 0; a < 2; ++a)
#pragma unroll
            for (int b = 0; b < 2; ++b)
#pragma unroll
                for (int m = 0; m < 4; ++m)
#pragma unroll
                    for (int n = 0; n < 2; ++n) acc[a][b][m][n] = (f32x4){0.f, 0.f, 0.f, 0.f};
        cur = nxt; cA = nA; cB = nB; ++ui;
        if constexpr (ALIGN_EPI) { if (wr == 1) PG8_BAR; }
    }
    PG8_WAIT_V(0);
    if constexpr (!ALIGN_EPI) { if (wr == 0) PG8_BAR; }
    PG8_BAR;
    if constexpr (Epi::AFTER_DRAIN) { E.fused(acc, cur, wr, wc, fr, fq, lds, wid, lane); S.done(cur); }
#undef PG8_SA
#undef PG8_SB
#undef PG8_STAGE
#undef PG8_LDA
#undef PG8_LDB
#undef PG8_MMA
#undef PG8_WAIT_V
#undef PG8_WAIT_L
#undef PG8_BAR
#undef PG8_SCHED
}
}

constexpr int DM = 2048, NTOK = 8192, NCTX = 4096, DEPTH = 4, NIN = 34;
constexpr int INW = 3136, INP = 3328;
constexpr int OFF_KV = 512, OFF_KR = 768, OFF_XF = 832, OFF_RKV = 1344, OFF_WLO = 2880, OFF_ALO = 2944, OFF_GLO = 3008;
constexpr int DFF = 5632, UPN = 11264, KVROWS = 9216, LORAN = 2560, QW = 1536;
constexpr float EPS = 1e-6f, GN_EPS = 64e-5f, DECAY_SCALE = 0.6065306597126334f;
enum { I_XP = 0, I_XS, I_CKV, I_CKR, I_ST, I_C, I_CCTX, I_WMOD, I_BMOD, I_GPREMIX, I_GPOSTMIX, I_GPREFFN, I_GPOSTFFN, I_WIN, I_GQ, I_WUQ, I_GKV, I_WUKV,
       I_RCONV, I_RW0, I_RW2, I_RA0, I_RA2, I_RG2, I_RKK, I_RKA, I_RRK, I_GNG, I_GNB, I_WOUT, I_WUP, I_FCONV, I_FCONVB, I_WDOWN };
constexpr size_t OUT_X = 0, OUT_CKV = (size_t)NTOK * DM, OUT_KR = OUT_CKV + (size_t)16 * 4 * 256 * 256, OUT_ST = OUT_KR + (size_t)16 * 4 * 256 * 64, OUT_END = OUT_ST + (size_t)16 * 4 * 2 * 8 * 64 * 64;

constexpr size_t A256(size_t x) { return (x + 255) & ~(size_t)255; }
constexpr size_t WS_CTL = 0, CTL_BYTES = 1u << 20;
constexpr size_t WS_MOD   = WS_CTL + CTL_BYTES;
constexpr size_t WS_ROPE  = WS_MOD + A256((size_t)4 * 5 * 12288 * 4);
constexpr size_t WS_P256  = WS_ROPE + A256((size_t)2 * 1024 * 32 * 4);
constexpr size_t WS_P1024 = WS_P256 + A256((size_t)256 * 512 * 2);
constexpr size_t WS_MBD   = WS_P1024 + A256((size_t)1024 * 2048 * 2);
constexpr size_t WS_WL    = WS_MBD + A256((size_t)1024 * 512 * 2);
constexpr size_t WS_WIN   = WS_WL + A256((size_t)4 * LORAN * 256 * 2);
constexpr size_t WS_WUQ   = WS_WIN + A256((size_t)4 * INP * DM * 2);
constexpr size_t WS_WUKV  = WS_WUQ + A256((size_t)4 * QW * 512 * 2);
constexpr size_t WS_WOUT  = WS_WUKV + A256((size_t)4 * 2048 * 256 * 2);
constexpr size_t WS_WUP   = WS_WOUT + A256((size_t)4 * DM * DM * 2);
constexpr size_t WS_WDN   = WS_WUP + A256((size_t)4 * UPN * DM * 2);
constexpr size_t WS_H     = WS_WDN + A256((size_t)4 * DM * DFF * 2);
constexpr size_t WS_PROJ  = WS_H + A256((size_t)NTOK * DM * 2);
constexpr size_t WS_QN    = WS_PROJ + A256((size_t)NTOK * INP * 2);
constexpr size_t WS_CKVA  = WS_QN + A256((size_t)NTOK * 512 * 2);
constexpr size_t WS_KR    = WS_CKVA + A256((size_t)KVROWS * 256 * 2);
constexpr size_t WS_AL    = WS_KR + A256((size_t)KVROWS * 64 * 2);
constexpr size_t WS_RC    = WS_AL + A256((size_t)NTOK * 256 * 2);
constexpr size_t WS_KC    = WS_RC + A256((size_t)NTOK * 512 * 4);
constexpr size_t WS_VC    = WS_KC + A256((size_t)NTOK * 512 * 4);
constexpr size_t WS_NK    = WS_VC + A256((size_t)NTOK * 512 * 4);
constexpr size_t WS_Q     = WS_NK + A256((size_t)NTOK * 8 * 4);
constexpr size_t WS_KV    = WS_Q + A256((size_t)NTOK * QW * 2);
constexpr size_t WS_LORA  = WS_KV + A256((size_t)KVROWS * 2048 * 2);
constexpr size_t WS_Y     = WS_LORA + A256((size_t)NTOK * LORAN * 2);
constexpr size_t WS_YF    = WS_Y + A256((size_t)NTOK * 1024 * 2);
constexpr size_t WS_YB    = WS_YF + A256((size_t)NTOK * 512 * 4);
constexpr size_t WS_BON   = WS_YB + A256((size_t)NTOK * 512 * 4);
constexpr size_t WS_MIX   = WS_BON + A256((size_t)2 * NTOK * 8 * 4);
constexpr size_t WS_O     = WS_MIX + A256((size_t)NTOK * DM * 2);
constexpr size_t WS_HALO  = WS_O + A256((size_t)NTOK * DM * 4);
constexpr size_t WS_ACT   = WS_HALO + A256((size_t)32 * 44 * 4 * 256 * 4);
constexpr size_t WS_END   = WS_ACT + A256((size_t)NTOK * DFF * 2);
constexpr int CW_TMO = 0, CW_CODE = 1, CW_QUEUE = 64  , CW_BAR = 4096;
constexpr int NPHASES = 2 + 11 * DEPTH;
constexpr int RING_OFF = 0, RING_BYTES = 131072, LDSCTL_OFF = RING_BYTES, MISC_OFF = LDSCTL_OFF + 320, HALO_OFF = MISC_OFF + 128  , LDS_BYTES = 147456, NWAVES = 8;

#define GAS __attribute__((address_space(1)))
#define LAS __attribute__((address_space(3)))
typedef unsigned short bf16;
typedef unsigned v4u __attribute__((ext_vector_type(4)));
typedef unsigned v2u __attribute__((ext_vector_type(2)));
typedef float f32x4 __attribute__((ext_vector_type(4)));
typedef float f32x2 __attribute__((ext_vector_type(2)));
typedef float f32x16 __attribute__((ext_vector_type(16)));
typedef short bf16x8 __attribute__((ext_vector_type(8)));
typedef short s16x4 __attribute__((ext_vector_type(4)));
typedef GAS unsigned gu32;
#define RLX_AGENT __ATOMIC_RELAXED, __HIP_MEMORY_SCOPE_AGENT
#define LDS_WAIT() asm volatile("s_waitcnt lgkmcnt(0)" ::: "memory")
#define VM_WAIT() asm volatile("s_waitcnt vmcnt(0)" ::: "memory")
#define SBAR() __builtin_amdgcn_sched_barrier(0)
__device__ __forceinline__ unsigned cvtpk(float lo, float hi) { unsigned r; asm volatile("v_cvt_pk_bf16_f32 %0, %1, %2" : "=v"(r) : "v"(lo), "v"(hi)); return r; }
__device__ __forceinline__ bf16 f2bf(float f) { return (bf16)(cvtpk(f, 0.f) & 0xffffu); }
__device__ __forceinline__ float bf2f(short s) { return __uint_as_float(((unsigned)(unsigned short)s) << 16); }
__device__ __forceinline__ float wave_sum(float v) {
#pragma unroll
    for (int o = 1; o < 64; o <<= 1) v += __shfl_xor(v, o);
    return v;
}
template <int CTRL> __device__ __forceinline__ float dpp_mov(float x) { return __int_as_float(__builtin_amdgcn_update_dpp(0, __float_as_int(x), CTRL, 0xf, 0xf, true)); }
__device__ __forceinline__ float allred16(float x) {
    x += dpp_mov<0xB1>(x);
    x += dpp_mov<0x4E>(x);
    x += dpp_mov<0x141>(x);
    x += dpp_mov<0x140>(x);
    return x;
}
__device__ __forceinline__ float sigmoidf_(float x) { return 1.0f / (1.0f + __expf(-x)); }
#define XB_TMO      128
#define XB_XCNT(j)  (256  + 64 * (j))
#define XB_XSUB(j)  (1280 + 64 * (j))
#define XB_XGEN(j)  (2304 + 64 * (j))
#define XB_TOP      3328
#define XB_TOPGEN   3392
#define XCD_BAR_WORDS 3456
#define XB_SPIN_CAP (1u << 18)

__device__ __forceinline__ unsigned xb_ld(unsigned* p)              { return __hip_atomic_load(p, __ATOMIC_RELAXED, __HIP_MEMORY_SCOPE_AGENT); }
__device__ __forceinline__ unsigned xb_add(unsigned* p, unsigned v) { return __hip_atomic_fetch_add(p, v, __ATOMIC_RELAXED, __HIP_MEMORY_SCOPE_AGENT); }
__device__ __forceinline__ unsigned xb_xcc_id() { return (unsigned)__builtin_amdgcn_s_getreg((3 << 11) | 20) & 0xFu; }
#define XB_SPIN(cond, bar) do { unsigned _sp = 0; while (cond) { __builtin_amdgcn_s_sleep(1); \
    if ((++_sp & 255u) == 0u) { if (xb_ld(&(bar)[XB_TMO])) break; if (_sp > XB_SPIN_CAP) { atomicAdd(&(bar)[XB_TMO], 1u); break; } } } } while (0)

struct XcdBarrier {
    unsigned* bar; unsigned x;
    volatile LAS unsigned* st;
};

__device__ __forceinline__ XcdBarrier xcd_barrier_post(unsigned* bar, volatile LAS unsigned* st) {
    XcdBarrier b; b.bar = bar; b.x = xb_xcc_id(); b.st = st;
    if (threadIdx.x == 0) (void)xb_add(&bar[XB_XCNT(b.x)], 1u);
    return b;
}
__device__ __forceinline__ void xcd_barrier_complete(unsigned* bar, unsigned x, unsigned& nloc, unsigned& nx) {
    const unsigned G = gridDim.x * gridDim.y * gridDim.z;
    unsigned sum, cnt, mine, sp = 0u;
    for (;;) {
        sum = 0u; cnt = 0u; mine = 0u;
#pragma unroll
        for (unsigned j = 0; j < 16; ++j) { const unsigned c = xb_ld(&bar[XB_XCNT(j)]); sum += c; cnt += (c > 0u) ? 1u : 0u; mine = (j == x) ? c : mine; }
        if (sum == G) break;
        __builtin_amdgcn_s_sleep(1);
        if ((++sp & 255u) == 0u) { if (xb_ld(&bar[XB_TMO])) break; if (sp > XB_SPIN_CAP) { atomicAdd(&bar[XB_TMO], 1u); break; } }
    }
    nloc = mine > 0u ? mine : 1u; nx = cnt > 0u ? cnt : 1u;
}

__device__ __forceinline__ void xcd_barrier(const XcdBarrier& b) {
    asm volatile("s_waitcnt vmcnt(0)" ::: "memory");
    __syncthreads();
    if (threadIdx.x == 0) {
        unsigned* bar = b.bar;
        __builtin_amdgcn_s_waitcnt(0);
        unsigned nloc = b.st[0], nx = b.st[1];
        if (nloc == 0u) { xcd_barrier_complete(bar, b.x, nloc, nx); b.st[0] = nloc; b.st[1] = nx; }
        const unsigned old = xb_add(&bar[XB_XSUB(b.x)], 1u);
        const unsigned gen = old / nloc;
        if (old + 1u == (gen + 1u) * nloc) {
            __builtin_amdgcn_fence(__ATOMIC_RELEASE, "agent");
            asm volatile("s_waitcnt vmcnt(0)" ::: "memory");
            const unsigned og = xb_add(&bar[XB_TOP], 1u);
            const unsigned tg = og / nx;
            if (og + 1u == (tg + 1u) * nx) xb_add(&bar[XB_TOPGEN], 1u);
            else XB_SPIN(xb_ld(&bar[XB_TOPGEN]) == tg, bar);
            __builtin_amdgcn_fence(__ATOMIC_ACQUIRE, "agent");
            xb_add(&bar[XB_XGEN(b.x)], 1u);
            asm volatile("s_waitcnt vmcnt(0)" ::: "memory");
        } else {
            XB_SPIN(xb_ld(&bar[XB_XGEN(b.x)]) == gen, bar);
            __builtin_amdgcn_fence(__ATOMIC_ACQUIRE, "agent");
            asm volatile("s_waitcnt vmcnt(0)" ::: "memory");
        }
    }
    __syncthreads();
}

struct Frame {
    LAS unsigned char* lds;
    volatile LAS unsigned* MISC;
    gu32* ctl;
    int tid, lane, wave, vcu, G;
    const float* const* in;
    float* out; unsigned char* ws;
};
#define WSP(T, off) ((T*)(F.ws + (off)))

template <bool FFNPERM = false> __device__ __forceinline__ void p0_transpose_item(const float* W, int K, int N, bf16* WT, LAS float* scr, int item, int lane) {
    const int nblk = N / 32, kb = item / nblk, nb = item % nblk, k0 = 64 * kb, n0 = 32 * nb;
    const int d0 = !FFNPERM ? n0 : (n0 < DFF ? 256 * (n0 >> 7) + (n0 & 127) : 256 * ((n0 - DFF) >> 7) + 128 + ((n0 - DFF) & 127));
    float v[32];
#pragma unroll
    for (int i = 0; i < 32; ++i) v[i] = W[(size_t)(k0 + 2 * i + (lane >> 5)) * N + n0 + (lane & 31)];
#pragma unroll
    for (int i = 0; i < 32; ++i) scr[(2 * i + (lane >> 5)) * 33 + (lane & 31)] = v[i];
    LDS_WAIT(); asm volatile("" ::: "memory");
    const int c = lane & 7;
#pragma unroll
    for (int j = 0; j < 4; ++j) { const int n = (lane >> 3) + 8 * j; const LAS float* s = scr + (8 * c) * 33 + n;
        v4u o; o.x = cvtpk(s[0 * 33], s[1 * 33]); o.y = cvtpk(s[2 * 33], s[3 * 33]); o.z = cvtpk(s[4 * 33], s[5 * 33]); o.w = cvtpk(s[6 * 33], s[7 * 33]);
        *(GAS v4u*)(WT + (size_t)(d0 + n) * K + k0 + 8 * c) = o; }
    LDS_WAIT(); asm volatile("" ::: "memory");
}
constexpr int I_IN = (DM / 64) * (INW / 32), I_UQ = (512 / 64) * (QW / 32), I_UKV = (256 / 64) * (2048 / 32), I_OUT = (DM / 64) * (DM / 32), I_UP = (DM / 64) * (UPN / 32), I_DN = (DFF / 64) * (DM / 32);
constexpr int I_LAYER = I_IN + I_UQ + I_UKV + I_OUT + I_UP + I_DN;
__device__ __forceinline__ void convert_wave_item(Frame& F, int l, int r, LAS float* scr) {
    if (r < I_IN) { p0_transpose_item(F.in[I_WIN] + (size_t)l * DM * INW, DM, INW, WSP(bf16, WS_WIN) + (size_t)l * INP * DM, scr, r, F.lane); return; } r -= I_IN;
    if (r < I_UQ) { p0_transpose_item(F.in[I_WUQ] + (size_t)l * 512 * QW, 512, QW, WSP(bf16, WS_WUQ) + (size_t)l * QW * 512, scr, r, F.lane); return; } r -= I_UQ;
    if (r < I_UKV) { p0_transpose_item(F.in[I_WUKV] + (size_t)l * 256 * 2048, 256, 2048, WSP(bf16, WS_WUKV) + (size_t)l * 2048 * 256, scr, r, F.lane); return; } r -= I_UKV;
    if (r < I_OUT) { p0_transpose_item(F.in[I_WOUT] + (size_t)l * DM * DM, DM, DM, WSP(bf16, WS_WOUT) + (size_t)l * DM * DM, scr, r, F.lane); return; } r -= I_OUT;
    if (r < I_UP) { p0_transpose_item<true>(F.in[I_WUP] + (size_t)l * DM * UPN, DM, UPN, WSP(bf16, WS_WUP) + (size_t)l * UPN * DM, scr, r, F.lane); return; } r -= I_UP;
    p0_transpose_item(F.in[I_WDOWN] + (size_t)l * DFF * DM, DFF, DM, WSP(bf16, WS_WDN) + (size_t)l * DM * DFF, scr, r, F.lane);
}
__device__ __forceinline__ void mod_block_item(Frame& F, int l, int ch) {
    LAS float* sc = (LAS float*)(F.lds);
    LAS float* red = (LAS float*)(F.lds + 40960);
    for (int i = F.tid; i < 5 * 2048; i += 512) { const int cd = i >> 11, k = i & 2047; const float x = (cd == 0) ? F.in[I_CCTX][k] : F.in[I_C][(cd - 1) * 2048 + k]; sc[i] = x * sigmoidf_(x); }
    __syncthreads();
    const int kh = F.lane >> 5, c4 = F.lane & 31;
    const float* wp = F.in[I_WMOD] + (size_t)l * DM * 12288 + (size_t)ch * 128 + 4 * c4;
    f32x4 a0 = {0.f, 0.f, 0.f, 0.f}, a1 = a0, a2 = a0, a3 = a0, a4 = a0;
#pragma unroll 8
    for (int i = 0; i < 128; ++i) { const int k = 256 * F.wave + 2 * i + kh; const f32x4 wv = *(const f32x4*)(wp + (size_t)k * 12288);
        a0 += wv * sc[k]; a1 += wv * sc[2048 + k]; a2 += wv * sc[4096 + k]; a3 += wv * sc[6144 + k]; a4 += wv * sc[8192 + k]; }
    const int part = F.wave * 2 + kh;
    *(LAS f32x4*)(red + (part * 5 + 0) * 128 + 4 * c4) = a0; *(LAS f32x4*)(red + (part * 5 + 1) * 128 + 4 * c4) = a1; *(LAS f32x4*)(red + (part * 5 + 2) * 128 + 4 * c4) = a2;
    *(LAS f32x4*)(red + (part * 5 + 3) * 128 + 4 * c4) = a3; *(LAS f32x4*)(red + (part * 5 + 4) * 128 + 4 * c4) = a4;
    __syncthreads();
    for (int i = F.tid; i < 640; i += 512) { const int cd = i >> 7, col = i & 127; float s = F.in[I_BMOD][(size_t)l * 12288 + ch * 128 + col];
#pragma unroll
        for (int p = 0; p < 16; ++p) s += red[(p * 5 + cd) * 128 + col];
        WSP(float, WS_MOD)[((size_t)l * 5 + cd) * 12288 + ch * 128 + col] = s; }
    __syncthreads();
}
__device__ __forceinline__ void p0_prologue(Frame& F) {
    LAS float* scr = (LAS float*)(F.lds + RING_OFF + F.wave * 16384);
    const int gw = F.vcu * NWAVES + F.wave, NGW = F.G * NWAVES;
    for (int it = gw; it < I_LAYER; it += NGW) convert_wave_item(F, 0, it, scr);
    const long gt = (long)F.vcu * 512 + F.tid, NGT = (long)F.G * 512;
    for (long i = gt; i < (long)DEPTH * (INP - INW) * DM / 8; i += NGT) { const int l = (int)(i / ((INP - INW) * DM / 8)); const long r = i % ((INP - INW) * DM / 8);
        *(v4u*)(WSP(bf16, WS_WIN) + (size_t)l * INP * DM + (size_t)INW * DM + r * 8) = (v4u){0u, 0u, 0u, 0u}; }
    for (long i = gt; i < (long)DEPTH * LORAN * 256; i += NGT) { const int l = (int)(i / (LORAN * 256)), n = (int)((i / 256) % LORAN), k = (int)(i & 255);
        float v = 0.f;
        if (n < 1024) { if (k < 64) v = F.in[I_RW2][(((size_t)l * 2 + (n >> 9)) * 64 + k) * 512 + (n & 511)]; }
        else if (n < 2048) { if (k >= 64 && k < 128) v = F.in[I_RA2][(((size_t)l * 2 + ((n - 1024) >> 9)) * 64 + (k - 64)) * 512 + (n & 511)]; }
        else { if (k >= 128) v = F.in[I_RG2][((size_t)l * 128 + (k - 128)) * 512 + (n - 2048)]; }
        WSP(bf16, WS_WL)[i] = f2bf(v); }
    for (long i = gt; i < 1024 * 512; i += NGT) { const int n = (int)(i >> 9), k = (int)(i & 511), g = n >> 8, j = n & 255, g2 = k >> 7, c = k & 127;
        float v = 0.f; if (g == g2) { const int m = (c * (j & 127)) & 127; v = (j < 128) ? cospif((float)m * (1.0f / 64.0f)) : sinpif((float)m * (1.0f / 64.0f)); }
        WSP(bf16, WS_MBD)[i] = f2bf(v); }
    for (long i = gt; i < 256 * 512; i += NGT) { const int tp = (int)(i >> 9), t = (int)(i & 511), m = (tp * (t & 255)) & 255; const float sc = 0.005524271728019903f;
        const float v = (t < 256) ? cospif((float)m * (1.0f / 128.0f)) : -sinpif((float)m * (1.0f / 128.0f)); WSP(bf16, WS_P256)[i] = f2bf(v * sc); }
    for (long i = gt; i < 1024 * 2048; i += NGT) { const int tp = (int)(i >> 11), t = (int)(i & 2047), m = (tp * (t & 1023)) & 1023; const float sc = 0.0027621358640099515f;
        const float v = (t < 1024) ? cospif((float)m * (1.0f / 512.0f)) : -sinpif((float)m * (1.0f / 512.0f)); WSP(bf16, WS_P1024)[i] = f2bf(v * sc); }
    for (long i = gt; i < 1024 * 32; i += NGT) { const int t = (int)(i >> 5), ii = (int)(i & 31); const float pos = (ii < 16) ? (float)(t >> 6) : (float)(t & 63);
        const float inv = exp2f(-(float)(ii & 15) * (13.287712379549449f / 16.0f)); const float ang = pos * inv;
        WSP(float, WS_ROPE)[i] = cosf(ang); WSP(float, WS_ROPE)[1024 * 32 + i] = sinf(ang); }
    __syncthreads();
    for (int it = F.vcu; it < 96; it += F.G) mod_block_item(F, 0, it);
}

template <int MODE> __device__ __forceinline__ void norm_phase(Frame& F, int l) {
    LAS float* vA = (LAS float*)(F.lds); LAS float* vB = vA + 2048; LAS float* vC = vB + 2048;
    const float* MOD = WSP(float, WS_MOD);
    const bool doh = (MODE != 2) || (l < DEPTH - 1);
    for (int ch = F.vcu; ch < NTOK / 32; ch += F.G) {
        const int row0 = 32 * ch, cond = row0 < NCTX ? 0 : 1 + ((row0 - NCTX) >> 10);
        __syncthreads();
        { const int col = 4 * F.tid;
          if (MODE != 0) { const float* gate = MOD + ((size_t)l * 5 + cond) * 12288 + (MODE == 1 ? 4096 : 10240) + col; const float* gp = F.in[MODE == 1 ? I_GPOSTMIX : I_GPOSTFFN] + (size_t)l * DM + col;
              *(LAS f32x4*)(vA + col) = *(const f32x4*)gate * *(const f32x4*)gp; }
          if (doh) { const int ln = (MODE == 2) ? l + 1 : l; const float* mb = MOD + ((size_t)ln * 5 + cond) * 12288;
              const float* gpre = F.in[MODE == 1 ? I_GPREFFN : I_GPREMIX] + (size_t)ln * DM + col;
              const float* scp = mb + (MODE == 1 ? 8192 : 2048) + col; const float* shp = mb + (MODE == 1 ? 6144 : 0) + col;
              *(LAS f32x4*)(vB + col) = *(const f32x4*)gpre * (*(const f32x4*)scp + 1.0f); *(LAS f32x4*)(vC + col) = *(const f32x4*)shp; } }
        __syncthreads();
        for (int rr = 0; rr < 4; ++rr) {
            const int row = row0 + 4 * F.wave + rr;
            float* xrow = F.out + OUT_X + (size_t)row * DM;
            f32x4 x[8];
            if (MODE == 0) { const float* src = row < NCTX ? F.in[I_XP] + (size_t)row * DM : F.in[I_XS] + (size_t)(row - NCTX) * DM;
#pragma unroll
                for (int j = 0; j < 8; ++j) x[j] = *(const f32x4*)(src + 4 * F.lane + 256 * j); }
            else { const bf16* orow = WSP(bf16, WS_O) + (size_t)row * DM; f32x4 o[8]; float ss = 0.f;
#pragma unroll
                for (int j = 0; j < 8; ++j) { const s16x4 ov = *(const s16x4*)(orow + 4 * F.lane + 256 * j); o[j] = (f32x4){bf2f(ov[0]), bf2f(ov[1]), bf2f(ov[2]), bf2f(ov[3])}; x[j] = *(const f32x4*)(xrow + 4 * F.lane + 256 * j); ss += o[j].x * o[j].x + o[j].y * o[j].y + o[j].z * o[j].z + o[j].w * o[j].w; }
                const float rs = rsqrtf(wave_sum(ss) * (1.0f / DM) + EPS);
#pragma unroll
                for (int j = 0; j < 8; ++j) x[j] += *(const LAS f32x4*)(vA + 4 * F.lane + 256 * j) * (o[j] * rs); }
#pragma unroll
            for (int j = 0; j < 8; ++j) *(f32x4*)(xrow + 4 * F.lane + 256 * j) = x[j];
            if (doh) { float ss = 0.f;
#pragma unroll
                for (int j = 0; j < 8; ++j) ss += x[j].x * x[j].x + x[j].y * x[j].y + x[j].z * x[j].z + x[j].w * x[j].w;
                const float rs = rsqrtf(wave_sum(ss) * (1.0f / DM) + EPS);
                bf16* hrow = WSP(bf16, WS_H) + (size_t)row * DM;
#pragma unroll
                for (int j = 0; j < 8; ++j) { const f32x4 hv = (x[j] * rs) * *(const LAS f32x4*)(vB + 4 * F.lane + 256 * j) + *(const LAS f32x4*)(vC + 4 * F.lane + 256 * j);
                    v2u w; w.x = cvtpk(hv.x, hv.y); w.y = cvtpk(hv.z, hv.w); *(v2u*)(hrow + 4 * F.lane + 256 * j) = w; } }
        }
    }
}

__device__ __forceinline__ int kv_row(int row) { return row < NCTX ? row : NCTX + ((row - NCTX) >> 10) * 1280 + 256 + ((row - NCTX) & 1023); }
__device__ __forceinline__ void prep_phase(Frame& F, int l) {
    const int gw = F.vcu * NWAVES + F.wave, NGW = F.G * NWAVES, lane = F.lane;
    const bf16* PROJ = WSP(bf16, WS_PROJ);
    for (int row = gw; row < NTOK; row += NGW) {
        const bf16* pr = PROJ + (size_t)row * INP;
        const int kvr = kv_row(row);
        { const bf16x8 qv = *(const bf16x8*)(pr + 8 * lane); float q[8]; float ss = 0.f;
#pragma unroll
          for (int e = 0; e < 8; ++e) { q[e] = bf2f(qv[e]); ss += q[e] * q[e]; }
          const float rs = rsqrtf(wave_sum(ss) * (1.0f / 512.0f) + EPS);
          const float* g = F.in[I_GQ] + (size_t)l * 512 + 8 * lane; const f32x4 g0 = *(const f32x4*)g, g1 = *(const f32x4*)(g + 4);
          v4u w; w.x = cvtpk(q[0] * rs * g0.x, q[1] * rs * g0.y); w.y = cvtpk(q[2] * rs * g0.z, q[3] * rs * g0.w); w.z = cvtpk(q[4] * rs * g1.x, q[5] * rs * g1.y); w.w = cvtpk(q[6] * rs * g1.z, q[7] * rs * g1.w);
          *(v4u*)(WSP(bf16, WS_QN) + (size_t)row * 512 + 8 * lane) = w; }
        { const s16x4 kvv = *(const s16x4*)(pr + OFF_KV + 4 * lane); f32x4 kv = {bf2f(kvv[0]), bf2f(kvv[1]), bf2f(kvv[2]), bf2f(kvv[3])};
          const float rs = rsqrtf(wave_sum(kv.x * kv.x + kv.y * kv.y + kv.z * kv.z + kv.w * kv.w) * (1.0f / 256.0f) + EPS);
          kv = kv * rs * *(const f32x4*)(F.in[I_GKV] + (size_t)l * 256 + 4 * lane);
          v2u w; w.x = cvtpk(kv.x, kv.y); w.y = cvtpk(kv.z, kv.w); *(v2u*)(WSP(bf16, WS_CKVA) + (size_t)kvr * 256 + 4 * lane) = w;
          if (row < NCTX) *(f32x4*)(F.out + OUT_CKV + ((size_t)((row >> 8) * DEPTH + l) * 256 + (row & 255)) * 256 + 4 * lane) = kv; }
        { const float kr = bf2f((short)pr[OFF_KR + lane]); float val = kr;
          if (row < NCTX) F.out[OUT_KR + ((size_t)((row >> 8) * DEPTH + l) * 256 + (row & 255)) * 64 + lane] = kr;
          else { const int t = (row - NCTX) & 1023, i = lane & 31; const float c = WSP(float, WS_ROPE)[t * 32 + i], s = WSP(float, WS_ROPE)[1024 * 32 + t * 32 + i];
              const float other = __shfl_xor(kr, 32); val = (lane < 32) ? kr * c - other * s : other * s + kr * c; }
          WSP(bf16, WS_KR)[(size_t)kvr * 64 + lane] = f2bf(val); }
        { bf16* al = WSP(bf16, WS_AL) + (size_t)row * 256;
          al[lane] = f2bf(tanhf(bf2f((short)pr[OFF_WLO + lane]))); al[64 + lane] = pr[OFF_ALO + lane];
          const unsigned gg = *(const unsigned*)(pr + OFF_GLO + 2 * lane); *(unsigned*)(al + 128 + 2 * lane) = cvtpk(sigmoidf_(__uint_as_float(gg << 16)), sigmoidf_(__uint_as_float(gg & 0xffff0000u))); }
    }
    for (int it = gw; it < (NTOK / 32) * 24; it += NGW) {
        const int chunk = it / 24, grp = it % 24, row0 = 32 * chunk, which = grp >> 3, hh = grp & 7;
        const int s0 = row0 < NCTX ? (row0 & ~255) : NCTX + ((row0 - NCTX) & ~1023), send = s0 + (row0 < NCTX ? 256 : 1024);
        const int ch = 64 * grp + lane, cc = 64 * hh + lane;
        const float* cw = F.in[I_RCONV] + (size_t)l * 3 * 1536;
        const float w0 = cw[ch], w1 = cw[1536 + ch], w2 = cw[3072 + ch];
        const float kk = F.in[I_RKK][(size_t)l * 512 + cc];
        float* dst = WSP(float, which == 0 ? WS_RC : (which == 1 ? WS_KC : WS_VC));
        const bf16* src = PROJ + OFF_RKV + ch;
        bf16 xv[34];
#pragma unroll
        for (int i = 0; i < 34; ++i) { const int row = row0 - 1 + i; xv[i] = (row >= s0 && row < send) ? src[(size_t)row * INP] : (bf16)0; }
#pragma unroll
        for (int i = 0; i < 32; ++i) { const int row = row0 + i;
            const float o = bf2f((short)xv[i]) * w0 + bf2f((short)xv[i + 1]) * w1 + bf2f((short)xv[i + 2]) * w2; dst[(size_t)row * 512 + cc] = o;
            if (which == 1) { const float kap = o * kk; const float ss = wave_sum(kap * kap); if (lane == 0) WSP(float, WS_NK)[row * 8 + hh] = rsqrtf(ss + EPS); } }
    }
    { const long gt = (long)F.vcu * 512 + F.tid, NGT = (long)F.G * 512;
      for (long i = gt; i < 1024 * 64; i += NGT) { const int r = (int)(i >> 6), c4 = (int)(i & 63) * 4, b = r >> 8, j = r & 255;
          const f32x4 v = *(const f32x4*)(F.in[I_CKV] + (((size_t)b * DEPTH + l) * 256 + j) * 256 + c4); v2u w; w.x = cvtpk(v.x, v.y); w.y = cvtpk(v.z, v.w);
          *(v2u*)(WSP(bf16, WS_CKVA) + (size_t)(NCTX + b * 1280 + j) * 256 + c4) = w; }
      for (long i = gt; i < 1024 * 16; i += NGT) { const int r = (int)(i >> 4), c4 = (int)(i & 15) * 4, b = r >> 8, j = r & 255;
          const f32x4 v = *(const f32x4*)(F.in[I_CKR] + (((size_t)b * DEPTH + l) * 256 + j) * 64 + c4); v2u w; w.x = cvtpk(v.x, v.y); w.y = cvtpk(v.z, v.w);
          *(v2u*)(WSP(bf16, WS_KR) + (size_t)(NCTX + b * 1280 + j) * 64 + c4) = w; } }
}

__device__ __forceinline__ void post_phase(Frame& F, int l) {
    const int gw = F.vcu * NWAVES + F.wave, NGW = F.G * NWAVES, lane = F.lane;
    for (int row = gw; row < NTOK; row += NGW) {
        float y[8], vv[8], gg[8], bo[8];
#pragma unroll
        for (int h = 0; h < 8; ++h) { const int c = 64 * h + lane;
            y[h] = WSP(float, WS_YF)[(size_t)row * 512 + c] + WSP(float, WS_YB)[(size_t)row * 512 + c]; vv[h] = WSP(float, WS_VC)[(size_t)row * 512 + c];
            gg[h] = bf2f((short)WSP(bf16, WS_LORA)[(size_t)row * LORAN + 2048 + c]);
            bo[h] = WSP(float, WS_BON)[(size_t)row * 8 + h] + WSP(float, WS_BON)[(size_t)NTOK * 8 + (size_t)row * 8 + h]; }
#pragma unroll
        for (int h = 0; h < 8; ++h) { const int c = 64 * h + lane;
            const float mu = wave_sum(y[h]) * (1.0f / 64.0f); const float d = y[h] - mu; const float var = wave_sum(d * d) * (1.0f / 64.0f);
            const float yn = d * rsqrtf(var + GN_EPS) * F.in[I_GNG][(size_t)l * 512 + c] + F.in[I_GNB][(size_t)l * 512 + c];
            WSP(bf16, WS_MIX)[(size_t)row * DM + 1536 + c] = f2bf((yn + bo[h] * vv[h]) * gg[h]); }
    }
}

__device__ __forceinline__ void ffn_fix_phase(Frame& F, int l) {
    const long gt = (long)F.vcu * 512 + F.tid, NGT = (long)F.G * 512;
    const float* cw = F.in[I_FCONV] + (size_t)l * 3 * UPN; const float* cb = F.in[I_FCONVB] + (size_t)l * UPN; const float* HG = WSP(float, WS_HALO);
    for (long i = gt; i < 12L * DFF; i += NGT) { const int sb = (int)(i / DFF), c = (int)(i % DFF), pmA = 16 + 4 * (sb / 3) + (sb % 3), pn = c >> 7, ch = c & 127;
        const float* hA = HG + ((size_t)(pmA * (DFF / 128) + pn) * 4) * 256 + ch; const float* hB = hA + (size_t)(DFF / 128) * 4 * 256;
        const float wg0 = cw[c], wg1 = cw[UPN + c], wg2 = cw[2 * UPN + c], wv0 = cw[DFF + c], wv1 = cw[UPN + DFF + c], wv2 = cw[2 * UPN + DFF + c], bg = cb[c], bv = cb[DFF + c];
        const float gA254 = hA[2 * 256], gA255 = hA[3 * 256], gB0 = hB[0], gB1 = hB[256], vA254 = hA[2 * 256 + 128], vA255 = hA[3 * 256 + 128], vB0 = hB[128], vB1 = hB[256 + 128];
        { const float g = wg0 * gA254 + wg1 * gA255 + wg2 * gB0 + bg, v = wv0 * vA254 + wv1 * vA255 + wv2 * vB0 + bv; WSP(bf16, WS_ACT)[(size_t)(256 * pmA + 255) * DFF + c] = f2bf(g * sigmoidf_(g) * v); }
        { const float g = wg0 * gA255 + wg1 * gB0 + wg2 * gB1 + bg, v = wv0 * vA255 + wv1 * vB0 + wv2 * vB1 + bv; WSP(bf16, WS_ACT)[(size_t)(256 * pmA + 256) * DFF + c] = f2bf(g * sigmoidf_(g) * v); } }
}

constexpr int SC_STEP = 448, SC_BUF = 32 * SC_STEP;
__device__ __forceinline__ void scan_unit(Frame& F, int l, int s, int h, int d) {
    const int tid = F.tid, lane = F.lane, wv = F.wave;
    const int T = s < 16 ? 256 : 1024, row0 = s < 16 ? 256 * s : NCTX + 1024 * (s - 16), NCH = T / 32;
    LAS float* SV = (LAS float*)F.lds;
    LAS float* YS = (LAS float*)(F.lds + 2 * SC_BUF * 4);
    const int rp = lane >> 4, kq = lane & 15, rowA = 8 * wv + 2 * rp;
    f32x2 ST[4];
    if (s >= 16) { const float* sp = F.in[I_ST] + ((((size_t)(s - 16) * DEPTH + l) * 2 + d) * 8 + h) * 4096 + rowA * 64 + 4 * kq; const f32x4 a = *(const f32x4*)sp, b = *(const f32x4*)(sp + 64);
#pragma unroll
        for (int k = 0; k < 4; ++k) ST[k] = (f32x2){a[k], b[k]}; }
    else {
#pragma unroll
        for (int k = 0; k < 4; ++k) ST[k] = (f32x2){0.f, 0.f}; }
    const int si = tid >> 4, sj = tid & 15, sn = sj * 4, cbase = 64 * h + sn;
    const f32x4 w0v = *(const f32x4*)(F.in[I_RW0] + ((size_t)l * 2 + d) * 512 + cbase), a0v = *(const f32x4*)(F.in[I_RA0] + ((size_t)l * 2 + d) * 512 + cbase);
    const f32x4 kkv = *(const f32x4*)(F.in[I_RKK] + (size_t)l * 512 + cbase), kav = *(const f32x4*)(F.in[I_RKA] + (size_t)l * 512 + cbase), rkv = *(const f32x4*)(F.in[I_RRK] + (size_t)l * 512 + cbase);
    float* Yout = WSP(float, d == 0 ? WS_YF : WS_YB); float* BON = WSP(float, WS_BON) + (size_t)d * NTOK * 8;
    const float* RC = WSP(float, WS_RC); const float* KC = WSP(float, WS_KC); const float* VC = WSP(float, WS_VC); const float* NK = WSP(float, WS_NK); const bf16* LORA = WSP(bf16, WS_LORA);
    f32x4 gr, gk, gv, gwp, gap; float gnk;
#define SCAN_ROW(c) (row0 + (d == 0 ? 32 * (c) + si : T - 1 - (32 * (c) + si)))
#define SCAN_LOADG(c) do { const size_t row_ = (size_t)SCAN_ROW(c); gr = *(const f32x4*)(RC + row_ * 512 + cbase); gk = *(const f32x4*)(KC + row_ * 512 + cbase); gv = *(const f32x4*)(VC + row_ * 512 + cbase); \
        { const s16x4 a_ = *(const s16x4*)(LORA + row_ * LORAN + d * 512 + cbase), b_ = *(const s16x4*)(LORA + row_ * LORAN + 1024 + d * 512 + cbase); \
          gwp = (f32x4){bf2f(a_[0]), bf2f(a_[1]), bf2f(a_[2]), bf2f(a_[3])}; gap = (f32x4){bf2f(b_[0]), bf2f(b_[1]), bf2f(b_[2]), bf2f(b_[3])}; } gnk = NK[row_ * 8 + h]; } while (0)
#define SCAN_WRITES(buf, c) do { const f32x4 kh_ = gk * kkv * gnk; f32x4 w_, a_; \
        _Pragma("unroll") for (int e = 0; e < 4; ++e) { w_[e] = __expf(-DECAY_SCALE * sigmoidf_(w0v[e] + gwp[e])); a_[e] = sigmoidf_(a0v[e] + gap[e]); } \
        const f32x4 b_ = a_ * kh_, kt_ = gk * ((a_ - 1.0f) * kav + 1.0f); const f32x4 bb_ = gr * rkv * kt_, br4_ = b_ * gr, kr4_ = kt_ * gr; \
        const float bon_ = allred16((bb_.x + bb_.y) + (bb_.z + bb_.w)), br_ = allred16((br4_.x + br4_.y) + (br4_.z + br4_.w)), ktr_ = allred16((kr4_.x + kr4_.y) + (kr4_.z + kr4_.w)); \
        if (sj == 0) BON[(size_t)SCAN_ROW(c) * 8 + h] = bon_; \
        LAS float* p_ = SV + (buf) * SC_BUF + si * SC_STEP; *(LAS f32x4*)(p_ + sn) = w_; *(LAS f32x4*)(p_ + 64 + sn) = kh_; *(LAS f32x4*)(p_ + 128 + sn) = b_; *(LAS f32x4*)(p_ + 192 + sn) = kt_; \
        *(LAS f32x4*)(p_ + 256 + sn) = gr; *(LAS f32x4*)(p_ + 320 + 8 * sj) = (f32x4){gv.x, gv.y, br_, ktr_}; *(LAS f32x4*)(p_ + 324 + 8 * sj) = (f32x4){gv.z, gv.w, br_, ktr_}; } while (0)
    SCAN_LOADG(0); SCAN_WRITES(0, 0); __syncthreads();
    const int vo = 4 * kq, ao = 320 + 4 * (4 * wv + rp);
    for (int c = 0; c < NCH; ++c) {
        if (c + 1 < NCH) SCAN_LOADG(c + 1);
        const LAS float* sv = SV + (c & 1) * SC_BUF; LAS float* ys = YS + (c & 1) * 2048;
        f32x4 w4 = *(const LAS f32x4*)(sv + vo), kh4 = *(const LAS f32x4*)(sv + 64 + vo), b4 = *(const LAS f32x4*)(sv + 128 + vo), kt4 = *(const LAS f32x4*)(sv + 192 + vo), r4 = *(const LAS f32x4*)(sv + 256 + vo), ax = *(const LAS f32x4*)(sv + ao);
#pragma unroll 4
        for (int i = 0; i < 32; ++i) {
            const LAS float* pn = sv + ((i + 1) & 31) * SC_STEP;
            const f32x4 nw = *(const LAS f32x4*)(pn + vo), nkh = *(const LAS f32x4*)(pn + 64 + vo), nb = *(const LAS f32x4*)(pn + 128 + vo), nkt = *(const LAS f32x4*)(pn + 192 + vo), nr = *(const LAS f32x4*)(pn + 256 + vo), nax = *(const LAS f32x4*)(pn + ao);
            f32x2 SW[4];
#pragma unroll
            for (int k = 0; k < 4; ++k) SW[k] = ST[k] * w4[k];
            f32x2 P = ST[0] * kh4[0], A = SW[0] * r4[0];
#pragma unroll
            for (int k = 1; k < 4; ++k) { P += ST[k] * kh4[k]; A += SW[k] * r4[k]; }
            float p0 = P.x, p1 = P.y, q0 = A.x, q1 = A.y;
            p0 += dpp_mov<0xB1>(p0); p1 += dpp_mov<0xB1>(p1); q0 += dpp_mov<0xB1>(q0); q1 += dpp_mov<0xB1>(q1);
            p0 += dpp_mov<0x4E>(p0); p1 += dpp_mov<0x4E>(p1); q0 += dpp_mov<0x4E>(q0); q1 += dpp_mov<0x4E>(q1);
            p0 += dpp_mov<0x141>(p0); p1 += dpp_mov<0x141>(p1); q0 += dpp_mov<0x141>(q0); q1 += dpp_mov<0x141>(q1);
            p0 += dpp_mov<0x140>(p0); p1 += dpp_mov<0x140>(p1); q0 += dpp_mov<0x140>(q0); q1 += dpp_mov<0x140>(q1);
            const f32x2 SK = {p0, p1}, V2 = {ax.x, ax.y};
            const f32x2 Y = (f32x2){q0, q1} - SK * ax.z + V2 * ax.w;
#pragma unroll
            for (int k = 0; k < 4; ++k) ST[k] = SW[k] - SK * b4[k] + V2 * kt4[k];
            if (kq == 0) *(LAS f32x2*)(ys + i * 64 + rowA) = Y;
            w4 = nw; kh4 = nkh; b4 = nb; kt4 = nkt; r4 = nr; ax = nax;
        }
        if (c + 1 < NCH) SCAN_WRITES((c + 1) & 1, c + 1);
        __syncthreads();
        *(f32x4*)(Yout + (size_t)SCAN_ROW(c) * 512 + cbase) = *(const LAS f32x4*)(ys + si * 64 + sn);
    }
    if (s < 16) { float* op = F.out + OUT_ST + ((((size_t)s * DEPTH + l) * 2 + d) * 8 + h) * 4096 + rowA * 64 + 4 * kq;
        *(f32x4*)op = (f32x4){ST[0].x, ST[1].x, ST[2].x, ST[3].x}; *(f32x4*)(op + 64) = (f32x4){ST[0].y, ST[1].y, ST[2].y, ST[3].y}; }
#undef SCAN_ROW
#undef SCAN_LOADG
#undef SCAN_WRITES
}

constexpr float ATT_SCALE = 0.07216878364870322f;
constexpr float ATT_THR = 8.f;
#define KSWZ(row, colB) ((row) * 256 + ((colB) ^ (((row) & 7) << 4)))
__device__ __forceinline__ int crow(int r, int hi) { return (r & 3) + 8 * (r >> 2) + 4 * hi; }
__device__ __forceinline__ void partialSM(f32x16& p0, f32x16& p1, float& m_reg, float& mn, float& alpha) {
    constexpr float C = ATT_SCALE * 1.4426950408889634f;
    float pmax = p0[0];
#pragma unroll
    for (int r = 1; r < 16; ++r) pmax = fmaxf(pmax, p0[r]);
#pragma unroll
    for (int r = 0; r < 16; ++r) pmax = fmaxf(pmax, p1[r]);
    { auto rr = __builtin_amdgcn_permlane32_swap(__float_as_uint(pmax), __float_as_uint(pmax), false, false); pmax = fmaxf(__uint_as_float(rr[0]), __uint_as_float(rr[1])); }
    if (__builtin_expect(__all(pmax - m_reg <= ATT_THR / ATT_SCALE), 1)) { mn = m_reg; alpha = 1.f; }
    else { mn = fmaxf(m_reg, pmax); alpha = __builtin_amdgcn_exp2f((m_reg - mn) * C); m_reg = mn; }
    const float mnC = -mn * C;
#pragma unroll
    for (int r = 0; r < 16; ++r) p0[r] = __builtin_amdgcn_exp2f(fmaf(p0[r], C, mnC));
#pragma unroll
    for (int r = 0; r < 16; ++r) p1[r] = __builtin_amdgcn_exp2f(fmaf(p1[r], C, mnC));
}
__device__ __forceinline__ void finishSM(f32x16& p0, f32x16& p1, float alpha, float& l_reg, bf16x8& pa0, bf16x8& pa1, bf16x8& pa2, bf16x8& pa3) {
    float ps = 0;
#pragma unroll
    for (int r = 0; r < 16; ++r) ps += p0[r];
#pragma unroll
    for (int r = 0; r < 16; ++r) ps += p1[r];
    { auto rr = __builtin_amdgcn_permlane32_swap(__float_as_uint(ps), __float_as_uint(ps), false, false); ps = __uint_as_float(rr[0]) + __uint_as_float(rr[1]); }
    l_reg = l_reg * alpha + ps;
#define PK4(P, BASE, OUT) do { unsigned a0 = cvtpk(P[BASE + 0], P[BASE + 1]), a1 = cvtpk(P[BASE + 2], P[BASE + 3]);   \
    unsigned b0 = cvtpk(P[BASE + 4], P[BASE + 5]), b1 = cvtpk(P[BASE + 6], P[BASE + 7]);                              \
    auto r0 = __builtin_amdgcn_permlane32_swap(a0, b0, false, false); auto r1 = __builtin_amdgcn_permlane32_swap(a1, b1, false, false); \
    v4u w = {r0[0], r1[0], r0[1], r1[1]}; OUT = *reinterpret_cast<bf16x8*>(&w); } while (0)
    PK4(p0, 0, pa0); PK4(p0, 8, pa1); PK4(p1, 0, pa2); PK4(p1, 8, pa3);
#undef PK4
}
__device__ __forceinline__ int v_st(int k, int c) { const int kk = (k & ~0xC) | ((k & 4) << 1) | ((k & 8) >> 1); return ((kk >> 3) * 4 + (c >> 5)) * 512 + ((kk & 7) * 32 + (c & 31)) * 2; }
__device__ __forceinline__ int v_rd_base(int lane) { return ((lane & 3) << 3) | (((lane >> 2) & 3) << 6) | (((lane >> 4) & 1) << 5) | (((lane >> 5) & 1) << 8); }
constexpr int v_rd_off(int d0, int ks, int half) { return d0 * 512 + ks * 4096 + half * 2048; }
template <int OFF> __device__ __forceinline__ s16x4 tr_read(int vb) { s16x4 r; asm volatile("ds_read_b64_tr_b16 %0, %1 offset:%2" : "=&v"(r) : "v"(vb), "i"(OFF) : "memory"); return r; }
template <int D0> __device__ __forceinline__ void pv_one(f32x16& od, int vb, bf16x8 pa0, bf16x8 pa1, bf16x8 pa2, bf16x8 pa3) {
    const s16x4 l0 = tr_read<v_rd_off(D0, 0, 0)>(vb), h0 = tr_read<v_rd_off(D0, 0, 1)>(vb), l1 = tr_read<v_rd_off(D0, 1, 0)>(vb), h1 = tr_read<v_rd_off(D0, 1, 1)>(vb);
    const s16x4 l2 = tr_read<v_rd_off(D0, 2, 0)>(vb), h2 = tr_read<v_rd_off(D0, 2, 1)>(vb), l3 = tr_read<v_rd_off(D0, 3, 0)>(vb), h3 = tr_read<v_rd_off(D0, 3, 1)>(vb);
    asm volatile("s_waitcnt lgkmcnt(0)" ::: "memory"); SBAR();
#define PK(L, H) (bf16x8){L[0], L[1], L[2], L[3], H[0], H[1], H[2], H[3]}
    od = __builtin_amdgcn_mfma_f32_32x32x16_bf16(pa0, PK(l0, h0), od, 0, 0, 0);
    od = __builtin_amdgcn_mfma_f32_32x32x16_bf16(pa1, PK(l1, h1), od, 0, 0, 0);
    od = __builtin_amdgcn_mfma_f32_32x32x16_bf16(pa2, PK(l2, h2), od, 0, 0, 0);
    od = __builtin_amdgcn_mfma_f32_32x32x16_bf16(pa3, PK(l3, h3), od, 0, 0, 0);
#undef PK
}
__device__ __forceinline__ void pv_d0(f32x16* o, int vb, bf16x8 pa0, bf16x8 pa1, bf16x8 pa2, bf16x8 pa3) {
    pv_one<0>(o[0], vb, pa0, pa1, pa2, pa3); pv_one<1>(o[1], vb, pa0, pa1, pa2, pa3); pv_one<2>(o[2], vb, pa0, pa1, pa2, pa3); pv_one<3>(o[3], vb, pa0, pa1, pa2, pa3);
}
__device__ __forceinline__ bf16x8 pack8(const float* x) { v4u w = {cvtpk(x[0], x[1]), cvtpk(x[2], x[3]), cvtpk(x[4], x[5]), cvtpk(x[6], x[7])}; return *reinterpret_cast<bf16x8*>(&w); }

#define GLDS16(gp, lp) __builtin_amdgcn_global_load_lds((const unsigned*)(gp), (LAS unsigned*)(lp), 16, 0, 0)
constexpr int AT_BUF = 40960;
__device__ __forceinline__ void attn_unit(Frame& F, int s, int h, int qb) {
    const int wid = F.wave, lane = F.lane, r32 = lane & 31, hi = lane >> 5;
    const int grow0 = (s < 16 ? 256 * s : NCTX + 1024 * (s - 16)) + 256 * qb;
    const int kvr0 = s < 16 ? 256 * s : NCTX + 1280 * (s - 16), NT = s < 16 ? 4 : 20;
    LAS char* L0 = (LAS char*)F.lds;
    LAS float* wsx = (LAS float*)(L0 + 2 * AT_BUF) + wid * 64; LAS float* li_l = wsx; LAS float* al_l = wsx + 32;
    bf16x8 qr[12];
    { const bf16* Qw = WSP(bf16, WS_Q) + (size_t)(grow0 + wid * 32 + r32) * QW + h * 192 + hi * 8;
#pragma unroll
      for (int d0 = 0; d0 < 12; ++d0) qr[d0] = *(const bf16x8*)(Qw + d0 * 16); }
    if (s >= 16) {
        const int t = 256 * qb + wid * 32 + r32; const float* ct = WSP(float, WS_ROPE) + t * 32; const float* stb = ct + 1024 * 32;
#pragma unroll
        for (int pr = 0; pr < 2; ++pr) { const int ib = 16 * pr + 8 * hi; float n1[8], n2[8];
#pragma unroll
            for (int j = 0; j < 8; ++j) { const float c = ct[ib + j], sn = stb[ib + j], x1 = bf2f(qr[8 + pr][j]), x2 = bf2f(qr[10 + pr][j]); n1[j] = x1 * c - x2 * sn; n2[j] = x1 * sn + x2 * c; }
            qr[8 + pr] = pack8(n1); qr[10 + pr] = pack8(n2); }
    }
    const bf16* KVb = WSP(bf16, WS_KV) + (size_t)kvr0 * 2048 + h * 256; const bf16* KRb = WSP(bf16, WS_KR) + (size_t)kvr0 * 64;
    int okn[2], ov[2], okr;
#pragma unroll
    for (int j = 0; j < 2; ++j) { const int p = 2 * wid + j;
        { const int row = 4 * p + (lane >> 4), ch = (lane & 15) ^ (row & 7); okn[j] = row * 2048 + 8 * ch; }
        { const int st = 2 * p + (lane >> 5), kk = 8 * (st >> 2) + ((lane & 31) >> 2), k = (kk & ~0xC) | ((kk & 4) << 1) | ((kk & 8) >> 1), col = 32 * (st & 3) + 8 * (lane & 3); ov[j] = k * 2048 + 128 + col; } }
    { const int row = 8 * wid + (lane >> 3), ch = (lane & 7) ^ ((row >> 1) & 7); okr = row * 64 + 8 * ch; }
#define AT_ISSUE(kt, b) do { LAS char* B_ = L0 + (b) * AT_BUF; const bf16* kv_ = KVb + (size_t)(kt) * (64 * 2048); \
        GLDS16(kv_ + ov[0], B_ + (2 * wid) * 1024); GLDS16(kv_ + ov[1], B_ + (2 * wid + 1) * 1024); \
        GLDS16(kv_ + okn[0], B_ + 16384 + (2 * wid) * 1024); GLDS16(kv_ + okn[1], B_ + 16384 + (2 * wid + 1) * 1024); \
        GLDS16(KRb + (size_t)(kt) * (64 * 64) + okr, B_ + 32768 + wid * 1024); } while (0)
    const int vb0 = (int)(unsigned)(size_t)L0 + v_rd_base(lane);
    float m_reg = -1e30f, l_reg = 0.f; f32x16 o[4];
#pragma unroll
    for (int d = 0; d < 4; ++d)
#pragma unroll
        for (int r = 0; r < 16; ++r) o[d][r] = 0.f;
    AT_ISSUE(0, 0);
    for (int kt = 0; kt < NT; ++kt) {
        VM_WAIT(); __syncthreads();
        if (kt + 1 < NT) AT_ISSUE(kt + 1, (kt + 1) & 1);
        const LAS char* Kn_lds = L0 + (kt & 1) * AT_BUF + 16384; const LAS char* Kr_lds = L0 + (kt & 1) * AT_BUF + 32768;
        f32x16 p0, p1;
#pragma unroll
        for (int r = 0; r < 16; ++r) { p0[r] = 0.f; p1[r] = 0.f; }
#pragma unroll
        for (int d0 = 0; d0 < 8; ++d0) { const int cb = (d0 * 16 + hi * 8) * 2;
            const bf16x8 b0 = *(const LAS bf16x8*)(Kn_lds + KSWZ(r32, cb)), b1 = *(const LAS bf16x8*)(Kn_lds + KSWZ(32 + r32, cb));
            p0 = __builtin_amdgcn_mfma_f32_32x32x16_bf16(b0, qr[d0], p0, 0, 0, 0); p1 = __builtin_amdgcn_mfma_f32_32x32x16_bf16(b1, qr[d0], p1, 0, 0, 0);
            if ((d0 & 3) == 3) SBAR(); }
#pragma unroll
        for (int d0 = 0; d0 < 4; ++d0) { const int ko = r32 * 128 + (((2 * d0 + hi) ^ ((r32 >> 1) & 7)) << 4);
            const bf16x8 b0 = *(const LAS bf16x8*)(Kr_lds + ko), b1 = *(const LAS bf16x8*)(Kr_lds + 32 * 128 + ko);
            p0 = __builtin_amdgcn_mfma_f32_32x32x16_bf16(b0, qr[8 + d0], p0, 0, 0, 0); p1 = __builtin_amdgcn_mfma_f32_32x32x16_bf16(b1, qr[8 + d0], p1, 0, 0, 0); }
        SBAR();
        float mn, alpha; bf16x8 pa0, pa1, pa2, pa3;
        partialSM(p0, p1, m_reg, mn, alpha);
        if (__any(alpha < 1.f)) { if (hi == 0) al_l[r32] = alpha; LDS_WAIT();
#pragma unroll
            for (int d = 0; d < 4; ++d)
#pragma unroll
                for (int r = 0; r < 16; ++r) o[d][r] *= al_l[crow(r, hi)]; }
        finishSM(p0, p1, alpha, l_reg, pa0, pa1, pa2, pa3); SBAR();
        pv_d0(o, vb0 + (kt & 1) * AT_BUF, pa0, pa1, pa2, pa3);
    }
    if (hi == 0) li_l[r32] = l_reg; LDS_WAIT();
    bf16* Ow = WSP(bf16, WS_MIX) + (size_t)(grow0 + wid * 32) * DM + h * 128 + r32;
#pragma unroll
    for (int r = 0; r < 16; ++r) { const int orow = crow(r, hi); const float rl = __builtin_amdgcn_rcpf(li_l[orow]);
#pragma unroll
        for (int d0 = 0; d0 < 4; ++d0) Ow[(size_t)orow * DM + d0 * 32] = f2bf(o[d0][r] * rl); }
#undef AT_ISSUE
}

__device__ __forceinline__ void four_unit(Frame& F, int s, int g, int ob) {
    const int wid = F.wave, lane = F.lane, r32 = lane & 31, hi = lane >> 5;
    const int T = s < 16 ? 256 : 1024, row0 = s < 16 ? 256 * s : NCTX + 1024 * (s - 16), NTH = T / 64, NT = 2 * NTH, ldp = 2 * T;
    LAS char* L0 = (LAS char*)F.lds;
    const bf16* Pw = (s < 16 ? WSP(bf16, WS_P256) : WSP(bf16, WS_P1024)) + (size_t)(256 * ob + wid * 32 + r32) * ldp + hi * 8;
    const bf16* Y = WSP(bf16, WS_Y) + (size_t)row0 * 1024 + g * 256;
    int ov[2];
#pragma unroll
    for (int j = 0; j < 2; ++j) { const int p = 2 * wid + j, st = 2 * p + (lane >> 5), kk = 8 * (st >> 2) + ((lane & 31) >> 2), k = (kk & ~0xC) | ((kk & 4) << 1) | ((kk & 8) >> 1), col = 32 * (st & 3) + 8 * (lane & 3); ov[j] = k * 1024 + col; }
    const int vb0 = (int)(unsigned)(size_t)L0 + v_rd_base(lane);
    bf16x8 na0, na1, na2, na3;
#define FO_ISSUE(kt, b) do { const int part_ = (kt) >= NTH ? 1 : 0; const bf16* yp_ = Y + (size_t)(64 * ((kt) - part_ * NTH)) * 1024 + part_ * 128; \
        GLDS16(yp_ + ov[0], L0 + (b) * 16384 + (2 * wid) * 1024); GLDS16(yp_ + ov[1], L0 + (b) * 16384 + (2 * wid + 1) * 1024); } while (0)
#define FO_LOADP(kt) do { na0 = *(const bf16x8*)(Pw + 64 * (kt)); na1 = *(const bf16x8*)(Pw + 64 * (kt) + 16); na2 = *(const bf16x8*)(Pw + 64 * (kt) + 32); na3 = *(const bf16x8*)(Pw + 64 * (kt) + 48); } while (0)
    f32x16 o[4];
#pragma unroll
    for (int d = 0; d < 4; ++d)
#pragma unroll
        for (int r = 0; r < 16; ++r) o[d][r] = 0.f;
    FO_ISSUE(0, 0); FO_LOADP(0);
    for (int kt = 0; kt < NT; ++kt) {
        VM_WAIT(); __syncthreads();
        const bf16x8 pa0 = na0, pa1 = na1, pa2 = na2, pa3 = na3;
        if (kt + 1 < NT) { FO_ISSUE(kt + 1, (kt + 1) & 1); FO_LOADP(kt + 1); }
        pv_d0(o, vb0 + (kt & 1) * 16384, pa0, pa1, pa2, pa3);
    }
    bf16* Ow = WSP(bf16, WS_MIX) + (size_t)(row0 + 256 * ob + wid * 32) * DM + 1024 + g * 128 + r32;
#pragma unroll
    for (int r = 0; r < 16; ++r) { const int orow = crow(r, hi);
#pragma unroll
        for (int d0 = 0; d0 < 4; ++d0) Ow[(size_t)orow * DM + d0 * 32] = f2bf(o[d0][r]); }
#undef FO_ISSUE
#undef FO_LOADP
}

constexpr int NUNITS = 704, CV_PER_UNIT = 64, NCVU = (I_LAYER + CV_PER_UNIT - 1) / CV_PER_UNIT, NMODU = 96;
__device__ __forceinline__ void mixer_phase(Frame& F, int lq) {
    const int l = lq & 3; gu32* ctr = F.ctl + CW_QUEUE + 64 * lq;
    const int ntot = (l < DEPTH - 1 && lq < 4) ? NUNITS + NCVU + NMODU : NUNITS;
    for (;;) {
        __syncthreads();
        if (F.tid == 0) F.MISC[0] = __hip_atomic_fetch_add(ctr, 1u, RLX_AGENT);
        __syncthreads();
        const int u = (int)F.MISC[0];
        if (u >= ntot) break;
        { int t_ = threadIdx.x; asm volatile("" : "+v"(t_)); F.tid = t_; F.lane = t_ & 63; F.wave = __builtin_amdgcn_readfirstlane(t_ >> 6); }
        if (u >= NUNITS) {
            if (u < NUNITS + NCVU) { LAS float* scr = (LAS float*)(F.lds + RING_OFF + F.wave * 16384); const int base = (u - NUNITS) * CV_PER_UNIT + F.wave * (CV_PER_UNIT / NWAVES);
                for (int i = 0; i < CV_PER_UNIT / NWAVES; ++i) if (base + i < I_LAYER) convert_wave_item(F, l + 1, base + i, scr); }
            else mod_block_item(F, l + 1, u - NUNITS - NCVU);
            continue;
        }
        int ty, a, b, c;
        if (u < 64) { ty = 0; a = 16 + (u >> 4); b = (u & 15) >> 1; c = u & 1; }
        else if (u < 192) { const int i = u - 64; ty = 1; a = 16 + (i >> 5); b = (i >> 2) & 7; c = i & 3; }
        else if (u < 256) { const int i = u - 192; ty = 2; a = 16 + (i >> 4); b = (i >> 2) & 3; c = i & 3; }
        else if (u < 512) { const int i = u - 256; ty = 0; a = i >> 4; b = (i & 15) >> 1; c = i & 1; }
        else if (u < 640) { const int i = u - 512; ty = 1; a = i >> 3; b = i & 7; c = 0; }
        else { const int i = u - 640; ty = 2; a = i >> 2; b = i & 3; c = 0; }
        if (ty == 0) scan_unit(F, l, a, b, c); else if (ty == 1) attn_unit(F, a, b, c); else four_unit(F, a, b, c);
    }
}

#ifndef MK_MODE
#define MK_MODE 1
#endif
struct Args { const float* in[NIN]; float* out; unsigned char* ws; int ph_lo, ph_hi, li, pad; };
__global__ void __launch_bounds__(NWAVES * 64, 2) mk_fwd(Args args) {
    extern __shared__ __attribute__((aligned(16))) unsigned char lds_raw[];
    Frame F;
    F.lds = (LAS unsigned char*)lds_raw;
    F.MISC = (volatile LAS unsigned*)(F.lds + MISC_OFF);
    F.tid = threadIdx.x; F.lane = F.tid & 63; F.wave = __builtin_amdgcn_readfirstlane(F.tid >> 6);
    F.G = gridDim.x; { const int bx = blockIdx.x; F.vcu = (F.G % 8 == 0) ? (bx % 8) * (F.G / 8) + bx / 8 : bx; }
    F.in = args.in; F.out = args.out; F.ws = args.ws; F.ctl = (gu32*)(args.ws + WS_CTL);
    for (int u = F.tid; u < (LDS_BYTES - LDSCTL_OFF) / 4; u += NWAVES * 64) ((LAS unsigned*)(F.lds + LDSCTL_OFF))[u] = 0u;
    __syncthreads();
    const int lo = args.ph_lo, hi = args.ph_hi;
    XcdBarrier bar; bar.bar = (unsigned*)(F.ctl + CW_BAR) + args.li * XCD_BAR_WORDS; bar.x = 0; bar.st = nullptr;
    if (hi - lo > 1) bar = xcd_barrier_post((unsigned*)(F.ctl + CW_BAR) + args.li * XCD_BAR_WORDS, F.MISC + 8);
#ifdef ONLY
#define KIND_ON(x) ((x) == ONLY)
#else
#define KIND_ON(x) true
#endif
#define IN(k) (lo <= (k) && (k) < hi)
#ifndef REPMASK
#define REPMASK 0
#endif
#define NREP(kind) (1 + ((REPMASK >> (kind)) & 1))
#define RELANE() do { int t_ = threadIdx.x; asm volatile("" : "+v"(t_)); F.tid = t_; F.lane = t_ & 63; F.wave = __builtin_amdgcn_readfirstlane(t_ >> 6); } while (0)
#define SEAM(k) do { if (IN(k) && IN((k) + 1)) xcd_barrier(bar); } while (0)
    const int cb = (int)blockIdx.x;

    if (KIND_ON(0) && IN(0)) { for (int rep = 0; rep < NREP(0); ++rep) { RELANE(); p0_prologue(F); } SEAM(0); }
    if (KIND_ON(1) && IN(1)) { for (int rep = 0; rep < NREP(1); ++rep) { RELANE(); norm_phase<0>(F, 0); } SEAM(1); }
    for (int l = 0; l < DEPTH; ++l) {
        const int pb = 2 + 11 * l;
        if (KIND_ON(2) && IN(pb + 0)) {
            for (int rep = 0; rep < NREP(2); ++rep) {
            pg8::Gemm g{WSP(bf16, WS_H), WSP(bf16, WS_WIN) + (size_t)l * INP * DM, NTOK, INP, DM, DM}; pg8::StaticOrder S; S.init(NTOK, INP, F.G, cb);
            pg8::EpiAny E{(void*)WSP(bf16, WS_PROJ), INP, 0};
            pg8::gemm_phase<pg8::EpiAny, pg8::StaticOrder, true, true>(F.lds + RING_OFF, g, S, E); }
            SEAM(pb + 0);
        }
        if (KIND_ON(3) && IN(pb + 1)) { for (int rep = 0; rep < NREP(3); ++rep) { RELANE(); prep_phase(F, l); } SEAM(pb + 1); }
        if (KIND_ON(4) && IN(pb + 2)) {
            for (int gi = 0; gi < 4 * NREP(4); ++gi) {
                const bf16* A_; const bf16* B_; void* O_; int M_, N_, K_, f_, rot_, lda_;
                if ((gi & 3) == 0) { A_ = WSP(bf16, WS_QN); B_ = WSP(bf16, WS_WUQ) + (size_t)l * QW * 512; O_ = WSP(bf16, WS_Q); M_ = NTOK; N_ = QW; K_ = 512; f_ = 0; rot_ = 0; lda_ = 512; }
                else if ((gi & 3) == 1) { A_ = WSP(bf16, WS_PROJ) + OFF_XF; B_ = WSP(bf16, WS_MBD); O_ = WSP(bf16, WS_Y); M_ = NTOK; N_ = 1024; K_ = 512; f_ = 0; rot_ = 192; lda_ = INP; }
                else if ((gi & 3) == 2) { A_ = WSP(bf16, WS_CKVA); B_ = WSP(bf16, WS_WUKV) + (size_t)l * 2048 * 256; O_ = WSP(bf16, WS_KV); M_ = KVROWS; N_ = 2048; K_ = 256; f_ = 0; rot_ = 64; lda_ = 256; }
                else { A_ = WSP(bf16, WS_AL); B_ = WSP(bf16, WS_WL) + (size_t)l * LORAN * 256; O_ = WSP(bf16, WS_LORA); M_ = NTOK; N_ = LORAN; K_ = 256; f_ = 0; rot_ = 96; lda_ = 256; }
                pg8::Gemm g{A_, B_, M_, N_, K_, lda_}; pg8::StaticOrder S; S.init(M_, N_, F.G, (cb + F.G - rot_ % F.G) % F.G);
                pg8::EpiAny E{O_, N_, f_};
                pg8::gemm_phase<pg8::EpiAny, pg8::StaticOrder, true, true>(F.lds + RING_OFF, g, S, E);
            }
            SEAM(pb + 2);
        }
        if (KIND_ON(5) && IN(pb + 3)) { for (int rep = 0; rep < NREP(5); ++rep) { RELANE(); mixer_phase(F, l + 4 * rep); } SEAM(pb + 3); }
        if (KIND_ON(6) && IN(pb + 4)) { for (int rep = 0; rep < NREP(6); ++rep) { RELANE(); post_phase(F, l); } SEAM(pb + 4); }
        if (KIND_ON(7) && IN(pb + 5)) {
            for (int rep = 0; rep < NREP(7); ++rep) {
            pg8::Gemm g{WSP(bf16, WS_MIX), WSP(bf16, WS_WOUT) + (size_t)l * DM * DM, NTOK, DM, DM, DM}; pg8::StaticOrder S; S.init(NTOK, DM, F.G, cb);
            pg8::EpiAny E{(void*)WSP(bf16, WS_O), DM, 0};
            pg8::gemm_phase<pg8::EpiAny, pg8::StaticOrder, true, true>(F.lds + RING_OFF, g, S, E); }
            SEAM(pb + 5);
        }
        if (KIND_ON(8) && IN(pb + 6)) { RELANE(); norm_phase<1>(F, l); SEAM(pb + 6); }
        if (KIND_ON(9) && IN(pb + 7)) {
            for (int rep = 0; rep < NREP(9); ++rep) {
            pg8::Gemm g{WSP(bf16, WS_H), WSP(bf16, WS_WUP) + (size_t)l * UPN * DM, NTOK, UPN, DM, DM}; pg8::StaticOrder S; S.init(NTOK, UPN, F.G, cb);
            pg8::EpiFfnAct E{WSP(bf16, WS_ACT), DFF, DFF, UPN, F.in[I_FCONV] + (size_t)l * 3 * UPN, F.in[I_FCONVB] + (size_t)l * UPN, WSP(float, WS_HALO), F.lds + HALO_OFF};
            pg8::gemm_phase<pg8::EpiFfnAct, pg8::StaticOrder, true, true>(F.lds + RING_OFF, g, S, E); }
            SEAM(pb + 7);
        }
        if (KIND_ON(10) && IN(pb + 8)) { for (int rep = 0; rep < NREP(10); ++rep) { RELANE(); ffn_fix_phase(F, l); } SEAM(pb + 8); }
        if (KIND_ON(11) && IN(pb + 9)) {
            for (int rep = 0; rep < NREP(11); ++rep) {
            pg8::Gemm g{WSP(bf16, WS_ACT), WSP(bf16, WS_WDN) + (size_t)l * DM * DFF, NTOK, DM, DFF, DFF}; pg8::StaticOrder S; S.init(NTOK, DM, F.G, cb);
            pg8::EpiAny E{(void*)WSP(bf16, WS_O), DM, 0};
            pg8::gemm_phase<pg8::EpiAny, pg8::StaticOrder, true, true>(F.lds + RING_OFF, g, S, E); }
            SEAM(pb + 9);
        }
        if (KIND_ON(12) && IN(pb + 10)) { RELANE(); norm_phase<2>(F, l); SEAM(pb + 10); }
    }
#undef IN
#undef SEAM
}

extern "C" void kernel_launch(void* const* d_in, const int* in_sizes, int n_in, void* d_out, int out_size, void* d_ws, size_t ws_size, hipStream_t stream) {
    static int grid = 0;
    if (grid == 0) {
        if (n_in != NIN || (size_t)out_size != OUT_END || ws_size < WS_END) { fprintf(stderr, "kernel_launch: built for %d inputs, %zu outputs, >= %zu bytes of workspace; got n_in %d, out %d, ws %zu; nothing launched\n", NIN, (size_t)OUT_END, (size_t)WS_END, n_in, out_size, ws_size); grid = -1; return; }
        int dev = 0, cus = 0, per_cu = 0;
        if (hipGetDevice(&dev) != hipSuccess || hipDeviceGetAttribute(&cus, hipDeviceAttributeMultiprocessorCount, dev) != hipSuccess) { fprintf(stderr, "kernel_launch: device query failed\n"); grid = -1; return; }
        if (hipFuncSetAttribute((const void*)mk_fwd, hipFuncAttributeMaxDynamicSharedMemorySize, LDS_BYTES) != hipSuccess) { fprintf(stderr, "kernel_launch: hipFuncSetAttribute failed\n"); grid = -1; return; }
        if (hipOccupancyMaxActiveBlocksPerMultiprocessor(&per_cu, (const void*)mk_fwd, NWAVES * 64, LDS_BYTES) != hipSuccess || per_cu < 1)
            fprintf(stderr, "kernel_launch: note: occupancy query reports %d workgroups per CU\n", per_cu);
        (void)hipGetLastError();
        grid = cus;
    }
    if (grid < 0) return;
    if (hipMemsetAsync((char*)d_ws + WS_CTL, 0, CTL_BYTES, stream) != hipSuccess) { fprintf(stderr, "kernel_launch: memset failed\n"); return; }
    Args a{};
    for (int i = 0; i < NIN; ++i) a.in[i] = (const float*)d_in[i];
    a.out = (float*)d_out; a.ws = (unsigned char*)d_ws; a.pad = 0;
#if MK_MODE == 1
    const int nl = 1; const int cuts[2] = {0, NPHASES};
#else
    const int nl = NPHASES; int cuts[NPHASES + 1]; for (int i = 0; i <= NPHASES; ++i) cuts[i] = i;
#endif
    for (int li = 0; li < nl; ++li) {
        a.ph_lo = cuts[li]; a.ph_hi = cuts[li + 1]; a.li = li;
        hipLaunchKernelGGL(mk_fwd, dim3(grid), dim3(NWAVES * 64), LDS_BYTES, stream, a);
        const hipError_t le = hipPeekAtLastError();
        if (le != hipSuccess) { fprintf(stderr, "kernel_launch: launch %d failed: %s\n", li, hipGetErrorName(le)); break; }
    }
}
```
